# Optimizing an MI355X kernel written in HIP

```python
import jax, jax.numpy as jnp
from jax import lax
import numpy as np

D_MODEL = 2048
BATCH = 4
SEQ = 2048
DEPTH = 1
DEC_BATCH = 128
DEC_SEQ = 8
PAST_LEN = 16384
PAGE_SIZE = 128

POOL_WIDTH = D_MODEL // 2
POOL_WINDOWS = (2, 4, 8, 16)
POOL_GROUPS = len(POOL_WINDOWS)
POOL_GROUP_DIM = POOL_WIDTH // POOL_GROUPS
POOL_BUF = max(POOL_WINDOWS) - 1
LRU_WIDTH = D_MODEL
LRU_BLOCKS = 8
LRU_BLOCK_DIM = LRU_WIDTH // LRU_BLOCKS
LRU_CONV = 4
LRU_C = 8.0
D_FF = 3 * D_MODEL
FFN_CONV = 3
IN_WIDTH = POOL_WIDTH + LRU_WIDTH + 2 * D_MODEL
N_ADA = 6
EPS = 1e-6

kernel_name = 'hybrid_pool_rglru_convffn_step'


def rmsnorm(x, g):
    xf = x.astype(jnp.float32)
    y = xf * lax.rsqrt(jnp.mean(xf * xf, axis=-1, keepdims=True) + EPS)
    return (y * g.astype(jnp.float32)).astype(x.dtype)


def causal_dwconv(buf, u, w, b):
    K = w.shape[0]
    T = u.shape[1]
    ext = jnp.concatenate([buf.astype(u.dtype), u], axis=1)
    out = ext[:, 0:T] * w[0]
    for k in range(1, K):
        out = out + ext[:, k:k + T] * w[k]
    return out + b, ext[:, -(K - 1):]


def pool_mix(buf, u, start, w_grp, scale):
    B, T, P = u.shape
    ext = jnp.concatenate([buf.astype(u.dtype), u], axis=1)
    cs = jnp.cumsum(ext.astype(jnp.float32), axis=1)
    cs = jnp.pad(cs, ((0, 0), (1, 0), (0, 0)))
    hi = cs[:, POOL_BUF + 1:]
    pos = start + jnp.arange(T, dtype=jnp.int32)
    means = []
    for k, w in enumerate(POOL_WINDOWS):
        sl = slice(k * POOL_GROUP_DIM, (k + 1) * POOL_GROUP_DIM)
        lo = cs[:, POOL_BUF + 1 - w:POOL_BUF + 1 - w + T, sl]
        cnt = jnp.minimum(w, pos + 1).astype(jnp.float32)[None, :, None]
        means.append((hi[..., sl] - lo) / cnt)
    mean = jnp.concatenate(means, axis=-1).astype(u.dtype)
    d = (mean - u).reshape(B, T, POOL_GROUPS, POOL_GROUP_DIM)
    y = jnp.einsum('btgc,gcd->btgd', d, w_grp).reshape(B, T, P) * scale
    return y, ext[:, -POOL_BUF:]


def rglru(h0, xc, w_rg, b_rg, w_ig, b_ig, lam):
    B, T, R = xc.shape
    xb = xc.reshape(B, T, LRU_BLOCKS, LRU_BLOCK_DIM)
    r = jax.nn.sigmoid((jnp.einsum('btnc,ncd->btnd', xb, w_rg).reshape(B, T, R) + b_rg).astype(jnp.float32))
    i = jax.nn.sigmoid((jnp.einsum('btnc,ncd->btnd', xb, w_ig).reshape(B, T, R) + b_ig).astype(jnp.float32))
    log_a = -LRU_C * r * jax.nn.softplus(-lam.astype(jnp.float32))
    a = jnp.exp(log_a)
    u = jnp.sqrt(-jnp.expm1(2.0 * log_a)) * (i * xc.astype(jnp.float32))

    def step(h, inp):
        a_t, u_t = inp
        h = a_t * h + u_t
        return h, h

    hT, hs = lax.scan(step, h0.astype(jnp.float32), (jnp.swapaxes(a, 0, 1), jnp.swapaxes(u, 0, 1)))
    return jnp.swapaxes(hs, 0, 1).astype(xc.dtype), hT


def _layer(x, c, pool_buf, lru_buf, lru_h, ffn_buf, start,
           w_ada, b_ada, g_pre1, g_post1, g_pre2, g_post2, w_in, w_pool_grp, pool_scale,
           w_lru_conv, b_lru_conv, w_rg, b_rg, w_ig, b_ig, lru_lambda,
           w_pool_up, w_lru_up, w_out, w_ffn_up, w_ffn_conv, b_ffn_conv, w_ffn_down):
    ada = (jax.nn.silu(c) @ w_ada + b_ada)[:, None, :]
    shift1, scale1, gate1, shift2, scale2, gate2 = jnp.split(ada, N_ADA, axis=-1)

    h = rmsnorm(x, g_pre1) * (1.0 + scale1) + shift1
    z = h @ w_in
    u_pool, u_lru, g_pool, g_lru = jnp.split(
        z, [POOL_WIDTH, POOL_WIDTH + LRU_WIDTH, POOL_WIDTH + LRU_WIDTH + D_MODEL], axis=-1)
    y_pool, new_pool = pool_mix(pool_buf, u_pool, start, w_pool_grp, pool_scale)
    xc, new_lru_buf = causal_dwconv(lru_buf, u_lru, w_lru_conv, b_lru_conv)
    y_lru, new_h = rglru(lru_h, xc, w_rg, b_rg, w_ig, b_ig, lru_lambda)
    merged = jax.nn.sigmoid(g_pool) * (y_pool @ w_pool_up) + jax.nn.sigmoid(g_lru) * (y_lru @ w_lru_up)
    x = x + gate1 * rmsnorm(merged @ w_out, g_post1)

    h = rmsnorm(x, g_pre2) * (1.0 + scale2) + shift2
    up = h @ w_ffn_up
    upc, new_ffn_buf = causal_dwconv(ffn_buf, up, w_ffn_conv, b_ffn_conv)
    gt, val = jnp.split(upc, 2, axis=-1)
    f = jax.nn.gelu(gt, approximate=True) * val
    x = x + gate2 * rmsnorm(f @ w_ffn_down, g_post2)
    return x, new_pool, new_lru_buf, new_h, new_ffn_buf


def setup_inputs(seed: int = 0) -> dict:
    key = jax.random.key(seed)
    ks = iter(jax.random.split(key, 40))
    f32 = jnp.float32

    def nrm(shape, scale):
        return jax.random.normal(next(ks), shape, f32) * scale

    def gain(shape):
        return 1.0 + 0.05 * jax.random.normal(next(ks), shape, f32)

    a0 = jax.random.uniform(next(ks), (DEPTH, LRU_WIDTH), f32, 0.9, 0.999)
    p = a0 ** (1.0 / LRU_C)
    lru_lambda = jnp.log(p) - jnp.log1p(-p)

    return {
        'x_prompt': nrm((BATCH, SEQ, D_MODEL), 1.0),
        'x_sample': nrm((DEC_BATCH, DEC_SEQ, D_MODEL), 1.0),
        'c_prompt': nrm((BATCH, D_MODEL), 1.0),
        'c_sample': nrm((DEC_BATCH, D_MODEL), 1.0),
        'state_pool': nrm((DEPTH, DEC_BATCH, POOL_BUF, POOL_WIDTH), 1.0),
        'state_lru_conv': nrm((DEPTH, DEC_BATCH, LRU_CONV - 1, LRU_WIDTH), 1.0),
        'state_lru_h': nrm((DEPTH, DEC_BATCH, LRU_WIDTH), 0.5),
        'state_ffn_conv': nrm((DEPTH, DEC_BATCH, FFN_CONV - 1, 2 * D_FF), 1.0),
        'w_ada': nrm((DEPTH, D_MODEL, N_ADA * D_MODEL), 0.5 * D_MODEL ** -0.5),
        'b_ada': nrm((DEPTH, N_ADA * D_MODEL), 0.02),
        'g_pre1': gain((DEPTH, D_MODEL)),
        'g_post1': gain((DEPTH, D_MODEL)),
        'g_pre2': gain((DEPTH, D_MODEL)),
        'g_post2': gain((DEPTH, D_MODEL)),
        'w_in': nrm((DEPTH, D_MODEL, IN_WIDTH), D_MODEL ** -0.5),
        'w_pool_grp': nrm((DEPTH, POOL_GROUPS, POOL_GROUP_DIM, POOL_GROUP_DIM), POOL_GROUP_DIM ** -0.5),
        'pool_scale': gain((DEPTH, POOL_WIDTH)),
        'w_lru_conv': nrm((DEPTH, LRU_CONV, LRU_WIDTH), LRU_CONV ** -0.5),
        'b_lru_conv': nrm((DEPTH, LRU_WIDTH), 0.02),
        'w_rg': nrm((DEPTH, LRU_BLOCKS, LRU_BLOCK_DIM, LRU_BLOCK_DIM), LRU_BLOCK_DIM ** -0.5),
        'b_rg': nrm((DEPTH, LRU_WIDTH), 0.02),
        'w_ig': nrm((DEPTH, LRU_BLOCKS, LRU_BLOCK_DIM, LRU_BLOCK_DIM), LRU_BLOCK_DIM ** -0.5),
        'b_ig': nrm((DEPTH, LRU_WIDTH), 0.02),
        'lru_lambda': lru_lambda,
        'w_pool_up': nrm((DEPTH, POOL_WIDTH, D_MODEL), POOL_WIDTH ** -0.5),
        'w_lru_up': nrm((DEPTH, LRU_WIDTH, D_MODEL), LRU_WIDTH ** -0.5),
        'w_out': nrm((DEPTH, D_MODEL, D_MODEL), D_MODEL ** -0.5),
        'w_ffn_up': nrm((DEPTH, D_MODEL, 2 * D_FF), D_MODEL ** -0.5),
        'w_ffn_conv': nrm((DEPTH, FFN_CONV, 2 * D_FF), FFN_CONV ** -0.5),
        'b_ffn_conv': nrm((DEPTH, 2 * D_FF), 0.02),
        'w_ffn_down': nrm((DEPTH, D_FF, D_MODEL), D_FF ** -0.5),
    }


def reference(x_prompt, x_sample, c_prompt, c_sample, state_pool, state_lru_conv, state_lru_h, state_ffn_conv,
              w_ada, b_ada, g_pre1, g_post1, g_pre2, g_post2, w_in, w_pool_grp, pool_scale,
              w_lru_conv, b_lru_conv, w_rg, b_rg, w_ig, b_ig, lru_lambda,
              w_pool_up, w_lru_up, w_out, w_ffn_up, w_ffn_conv, b_ffn_conv, w_ffn_down):
    weights = (w_ada, b_ada, g_pre1, g_post1, g_pre2, g_post2, w_in, w_pool_grp, pool_scale,
               w_lru_conv, b_lru_conv, w_rg, b_rg, w_ig, b_ig, lru_lambda,
               w_pool_up, w_lru_up, w_out, w_ffn_up, w_ffn_conv, b_ffn_conv, w_ffn_down)
    dt = x_prompt.dtype
    yp, ys = x_prompt, x_sample
    pp, plc, plh, pfc = [], [], [], []
    sp, slc, slh, sfc = [], [], [], []
    for l in range(DEPTH):
        params = [w[l] for w in weights]
        yp, a1, a2, a3, a4 = _layer(
            yp, c_prompt,
            jnp.zeros((BATCH, POOL_BUF, POOL_WIDTH), dt),
            jnp.zeros((BATCH, LRU_CONV - 1, LRU_WIDTH), dt),
            jnp.zeros((BATCH, LRU_WIDTH), jnp.float32),
            jnp.zeros((BATCH, FFN_CONV - 1, 2 * D_FF), dt),
            0, *params)
        pp.append(a1); plc.append(a2); plh.append(a3); pfc.append(a4)
        ys, b1, b2, b3, b4 = _layer(
            ys, c_sample, state_pool[l], state_lru_conv[l], state_lru_h[l], state_ffn_conv[l],
            PAST_LEN, *params)
        sp.append(b1); slc.append(b2); slh.append(b3); sfc.append(b4)
    return (yp, ys,
            jnp.stack(pp), jnp.stack(plc), jnp.stack(plh), jnp.stack(pfc),
            jnp.stack(sp), jnp.stack(slc), jnp.stack(slh), jnp.stack(sfc))
```

```cpp
#include <hip/hip_runtime.h>
#include <hip/hip_cooperative_groups.h>
#include <cstdio>
namespace cg = cooperative_groups;

#define LAS __attribute__((address_space(3)))
typedef unsigned short bf16_t;
typedef short bf16x8 __attribute__((ext_vector_type(8)));
typedef float f32x4 __attribute__((ext_vector_type(4)));
typedef float f32x2 __attribute__((ext_vector_type(2)));
typedef unsigned u32x4 __attribute__((ext_vector_type(4)));
typedef unsigned u32x2 __attribute__((ext_vector_type(2)));

#ifndef PHASE_MASK
#define PHASE_MASK 0xFFFFFFFFu
#endif

constexpr int DM = 2048, MTOK = 9216, MPROMPT = 8192, SEQ = 2048, NSEQ = 132;
constexpr int PW = 1024, LW = 2048, INW = 7168, DFF = 6144, NADA = 12288;
constexpr float EPS = 1e-6f;
constexpr int NTHREADS = 512, NWAVES = 8;

enum { I_XP = 0, I_XS, I_CP, I_CS, I_SPOOL, I_SLCONV, I_SLH, I_SFCONV, I_WADA, I_BADA, I_GPRE1, I_GPOST1, I_GPRE2, I_GPOST2,
       I_WIN, I_WGRP, I_PSCALE, I_WLCONV, I_BLCONV, I_WRG, I_BRG, I_WIG, I_BIG, I_LAM, I_WPU, I_WLU, I_WOUT, I_WUP, I_WFCONV, I_BFCONV, I_WDOWN, N_IN };

constexpr size_t O_YP = 0, O_YS = 16777216, O_POOLP = 18874368, O_LCONVP = O_POOLP + 61440, O_LHP = O_LCONVP + 24576, O_FCONVP = O_LHP + 8192,
                 O_POOLS = O_FCONVP + 98304, O_LCONVS = O_POOLS + 1966080, O_LHS = O_LCONVS + 786432, O_FCONVS = O_LHS + 262144;

constexpr size_t MiB = 1ull << 20;
constexpr size_t WS_ADA = 0, WS_CTL = 12 * MiB, WS_SADA = 13 * MiB, WS_WDOWN = 14 * MiB, WS_WUP = 38 * MiB,
                 WS_WGRP = 86 * MiB, WS_WGATE = 86 * MiB + 512 * 1024, WS_WPU = 89 * MiB, WS_WLU = 93 * MiB, WS_WOUT = 101 * MiB,
                 WS_WADA = 109 * MiB, WS_WIN = 157 * MiB, WS_H = 185 * MiB, WS_Z = 221 * MiB, WS_DP = 347 * MiB, WS_XC = 365 * MiB, WS_YP = 401 * MiB,
                 WS_LA = 109 * MiB, WS_UU = 181 * MiB, WS_YL = 347 * MiB, WS_MG = 109 * MiB, WS_MO = 221 * MiB, WS_UP = 221 * MiB, WS_F = 109 * MiB;

constexpr size_t WS_BAR = WS_CTL + 64 * 1024;
constexpr size_t WS_MOS = 253 * MiB;
constexpr size_t WS_MGS = 145 * MiB;
constexpr size_t WS_H2 = 109 * MiB;
constexpr size_t WS_UPB = 145 * MiB;
constexpr size_t WS_F2 = 221 * MiB;
constexpr size_t WS_FO = 109 * MiB;
constexpr size_t WS_FOS2 = 329 * MiB;
constexpr size_t WS_FOS = 253 * MiB;
constexpr int LDS_MAIN = 8 * 16640;
struct Params { const float* in[N_IN]; float* out; unsigned char* ws; };

__device__ __forceinline__ unsigned pk2(float lo, float hi) { unsigned r; asm("v_cvt_pk_bf16_f32 %0, %1, %2" : "=v"(r) : "v"(lo), "v"(hi)); return r; }
__device__ __forceinline__ float bflo(unsigned w) { return __uint_as_float(w << 16); }
__device__ __forceinline__ float bfhi(unsigned w) { return __uint_as_float(w & 0xffff0000u); }
__device__ __forceinline__ float bf1(bf16_t b) { return __uint_as_float(((unsigned)b) << 16); }
__device__ __forceinline__ float sigmoidf_(float x) { return __builtin_amdgcn_rcpf(1.0f + __expf(-x)); }
__device__ __forceinline__ float wave_sum(float v) {
#pragma unroll
    for (int o = 1; o < 64; o <<= 1) v += __shfl_xor(v, o);
    return v;
}
__device__ __forceinline__ int seq_of_row(int r) { return r < MPROMPT ? (r >> 11) : 4 + ((r - MPROMPT) >> 3); }
__device__ __forceinline__ void unpack8(const u32x4 w, float (&f)[8]) {
    f[0] = bflo(w.x); f[1] = bfhi(w.x); f[2] = bflo(w.y); f[3] = bfhi(w.y); f[4] = bflo(w.z); f[5] = bfhi(w.z); f[6] = bflo(w.w); f[7] = bfhi(w.w);
}
__device__ __forceinline__ u32x4 pack8(const float (&f)[8]) { u32x4 w; w.x = pk2(f[0], f[1]); w.y = pk2(f[2], f[3]); w.z = pk2(f[4], f[5]); w.w = pk2(f[6], f[7]); return w; }


#define XB_TMO      128
#define XB_XCNT(j)  (256  + 64 * (j))
#define XB_XSUB(j)  (1280 + 64 * (j))
#define XB_XGEN(j)  (2304 + 64 * (j))
#define XB_TOP      3328
#define XB_TOPGEN   3392
#define XCD_BAR_WORDS 3456
#define P7_FLAG(t) (XCD_BAR_WORDS + 64 * (t))
#define ADA_FLAG (XCD_BAR_WORDS + 64 * 32)
#define BAR_ZERO_WORDS (XCD_BAR_WORDS + 64 * 33)
#define XB_SPIN_CAP (1u << 18)
__device__ __forceinline__ unsigned xb_ld(unsigned* p)              { return __hip_atomic_load(p, __ATOMIC_RELAXED, __HIP_MEMORY_SCOPE_AGENT); }
__device__ __forceinline__ unsigned xb_add(unsigned* p, unsigned v) { return __hip_atomic_fetch_add(p, v, __ATOMIC_RELAXED, __HIP_MEMORY_SCOPE_AGENT); }
__device__ __forceinline__ unsigned xb_xcc_id() { return (unsigned)__builtin_amdgcn_s_getreg((3 << 11) | 20) & 0xFu; }
#define XB_SPIN(cond, bar) do { unsigned _sp = 0; while (cond) { __builtin_amdgcn_s_sleep(1); \
    if ((++_sp & 255u) == 0u) { if (xb_ld(&(bar)[XB_TMO])) break; if (_sp > XB_SPIN_CAP) { atomicAdd(&(bar)[XB_TMO], 1u); break; } } } } while (0)
struct XcdBarrier { unsigned* bar; unsigned x; volatile LAS unsigned* st; };
__device__ __forceinline__ XcdBarrier xcd_barrier_post(unsigned* bar, volatile LAS unsigned* st) {
    XcdBarrier b; b.bar = bar; b.x = xb_xcc_id(); b.st = st;
    if (threadIdx.x == 0) (void)xb_add(&bar[XB_XCNT(b.x)], 1u);
    return b;
}
__device__ __forceinline__ void xcd_barrier_complete(unsigned* bar, unsigned x, unsigned& nloc, unsigned& nx) {
    const unsigned G = gridDim.x * gridDim.y * gridDim.z;
    unsigned sum, cnt, mine, sp = 0u;
    for (;;) {
        sum = 0u; cnt = 0u; mine = 0u;
#pragma unroll
        for (unsigned j = 0; j < 16; ++j) { const unsigned c = xb_ld(&bar[XB_XCNT(j)]); sum += c; cnt += (c > 0u) ? 1u : 0u; mine = (j == x) ? c : mine; }
        if (sum == G) break;
        __builtin_amdgcn_s_sleep(1);
        if ((++sp & 255u) == 0u) { if (xb_ld(&bar[XB_TMO])) break; if (sp > XB_SPIN_CAP) { atomicAdd(&bar[XB_TMO], 1u); break; } }
    }
    nloc = mine > 0u ? mine : 1u; nx = cnt > 0u ? cnt : 1u;
}
__device__ __forceinline__ void xcd_barrier(const XcdBarrier& b) {
    asm volatile("s_waitcnt vmcnt(0)" ::: "memory");
    __syncthreads();
    if (threadIdx.x == 0) {
        unsigned* bar = b.bar;
        __builtin_amdgcn_s_waitcnt(0);
        unsigned nloc = b.st[0], nx = b.st[1];
        if (nloc == 0u) { xcd_barrier_complete(bar, b.x, nloc, nx); b.st[0] = nloc; b.st[1] = nx; }
        const unsigned old = xb_add(&bar[XB_XSUB(b.x)], 1u);
        const unsigned gen = old / nloc;
        if (old + 1u == (gen + 1u) * nloc) {
            __builtin_amdgcn_fence(__ATOMIC_RELEASE, "agent");
            asm volatile("s_waitcnt vmcnt(0)" ::: "memory");
            const unsigned og = xb_add(&bar[XB_TOP], 1u);
            const unsigned tg = og / nx;
            if (og + 1u == (tg + 1u) * nx) xb_add(&bar[XB_TOPGEN], 1u);
            else XB_SPIN(xb_ld(&bar[XB_TOPGEN]) == tg, bar);
            __builtin_amdgcn_fence(__ATOMIC_ACQUIRE, "agent");
            xb_add(&bar[XB_XGEN(b.x)], 1u);
            asm volatile("s_waitcnt vmcnt(0)" ::: "memory");
        } else {
            XB_SPIN(xb_ld(&bar[XB_XGEN(b.x)]) == gen, bar);
            __builtin_amdgcn_fence(__ATOMIC_ACQUIRE, "agent");
            asm volatile("s_waitcnt vmcnt(0)" ::: "memory");
        }
    }
    __syncthreads();
}

__device__ __forceinline__ void ld8f(const float* p, float (&x)[8]);
__device__ __forceinline__ float gelu_tanh(float x) { const float y = 1.5957691216f * (x + 0.044715f * x * x * x); return x * __builtin_amdgcn_rcpf(1.0f + __expf(-y)); }
namespace pg8 {
constexpr int BM = 256, BK = 64, HALF = 128, HTB = HALF * BK * 2, STAGE_BYTES = 8 * HTB;
__device__ __forceinline__ int lds_byte(int r, int c) { const int st = (r >> 4) * 2 + (c >> 5), rr = r & 15, cc = c & 31, ob = rr * 64 + cc * 2; return st * 1024 + (ob ^ (((ob >> 9) & 1) << 5)); }
__device__ __forceinline__ void stage_rc(int b, int& R, int& C) { const int st = b / 1024, sb = b % 1024, swz = sb ^ (((sb >> 9) & 1) << 5); R = (st >> 1) * 16 + swz / 64; C = (st & 1) * 32 + (swz % 64) / 2; }
__device__ __forceinline__ int perm32(int rho) { const int n = rho >> 4, i = rho & 15; return 8 * (i >> 2) + 4 * n + (i & 3); }

struct Unit { const char* A; const char* B; int nt, pm, pn, tag; };

struct Sched {
    const char* A; const char* B; size_t a_tile, b_tile; int nM, nN, nt, G, c, a_sh, a_mul;
    __device__ __forceinline__ bool next(int i, Unit& u) const {
        const long L = (long)i * G + c; const int nwg = nM * nN; if (L >= nwg) return false;
        int wgid = (int)L; { const int q = nwg / 8, r = nwg % 8, xcd = wgid % 8, off = wgid / 8; wgid = (xcd < r ? xcd * (q + 1) : r * (q + 1) + (xcd - r) * q) + off; }
        const int nig = 8 * nN, gid = wgid / nig, fm = gid * 8, gsz = (nM - fm) < 8 ? (nM - fm) : 8;
        u.pm = fm + ((wgid % nig) % gsz); u.pn = (wgid % nig) / gsz; u.tag = 0;
        u.A = A + (size_t)u.pm * a_tile + (size_t)((u.pn >> a_sh) * a_mul); u.B = B + (size_t)u.pn * b_tile; u.nt = nt; return true;
    }
};

template <class Epi, class S_t>
__device__ __forceinline__ void gemm_phase(LAS unsigned char* lds, int lda, int ldb, const S_t& S, const Epi& E) {
    int tid = threadIdx.x; asm volatile("" : "+v"(tid));
    const int wid = __builtin_amdgcn_readfirstlane(tid >> 6), lane = tid & 63, wr = wid >> 2, wc = wid & 3, fr = lane & 15, fq = lane >> 4;
    unsigned voffA[2], voffB[2];
#pragma unroll
    for (int i = 0; i < 2; ++i) { int R, C; stage_rc(tid * 16 + i * 8192, R, C); const int Rb = Epi::PERM ? ((R & ~31) + perm32(R & 31)) : R;
        voffA[i] = (unsigned)(R * lda + C) * 2u; voffB[i] = (unsigned)(Rb * ldb + C) * 2u; }
    const size_t kstep = (size_t)(BK * 2);
    const size_t hstepA = (size_t)HALF * lda * 2, hstepB = (size_t)HALF * ldb * 2;
    const unsigned ldsw = (unsigned)wid * 1024u;
    const int aoff = lds_byte(wr * 64 + fr, fq * 8), boff = lds_byte(wc * 32 + fr, fq * 8);
#define PG8_SA(b, h) (((b) * 2 + (h)) * HTB)
#define PG8_SB(b, h) ((4 + (b) * 2 + (h)) * HTB)
#define PG8_STAGE(bufoff, gbase, voff) do { _Pragma("unroll") for (int _i = 0; _i < 2; ++_i) \
        __builtin_amdgcn_global_load_lds((const unsigned*)((const char*)(gbase) + (voff)[_i]), (LAS unsigned*)(lds + (bufoff) + ldsw + _i * 8192), 16, 0, 0); } while (0)
#define PG8_LDA(dst, b, h) do { _Pragma("unroll") for (int m = 0; m < 4; ++m) _Pragma("unroll") for (int k = 0; k < 2; ++k) dst[m][k] = *(const LAS bf16x8*)(lds + PG8_SA(b, h) + aoff + m * 2048 + k * 1024); } while (0)
#define PG8_LDB(dst, b, h) do { _Pragma("unroll") for (int n = 0; n < 2; ++n) _Pragma("unroll") for (int k = 0; k < 2; ++k) dst[n][k] = *(const LAS bf16x8*)(lds + PG8_SB(b, h) + boff + n * 2048 + k * 1024); } while (0)
#define PG8_MMA(ai, bj, At, Bt) do { __builtin_amdgcn_s_setprio(1); _Pragma("unroll") for (int m = 0; m < 4; ++m) _Pragma("unroll") for (int n = 0; n < 2; ++n) _Pragma("unroll") for (int k = 0; k < 2; ++k) \
        acc[ai][bj][m][n] = __builtin_amdgcn_mfma_f32_16x16x32_bf16(Bt[n][k], At[m][k], acc[ai][bj][m][n], 0, 0, 0); __builtin_amdgcn_s_setprio(0); } while (0)
#define PG8_WAIT_V(n) asm volatile("s_waitcnt vmcnt(" #n ")" ::: "memory")
#define PG8_WAIT_L(n) asm volatile("s_waitcnt lgkmcnt(" #n ")" ::: "memory")
#define PG8_BAR __builtin_amdgcn_s_barrier()
#define PG8_SCHED __builtin_amdgcn_sched_barrier(0)
    Unit cur, nxt; int ui = 0;
    if (!S.next(0, cur)) return;
    f32x4 acc[2][2][4][2];
#pragma unroll
    for (int a = 0; a < 2; ++a)
#pragma unroll
        for (int b = 0; b < 2; ++b)
#pragma unroll
            for (int m = 0; m < 4; ++m)
#pragma unroll
                for (int n = 0; n < 2; ++n) acc[a][b][m][n] = (f32x4){0.f, 0.f, 0.f, 0.f};
    bf16x8 At[4][2], B0[2][2], B1[2][2];
    const char* cA = cur.A; const char* cB = cur.B;
    PG8_STAGE(PG8_SB(0, 0), cB, voffB); PG8_STAGE(PG8_SA(0, 0), cA, voffA); PG8_STAGE(PG8_SB(0, 1), cB + hstepB, voffB); PG8_STAGE(PG8_SA(0, 1), cA + hstepA, voffA);
    if (wr == 1) PG8_BAR;
    PG8_WAIT_V(4); PG8_BAR;
    PG8_STAGE(PG8_SB(1, 0), cB + kstep, voffB); PG8_STAGE(PG8_SA(1, 0), cA + kstep, voffA); PG8_STAGE(PG8_SB(1, 1), cB + hstepB + kstep, voffB);
    PG8_WAIT_V(6); PG8_BAR;
    for (;;) {
        const bool has_next = S.next(ui + 1, nxt);
        const char* nA = has_next ? nxt.A : cA; const char* nB = has_next ? nxt.B : cB;
        const int nt = cur.nt;
        for (int t = 0; t < nt; t += 2) {
            const bool last = (t == nt - 2);
            const char* a1 = cA + (size_t)(t + 1) * kstep;
            const char* a2 = last ? nA : cA + (size_t)(t + 2) * kstep; const char* b2 = last ? nB : cB + (size_t)(t + 2) * kstep;
            const char* a3 = a2 + kstep; const char* b3 = b2 + kstep;
            PG8_LDB(B0, 0, 0); PG8_SCHED; PG8_LDA(At, 0, 0); PG8_STAGE(PG8_SA(1, 1), a1 + hstepA, voffA);
            PG8_WAIT_L(8); PG8_BAR; PG8_WAIT_L(0); PG8_MMA(0, 0, At, B0); PG8_BAR; PG8_SCHED;
            PG8_LDB(B1, 0, 1); PG8_STAGE(PG8_SB(0, 0), b2, voffB);
            PG8_BAR; PG8_WAIT_L(0); PG8_MMA(0, 1, At, B1); PG8_BAR;
            PG8_LDA(At, 0, 1); PG8_STAGE(PG8_SA(0, 0), a2, voffA);
            PG8_BAR; PG8_WAIT_L(0); PG8_MMA(1, 0, At, B0); PG8_BAR; PG8_SCHED;
            PG8_STAGE(PG8_SB(0, 1), b2 + hstepB, voffB);
            PG8_WAIT_V(6); PG8_BAR; PG8_MMA(1, 1, At, B1); PG8_BAR;
            PG8_LDB(B0, 1, 0); PG8_SCHED; PG8_LDA(At, 1, 0); PG8_STAGE(PG8_SA(0, 1), a2 + hstepA, voffA);
            PG8_WAIT_L(8); PG8_BAR; PG8_WAIT_L(0); PG8_MMA(0, 0, At, B0); PG8_BAR; PG8_SCHED;
            PG8_LDB(B1, 1, 1); PG8_STAGE(PG8_SB(1, 0), b3, voffB);
            PG8_BAR; PG8_WAIT_L(0); PG8_MMA(0, 1, At, B1); PG8_BAR;
            PG8_LDA(At, 1, 1); PG8_STAGE(PG8_SA(1, 0), a3, voffA);
            PG8_BAR; PG8_WAIT_L(0); PG8_MMA(1, 0, At, B0); PG8_BAR; PG8_SCHED;
            PG8_STAGE(PG8_SB(1, 1), b3 + hstepB, voffB);
            PG8_WAIT_V(6); PG8_BAR; PG8_MMA(1, 1, At, B1); PG8_BAR;
        }
        E(acc, cur, wr, wc, fr, fq);
        if (!has_next) break;
#pragma unroll
        for (int a = 0; a < 2; ++a)
#pragma unroll
            for (int b = 0; b < 2; ++b)
#pragma unroll
                for (int m = 0; m < 4; ++m)
#pragma unroll
                    for (int n = 0; n < 2; ++n) acc[a][b][m][n] = (f32x4){0.f, 0.f, 0.f, 0.f};
        cur = nxt; cA = nA; cB = nB; ++ui;
    }
    PG8_WAIT_V(0);
    if (wr == 0) PG8_BAR;
    PG8_BAR;
#undef PG8_SA
#undef PG8_SB
#undef PG8_STAGE
#undef PG8_LDA
#undef PG8_LDB
#undef PG8_MMA
#undef PG8_WAIT_V
#undef PG8_WAIT_L
#undef PG8_BAR
#undef PG8_SCHED
}

struct EpiF32 {
    static constexpr bool PERM = false;
    float* C; int ldc; const float* bias;
    __device__ __forceinline__ void operator()(const f32x4 (&acc)[2][2][4][2], const Unit& u, int wr, int wc, int fr, int fq) const {
        const int row0 = u.pm * BM + wr * 64 + fr, col0 = u.pn * BM + wc * 32 + 4 * fq;
        f32x4 bv[2][2];
#pragma unroll
        for (int bj = 0; bj < 2; ++bj)
#pragma unroll
            for (int n = 0; n < 2; ++n) bv[bj][n] = bias ? *(const f32x4*)(bias + col0 + bj * HALF + n * 16) : (f32x4){0.f, 0.f, 0.f, 0.f};
#pragma unroll
        for (int ai = 0; ai < 2; ++ai)
#pragma unroll
            for (int m = 0; m < 4; ++m) { float* rowp = C + (size_t)(row0 + ai * HALF + m * 16) * ldc + col0;
#pragma unroll
                for (int bj = 0; bj < 2; ++bj)
#pragma unroll
                    for (int n = 0; n < 2; ++n) *(f32x4*)(rowp + bj * HALF + n * 16) = acc[ai][bj][m][n] + bv[bj][n]; }
    }
};
struct EpiAda {
    static constexpr bool PERM = false;
    float* C; const float* bias; const float* g1; const float* g2; const float* g4; const float* g5;
    __device__ __forceinline__ void operator()(const f32x4 (&acc)[2][2][4][2], const Unit& u, int wr, int wc, int fr, int fq) const {
        const int row0 = wr * 64 + fr, col0 = u.pn * BM + wc * 32 + 4 * fq, kind = u.pn >> 3;
        const float* gm = kind == 2 ? g2 : kind == 4 ? g4 : kind == 5 ? g5 : g1;
        const float one = (kind == 1 || kind == 4) ? 1.0f : 0.0f, gs = (kind == 0 || kind == 3) ? 0.0f : 1.0f;
#pragma unroll
        for (int bj = 0; bj < 2; ++bj)
#pragma unroll
            for (int n = 0; n < 2; ++n) { const int col = col0 + bj * HALF + n * 16;
                const f32x4 bv = *(const f32x4*)(bias + col) + one, gv = *(const f32x4*)(gm + (col & (DM - 1))) * gs + (1.0f - gs);
#pragma unroll
                for (int ai = 0; ai < 2; ++ai)
#pragma unroll
                    for (int m = 0; m < 4; ++m) *(f32x4*)(C + (size_t)(row0 + ai * HALF + m * 16) * NADA + col) = (acc[ai][bj][m][n] + bv) * gv; }
    }
};
struct EpiBf16 {
    static constexpr bool PERM = true;
    bf16_t* O; int ldc; int sig_pn;
    __device__ __forceinline__ void operator()(const f32x4 (&acc)[2][2][4][2], const Unit& u, int wr, int wc, int fr, int fq) const {
        const int row0 = u.pm * BM + wr * 64 + fr, col0 = u.pn * BM + wc * 32 + 8 * fq;
        const bool sg = u.pn >= sig_pn;
#pragma unroll
        for (int ai = 0; ai < 2; ++ai)
#pragma unroll
            for (int m = 0; m < 4; ++m) { bf16_t* rowp = O + (size_t)(row0 + ai * HALF + m * 16) * ldc + col0;
#pragma unroll
                for (int bj = 0; bj < 2; ++bj) { f32x4 v0 = acc[ai][bj][m][0], v1 = acc[ai][bj][m][1];
                    if (sg) {
#pragma unroll
                        for (int j = 0; j < 4; ++j) { v0[j] = sigmoidf_(v0[j]); v1[j] = sigmoidf_(v1[j]); } }
                    u32x4 w; w.x = pk2(v0[0], v0[1]); w.y = pk2(v0[2], v0[3]); w.z = pk2(v1[0], v1[1]); w.w = pk2(v1[2], v1[3]);
                    *(u32x4*)(rowp + bj * HALF) = w; } }
    }
};
struct EpiPool {
    static constexpr bool PERM = true;
    bf16_t* O; const float* scale;
    __device__ __forceinline__ void operator()(const f32x4 (&acc)[2][2][4][2], const Unit& u, int wr, int wc, int fr, int fq) const {
        const int row0 = u.pm * BM + wr * 64 + fr, col0 = u.pn * BM + wc * 32 + 8 * fq;
        f32x4 sv[2][2];
#pragma unroll
        for (int bj = 0; bj < 2; ++bj)
#pragma unroll
            for (int n = 0; n < 2; ++n) sv[bj][n] = *(const f32x4*)(scale + col0 + bj * HALF + 4 * n);
#pragma unroll
        for (int ai = 0; ai < 2; ++ai)
#pragma unroll
            for (int m = 0; m < 4; ++m) { bf16_t* rowp = O + (size_t)(row0 + ai * HALF + m * 16) * PW + col0;
#pragma unroll
                for (int bj = 0; bj < 2; ++bj) { const f32x4 v0 = acc[ai][bj][m][0] * sv[bj][0], v1 = acc[ai][bj][m][1] * sv[bj][1];
                    u32x4 w; w.x = pk2(v0[0], v0[1]); w.y = pk2(v0[2], v0[3]); w.z = pk2(v1[0], v1[1]); w.w = pk2(v1[2], v1[3]);
                    *(u32x4*)(rowp + bj * HALF) = w; } }
    }
};
struct EpiGates {
    static constexpr bool PERM = true;
    const bf16_t* XC; unsigned* LU; const float* brg; const float* big; const float* spl;
    __device__ __forceinline__ void operator()(const f32x4 (&acc)[2][2][4][2], const Unit& u, int wr, int wc, int fr, int fq) const {
        const int row0 = u.pm * BM + wr * 64 + fr, ch0 = u.pn * HALF + wc * 32 + 8 * fq;
        float br[8], bi[8], sp[8];
#pragma unroll
        for (int q = 0; q < 2; ++q) { const f32x4 a = *(const f32x4*)(brg + ch0 + 4 * q), b = *(const f32x4*)(big + ch0 + 4 * q), c = *(const f32x4*)(spl + ch0 + 4 * q);
#pragma unroll
            for (int j = 0; j < 4; ++j) { br[4 * q + j] = a[j]; bi[4 * q + j] = b[j]; sp[4 * q + j] = c[j]; } }
        u32x4 xraw[2][4];
#pragma unroll
        for (int ai = 0; ai < 2; ++ai)
#pragma unroll
            for (int m = 0; m < 4; ++m) xraw[ai][m] = *(const u32x4*)(XC + (size_t)(row0 + ai * HALF + m * 16) * LW + ch0);
        asm volatile("" ::: "memory");
#pragma unroll
        for (int ai = 0; ai < 2; ++ai)
#pragma unroll
            for (int m = 0; m < 4; ++m) { const size_t off = (size_t)(row0 + ai * HALF + m * 16) * LW + ch0;
                float xc[8]; unpack8(xraw[ai][m], xc);
                float la[8], uu[8];
#pragma unroll
                for (int n = 0; n < 2; ++n)
#pragma unroll
                    for (int j = 0; j < 4; ++j) { const int e = 4 * n + j;
                        const float r = sigmoidf_(acc[ai][0][m][n][j] + br[e]), ig = sigmoidf_(acc[ai][1][m][n][j] + bi[e]);
                        const float l = -8.0f * r * sp[e]; la[e] = l;
                        const float x2 = 2.0f * l;
                        const float om = x2 > -0.03125f ? -x2 * (1.0f + x2 * (0.5f + x2 * (0.16666667f + x2 * 0.041666668f))) : 1.0f - __expf(x2);
                        uu[e] = __builtin_amdgcn_sqrtf(om) * (ig * xc[e]); }
                u32x4 w0, w1; w0.x = pk2(la[0], uu[0]); w0.y = pk2(la[1], uu[1]); w0.z = pk2(la[2], uu[2]); w0.w = pk2(la[3], uu[3]);
                w1.x = pk2(la[4], uu[4]); w1.y = pk2(la[5], uu[5]); w1.z = pk2(la[6], uu[6]); w1.w = pk2(la[7], uu[7]);
                *(u32x4*)(LU + off) = w0; *(u32x4*)(LU + off + 4) = w1; }
    }
};
template <bool ADD> struct EpiMerge {
    static constexpr bool PERM = true;
    bf16_t* MG; const bf16_t* Z; int gcol0; unsigned* flags;
    __device__ __forceinline__ void operator()(const f32x4 (&acc)[2][2][4][2], const Unit& u, int wr, int wc, int fr, int fq) const {
        const int row0 = u.pm * BM + wr * 64 + fr, col0 = u.pn * BM + wc * 32 + 8 * fq;
        if (ADD && u.tag >= 2000) {
            unsigned* f = flags + P7_FLAG(u.tag - 2000); unsigned sp = 0;
            while ((unsigned)__builtin_amdgcn_readfirstlane(__hip_atomic_load(f, __ATOMIC_RELAXED, __HIP_MEMORY_SCOPE_AGENT)) < 8u) { __builtin_amdgcn_s_sleep(2); if (++sp > (1u << 20)) break; }
            __builtin_amdgcn_fence(__ATOMIC_ACQUIRE, "agent");
            asm volatile("s_waitcnt vmcnt(0)" ::: "memory");
        }
#pragma unroll
        for (int ai = 0; ai < 2; ++ai) {
            u32x4 gr[4][2], orw[4][2];
            asm volatile("" ::: "memory");
#pragma unroll
            for (int m = 0; m < 4; ++m)
#pragma unroll
                for (int bj = 0; bj < 2; ++bj) { const int row = row0 + ai * HALF + m * 16, col = col0 + bj * HALF;
                    gr[m][bj] = __builtin_nontemporal_load((const u32x4*)(Z + (size_t)row * INW + gcol0 + col));
                    if (ADD) orw[m][bj] = *(const u32x4*)(MG + (size_t)row * DM + col); }
            asm volatile("" ::: "memory");
#pragma unroll
            for (int m = 0; m < 4; ++m)
#pragma unroll
                for (int bj = 0; bj < 2; ++bj) { const int row = row0 + ai * HALF + m * 16, col = col0 + bj * HALF;
                    float g[8], o[8]; unpack8(gr[m][bj], g);
                    if (ADD) unpack8(orw[m][bj], o);
#pragma unroll
                    for (int n = 0; n < 2; ++n)
#pragma unroll
                        for (int j = 0; j < 4; ++j) { const int e = 4 * n + j; o[e] = ADD ? o[e] + g[e] * acc[ai][bj][m][n][j] : g[e] * acc[ai][bj][m][n][j]; }
                    *(u32x4*)(MG + (size_t)row * DM + col) = pack8(o); }
        }
        if (!ADD && u.tag >= 1000) {
            asm volatile("s_waitcnt vmcnt(0)" ::: "memory");
            __builtin_amdgcn_fence(__ATOMIC_RELEASE, "agent");
            asm volatile("s_waitcnt vmcnt(0)" ::: "memory");
            if ((threadIdx.x & 63) == 0) __hip_atomic_fetch_add(flags + P7_FLAG(u.tag - 1000), 1u, __ATOMIC_RELAXED, __HIP_MEMORY_SCOPE_AGENT);
        }
    }
};
struct SchedSplit {
    Sched base; int ntp, kz_lo, kz_hi, mode;
    __device__ __forceinline__ bool next(int i, Unit& u) const {
        if (i == 0) return base.next(0, u);
        if (i > 1) return false;
        const int tile = base.c >> 3, kz = base.c & 7;
        if (kz < kz_lo || kz >= kz_hi) return false;
        const int k = kz - kz_lo; int koff, nt;
        if (mode == 0) { koff = k * ntp; nt = ntp; } else { koff = k < 4 ? 6 * k : 24 + 4 * (k - 4); nt = k < 4 ? 6 : 4; }
        u.pm = 32 + (tile >> 3); u.pn = tile & 7; u.tag = 1 + kz; u.nt = nt;
        u.A = base.A + (size_t)u.pm * base.a_tile + (size_t)koff * 128; u.B = base.B + (size_t)u.pn * base.b_tile + (size_t)koff * 128; return true;
    }
};
struct SchedP7 {
    Sched base; int lo, tg;
    __device__ __forceinline__ bool next(int i, Unit& u) const {
        if (i == 0) return base.next(0, u);
        const int t = base.c - lo;
        if (i > 1 || t < 0 || t >= 32) return false;
        u.pm = 32 + (t >> 3); u.pn = t & 7; u.tag = tg + t; u.nt = base.nt;
        u.A = base.A + (size_t)u.pm * base.a_tile; u.B = base.B + (size_t)u.pn * base.b_tile; return true;
    }
};
struct EpiOut {
    static constexpr bool PERM = true;
    bf16_t* Ob; float* Os;
    __device__ __forceinline__ void operator()(const f32x4 (&acc)[2][2][4][2], const Unit& u, int wr, int wc, int fr, int fq) const {
        const int col0 = u.pn * BM + wc * 32 + 8 * fq;
        if (u.tag == 0) {
            const int row0 = u.pm * BM + wr * 64 + fr;
#pragma unroll
            for (int ai = 0; ai < 2; ++ai)
#pragma unroll
                for (int m = 0; m < 4; ++m) { bf16_t* rowp = Ob + (size_t)(row0 + ai * HALF + m * 16) * DM + col0;
#pragma unroll
                    for (int bj = 0; bj < 2; ++bj) { const f32x4 v0 = acc[ai][bj][m][0], v1 = acc[ai][bj][m][1];
                        u32x4 w; w.x = pk2(v0[0], v0[1]); w.y = pk2(v0[2], v0[3]); w.z = pk2(v1[0], v1[1]); w.w = pk2(v1[2], v1[3]);
                        *(u32x4*)(rowp + bj * HALF) = w; } }
        } else {
            const int row0 = (u.pm - 32) * BM + wr * 64 + fr;
            float* Op = Os + (size_t)(u.tag - 1) * (1024ull * DM);
#pragma unroll
            for (int ai = 0; ai < 2; ++ai)
#pragma unroll
                for (int m = 0; m < 4; ++m) { float* rowp = Op + (size_t)(row0 + ai * HALF + m * 16) * DM + col0;
#pragma unroll
                    for (int bj = 0; bj < 2; ++bj)
#pragma unroll
                        for (int n = 0; n < 2; ++n) *(f32x4*)(rowp + bj * HALF + 4 * n) = acc[ai][bj][m][n]; }
        }
    }
};
__device__ __forceinline__ float dpp_shr1(float old, float src) { return __int_as_float(__builtin_amdgcn_update_dpp(__float_as_int(old), __float_as_int(src), 0x111, 0xf, 0xf, false)); }
__device__ __forceinline__ float dpp_shr2(float old, float src) { return __int_as_float(__builtin_amdgcn_update_dpp(__float_as_int(old), __float_as_int(src), 0x112, 0xf, 0xf, false)); }
__device__ __forceinline__ float dpp_ror1(float src) { return __int_as_float(__builtin_amdgcn_update_dpp(0, __float_as_int(src), 0x121, 0xf, 0xf, false)); }
__device__ __forceinline__ float dpp_ror2(float src) { return __int_as_float(__builtin_amdgcn_update_dpp(0, __float_as_int(src), 0x122, 0xf, 0xf, false)); }
struct EpiUpFused {
    static constexpr bool PERM = true;
    bf16_t* UP; bf16_t* F; bf16_t* UPB; const float* wconv; const float* bconv;
    __device__ __forceinline__ void operator()(const f32x4 (&acc)[2][2][4][2], const Unit& u, int wr, int wc, int fr, int fq) const {
        const int row0 = u.pm * BM + wr * 64 + fr, col0 = u.pn * BM + wc * 32 + 8 * fq;
        if (u.pm >= 32) {
#pragma unroll
            for (int ai = 0; ai < 2; ++ai)
#pragma unroll
                for (int m = 0; m < 4; ++m) { bf16_t* rowp = UP + (size_t)(row0 + ai * HALF + m * 16) * (2 * DFF) + col0;
#pragma unroll
                    for (int bj = 0; bj < 2; ++bj) { const f32x4 v0 = acc[ai][bj][m][0], v1 = acc[ai][bj][m][1];
                        u32x4 w; w.x = pk2(v0[0], v0[1]); w.y = pk2(v0[2], v0[3]); w.z = pk2(v1[0], v1[1]); w.w = pk2(v1[2], v1[3]);
                        *(u32x4*)(rowp + bj * HALF) = w; } }
            return;
        }
        const int j0 = u.pn * HALF + wc * 32 + 8 * fq;
        u32x2 res0[8];
#pragma unroll
        for (int n = 0; n < 2; ++n) {
            asm volatile("" ::: "memory");
            const int jc = j0 + 4 * n;
            const f32x4 wg0 = *(const f32x4*)(wconv + jc), wg1 = *(const f32x4*)(wconv + 2 * DFF + jc), wg2 = *(const f32x4*)(wconv + 4 * DFF + jc), bg = *(const f32x4*)(bconv + jc);
            const f32x4 wv0 = *(const f32x4*)(wconv + DFF + jc), wv1 = *(const f32x4*)(wconv + 3 * DFF + jc), wv2 = *(const f32x4*)(wconv + 5 * DFF + jc), bv = *(const f32x4*)(bconv + DFF + jc);
#pragma unroll
            for (int ai = 0; ai < 2; ++ai)
#pragma unroll
                for (int m = 0; m < 4; ++m) { const int row = row0 + ai * HALF + m * 16;
                    const f32x4 g0 = acc[ai][0][m][n], v0 = acc[ai][1][m][n];
                    f32x4 gp = (f32x4){0.f, 0.f, 0.f, 0.f}, vp = gp;
                    if (m > 0) { gp = acc[ai][0][m > 0 ? m - 1 : 0][n]; vp = acc[ai][1][m > 0 ? m - 1 : 0][n]; }
                    f32x4 f;
#pragma unroll
                    for (int j = 0; j < 4; ++j) {
                        const float g1 = dpp_shr1(dpp_ror1(gp[j]), g0[j]), g2 = dpp_shr2(dpp_ror2(gp[j]), g0[j]);
                        const float v1 = dpp_shr1(dpp_ror1(vp[j]), v0[j]), v2 = dpp_shr2(dpp_ror2(vp[j]), v0[j]);
                        const float cg_ = bg[j] + g2 * wg0[j] + g1 * wg1[j] + g0[j] * wg2[j];
                        const float cv_ = bv[j] + v2 * wv0[j] + v1 * wv1[j] + v0[j] * wv2[j];
                        f[j] = gelu_tanh(cg_) * cv_; }
                    u32x2 w; w.x = pk2(f[0], f[1]); w.y = pk2(f[2], f[3]);
                    if (n == 0) res0[ai * 4 + m] = w;
                    else if (m > 0 || fr >= 2) { u32x4 w4; w4.x = res0[ai * 4 + m].x; w4.y = res0[ai * 4 + m].y; w4.z = w.x; w4.w = w.y; *(u32x4*)(F + (size_t)row * DFF + j0) = w4; }
                    if (n == 1 && ((m == 0 && fr < 2) || (m == 3 && fr >= 14))) { const int slot = m == 0 ? fr : fr - 12;
                        const f32x4 ga = acc[ai][0][m][0], va = acc[ai][1][m][0];
                        bf16_t* bp = UPB + ((size_t)(row >> 6) * 4 + slot) * (2 * DFF) + col0;
                        u32x4 wg_, wv_; wg_.x = pk2(ga[0], ga[1]); wg_.y = pk2(ga[2], ga[3]); wg_.z = pk2(g0[0], g0[1]); wg_.w = pk2(g0[2], g0[3]);
                        wv_.x = pk2(va[0], va[1]); wv_.y = pk2(va[2], va[3]); wv_.z = pk2(v0[0], v0[1]); wv_.w = pk2(v0[2], v0[3]);
                        *(u32x4*)bp = wg_; *(u32x4*)(bp + HALF) = wv_; } }
        }
    }
};
}

__device__ __forceinline__ void cvt_item(const float* __restrict__ W, int N, bf16_t* WT, int K, int k0, int n0, int drow0, LAS float* scr, int lane) {
    float v[64];
#pragma unroll
    for (int kk = 0; kk < 64; ++kk) v[kk] = __builtin_nontemporal_load(W + (size_t)(k0 + kk) * N + n0 + lane);
#pragma unroll
    for (int kk = 0; kk < 64; ++kk) scr[kk * 65 + lane] = v[kk];
    asm volatile("s_waitcnt lgkmcnt(0)" ::: "memory");
    const int c = lane & 7;
#pragma unroll
    for (int j = 0; j < 8; ++j) { const int n = (lane >> 3) + 8 * j; const LAS float* s = scr + (8 * c) * 65 + n;
        u32x4 o; o.x = pk2(s[0 * 65], s[1 * 65]); o.y = pk2(s[2 * 65], s[3 * 65]); o.z = pk2(s[4 * 65], s[5 * 65]); o.w = pk2(s[6 * 65], s[7 * 65]);
        *(u32x4*)(WT + (size_t)(drow0 + n) * K + k0 + 8 * c) = o; }
    asm volatile("s_waitcnt lgkmcnt(0)" ::: "memory");
}

template <int PART> __device__ __forceinline__ void phase0(const Params& p, LAS unsigned char* lds) {
    constexpr int SKIP = PART == 0 ? 0 : PART == 1 ? 48 : 192;
    const int tid = threadIdx.x, lane = tid & 63, wave = tid >> 6;
    const int gw = ((int)blockIdx.x - SKIP) * NWAVES + wave, NGW = ((int)gridDim.x - SKIP) * NWAVES;
    if (gw < 0) return;
    const int gt = blockIdx.x * NTHREADS + tid, NGT = gridDim.x * NTHREADS;
    unsigned char* ws = p.ws;
    LAS float* scr = (LAS float*)(lds + wave * 16640);
    constexpr int I0 = 32 * 192, I1 = 32 * 112, I2 = 32 * 192, I3 = 96 * 32, I4 = 32 * 32, I5 = 32 * 32, I6 = 16 * 32, I7 = 64, I8 = 128, I9 = 128;
    constexpr int NIT = I0 + I1 + I2 + I3 + I4 + I5 + I6 + I7 + I8 + I9;
    constexpr int U0 = I0 + I1, U1 = U0 + I2 / 2, D0 = I0 + I1 + I2, D1 = D0 + I3;
    constexpr int CUT = (U1 - U0) + I3;
    constexpr int LO = PART == 0 ? 0 : PART == 1 ? I0 : PART == 2 ? U0 : D0, HI = PART == 0 ? I0 : PART == 1 ? NIT - CUT : PART == 2 ? U1 : D1;
    for (int it0 = LO + gw; it0 < HI; it0 += NGW) {
        int it = it0;
        if (PART == 1) { if (it >= U0) it += U1 - U0; if (it >= D0) it += I3; }
        int r = it;
        if (r < I0) { const int nb = r % 192, kb = r / 192; cvt_item(p.in[I_WADA], NADA, (bf16_t*)(ws + WS_WADA), DM, 64 * kb, 64 * nb, 64 * nb, scr, lane); continue; } r -= I0;
        if (r < I1) { const int nb = r % 112, kb = r / 112; cvt_item(p.in[I_WIN], INW, (bf16_t*)(ws + WS_WIN), DM, 64 * kb, 64 * nb, 64 * nb, scr, lane); continue; } r -= I1;
        if (r < I2) { const int nb = r % 192, kb = r / 192; const int n0 = 64 * nb; const int j0 = n0 < DFF ? n0 : n0 - DFF;
            const int drow = (j0 >> 7) * 256 + (n0 < DFF ? 0 : 128) + (j0 & 127);
            cvt_item(p.in[I_WUP], 2 * DFF, (bf16_t*)(ws + WS_WUP), DM, 64 * kb, n0, drow, scr, lane); continue; } r -= I2;
        if (r < I3) { const int nb = r % 32, kb = r / 32; cvt_item(p.in[I_WDOWN], DM, (bf16_t*)(ws + WS_WDOWN), DFF, 64 * kb, 64 * nb, 64 * nb, scr, lane); continue; } r -= I3;
        if (r < I4) { const int nb = r % 32, kb = r / 32; cvt_item(p.in[I_WOUT], DM, (bf16_t*)(ws + WS_WOUT), DM, 64 * kb, 64 * nb, 64 * nb, scr, lane); continue; } r -= I4;
        if (r < I5) { const int nb = r % 32, kb = r / 32; cvt_item(p.in[I_WLU], DM, (bf16_t*)(ws + WS_WLU), LW, 64 * kb, 64 * nb, 64 * nb, scr, lane); continue; } r -= I5;
        if (r < I6) { const int nb = r % 32, kb = r / 32; cvt_item(p.in[I_WPU], DM, (bf16_t*)(ws + WS_WPU), PW, 64 * kb, 64 * nb, 64 * nb, scr, lane); continue; } r -= I6;
        if (r < I7) { const int g = r >> 4, q = r & 15, kb = q >> 2, nb = q & 3;
            cvt_item(p.in[I_WGRP] + (size_t)g * 65536, 256, (bf16_t*)(ws + WS_WGRP) + (size_t)g * 65536, 256, 64 * kb, 64 * nb, 64 * nb, scr, lane); continue; } r -= I7;
        { const bool isig = r >= I8; if (isig) r -= I8;
          const int blk = r >> 4, q = r & 15, kb = q >> 2, nb = q & 3, n0 = 64 * nb;
          const int drow = (blk * 2 + (n0 >> 7)) * 256 + (isig ? 128 : 0) + (n0 & 127);
          cvt_item(p.in[isig ? I_WIG : I_WRG] + (size_t)blk * 65536, 256, (bf16_t*)(ws + WS_WGATE), 256, 64 * kb, n0, drow, scr, lane); }
    }
    if (PART != 0) return;
    bf16_t* sada = (bf16_t*)(ws + WS_SADA);
    for (int i = gt; i < 256 * DM; i += NGT) { const int r = i >> 11, k = i & 2047;
        float v = 0.f; if (r < 4) v = p.in[I_CP][r * DM + k]; else if (r < NSEQ) v = p.in[I_CS][(r - 4) * DM + k];
        const float s = v * sigmoidf_(v);
        sada[i] = (bf16_t)(pk2(s, s) & 0xffffu); }
    float* spl = (float*)(ws + WS_CTL);
    for (int i = gt; i < LW; i += NGT) spl[i] = log1pf(expf(-p.in[I_LAM][i]));
}

__device__ __forceinline__ const float* xrow_ptr(const Params& p, int row) { return row < MPROMPT ? p.in[I_XP] + (size_t)row * DM : p.in[I_XS] + (size_t)(row - MPROMPT) * DM; }

__device__ __forceinline__ void norm1_row(const Params& p, const f32x4 (&v)[8], const f32x4 (&sc)[8], const f32x4 (&sh)[8], int row, int lane) {
    bf16_t* H = (bf16_t*)(p.ws + WS_H);
    float ss = 0.f;
#pragma unroll
    for (int j = 0; j < 8; ++j) ss += (v[j].x * v[j].x + v[j].y * v[j].y) + (v[j].z * v[j].z + v[j].w * v[j].w);
    const float rstd = 1.0f / sqrtf(wave_sum(ss) * (1.0f / DM) + EPS);
#pragma unroll
    for (int j = 0; j < 8; ++j) { const int col = 4 * lane + 256 * j;
        const f32x4 h = v[j] * rstd * sc[j] + sh[j];
        u32x2 w; w.x = pk2(h.x, h.y); w.y = pk2(h.z, h.w);
        *(u32x2*)(H + (size_t)row * DM + col) = w; }
}
__device__ __forceinline__ void phase_norm1(const Params& p) {
    const int tid = threadIdx.x, lane = tid & 63, wave = tid >> 6;
    const int gw = blockIdx.x * NWAVES + wave, NGW = gridDim.x * NWAVES;
    const float* ada = (const float*)(p.ws + WS_ADA);
    f32x4 v[8], vn[8];
    if (gw < MPROMPT) { const f32x4* xr = (const f32x4*)(p.in[I_XP] + (size_t)gw * DM) + lane;
#pragma unroll
        for (int j = 0; j < 8; ++j) v[j] = __builtin_nontemporal_load(xr + 64 * j); }
    for (int row = gw; row < MPROMPT; row += NGW) {
        const float* ar = ada + (size_t)(row >> 11) * NADA;
        f32x4 sc[8], sh[8];
#pragma unroll
        for (int j = 0; j < 8; ++j) { const int col = 4 * lane + 256 * j; sc[j] = *(const f32x4*)(ar + DM + col); sh[j] = *(const f32x4*)(ar + col); }
        if (row + NGW < MPROMPT) { const f32x4* xr = (const f32x4*)(p.in[I_XP] + (size_t)(row + NGW) * DM) + lane;
#pragma unroll
            for (int j = 0; j < 8; ++j) vn[j] = __builtin_nontemporal_load(xr + 64 * j); }
        norm1_row(p, v, sc, sh, row, lane);
#pragma unroll
        for (int j = 0; j < 8; ++j) v[j] = vn[j];
    }
    for (int row = MPROMPT + (gw >> 1); (gw & 1) == 0 && row < MTOK; row += (NGW >> 1)) {
        const float* ar = ada + (size_t)seq_of_row(row) * NADA; const f32x4* xr = (const f32x4*)xrow_ptr(p, row) + lane;
        f32x4 x[8], sc[8], sh[8];
#pragma unroll
        for (int j = 0; j < 8; ++j) { const int col = 4 * lane + 256 * j; x[j] = __builtin_nontemporal_load(xr + 64 * j); sc[j] = *(const f32x4*)(ar + DM + col); sh[j] = *(const f32x4*)(ar + col); }
        norm1_row(p, x, sc, sh, row, lane);
    }
}

__device__ __forceinline__ void ld8f(const float* p, float (&x)[8]) { const f32x4 a = *(const f32x4*)p, c = *(const f32x4*)(p + 4); x[0] = a.x; x[1] = a.y; x[2] = a.z; x[3] = a.w; x[4] = c.x; x[5] = c.y; x[6] = c.z; x[7] = c.w; }
template <int W> __device__ __forceinline__ void pool_run(const bf16_t* zp, bf16_t* dp, int t0) {
    u32x2 raw[15 + W];
#pragma unroll
    for (int i = 0; i < 15 + W; ++i) { const int rr = i - (W - 1); raw[i] = (u32x2){0u, 0u}; if (t0 + rr >= 0) raw[i] = *(const u32x2*)(zp + (ptrdiff_t)rr * INW); }
    float s[4] = {0.f, 0.f, 0.f, 0.f};
#pragma unroll
    for (int i = 0; i < W - 1; ++i) { s[0] += bflo(raw[i].x); s[1] += bfhi(raw[i].x); s[2] += bflo(raw[i].y); s[3] += bfhi(raw[i].y); }
#pragma unroll
    for (int i = 0; i < 16; ++i) { const u32x2 cu = raw[i + W - 1]; const float u0 = bflo(cu.x), u1 = bfhi(cu.x), u2 = bflo(cu.y), u3 = bfhi(cu.y);
        s[0] += u0; s[1] += u1; s[2] += u2; s[3] += u3;
        const int t = t0 + i; const float inv = 1.0f / (float)((t + 1) < W ? (t + 1) : W);
        u32x2 o; o.x = pk2(s[0] * inv - u0, s[1] * inv - u1); o.y = pk2(s[2] * inv - u2, s[3] * inv - u3);
        *(u32x2*)(dp + (size_t)i * PW) = o;
        const u32x2 od = raw[i]; s[0] -= bflo(od.x); s[1] -= bfhi(od.x); s[2] -= bflo(od.y); s[3] -= bfhi(od.y); }
}
__device__ __forceinline__ void phase_mixprep(const Params& p) {
    const int gt = blockIdx.x * NTHREADS + threadIdx.x, NGT = gridDim.x * NTHREADS;
    const bf16_t* Z = (const bf16_t*)(p.ws + WS_Z); bf16_t* Dp = (bf16_t*)(p.ws + WS_DP); bf16_t* XC = (bf16_t*)(p.ws + WS_XC);
    for (int it = gt; it < (MPROMPT / 16) * 256; it += NGT) {
        const int c4 = it & 255, run = it >> 8, ch0 = 4 * c4, g = ch0 >> 8, r0 = run * 16, t0 = r0 & (SEQ - 1);
        const bf16_t* zp = Z + (size_t)r0 * INW + ch0;
        switch (g) { case 0: pool_run<2>(zp, Dp + (size_t)r0 * PW + ch0, t0); break; case 1: pool_run<4>(zp, Dp + (size_t)r0 * PW + ch0, t0); break;
                     case 2: pool_run<8>(zp, Dp + (size_t)r0 * PW + ch0, t0); break; default: pool_run<16>(zp, Dp + (size_t)r0 * PW + ch0, t0); break; }
    }
    for (int it = gt; it < 1024 * 128; it += NGT) {
        const int row = MPROMPT + (it >> 7), ch0 = (it & 127) * 8, g = ch0 >> 8, w = 2 << g;
        const int b = (row - MPROMPT) >> 3, t = (row - MPROMPT) & 7;
        u32x4 zr[8]; f32x4 sa[15], sb[15];
#pragma unroll
        for (int j = 0; j < 8; ++j) { zr[j] = (u32x4){0u, 0u, 0u, 0u}; if (j <= t && j < w) zr[j] = *(const u32x4*)(Z + (size_t)(row - j) * INW + ch0); }
#pragma unroll
        for (int k = 0; k < 15; ++k) { const int j = t + 15 - k;
            sa[k] = (f32x4){0.f, 0.f, 0.f, 0.f}; sb[k] = sa[k];
            if (j < w) { const float* sp = p.in[I_SPOOL] + ((size_t)b * 15 + k) * PW + ch0; sa[k] = *(const f32x4*)sp; sb[k] = *(const f32x4*)(sp + 4); } }
        float s[8], u[8]; unpack8(zr[0], u);
#pragma unroll
        for (int e = 0; e < 8; ++e) s[e] = u[e];
#pragma unroll
        for (int j = 1; j < 8; ++j) { float x[8]; unpack8(zr[j], x);
#pragma unroll
            for (int e = 0; e < 8; ++e) s[e] += x[e]; }
#pragma unroll
        for (int k = 0; k < 15; ++k) { s[0] += sa[k].x; s[1] += sa[k].y; s[2] += sa[k].z; s[3] += sa[k].w; s[4] += sb[k].x; s[5] += sb[k].y; s[6] += sb[k].z; s[7] += sb[k].w; }
        const float inv = 1.0f / (float)w; float d[8];
#pragma unroll
        for (int e = 0; e < 8; ++e) d[e] = s[e] * inv - u[e];
        *(u32x4*)(Dp + (size_t)row * PW + ch0) = pack8(d);
    }
    for (int it = gt; it < (MPROMPT / 8) * 256; it += NGT) {
        const int c8 = it & 255, run = it >> 8, ch0 = 8 * c8, r0 = run * 8, t0 = r0 & (SEQ - 1);
        u32x4 raw[11];
#pragma unroll
        for (int i = 0; i < 11; ++i) { const int tt = t0 - 3 + i; raw[i] = (u32x4){0u, 0u, 0u, 0u}; if (tt >= 0) raw[i] = *(const u32x4*)(Z + (size_t)(r0 - 3 + i) * INW + PW + ch0); }
        float wk[4][8], bb[8];
#pragma unroll
        for (int k = 0; k < 4; ++k) ld8f(p.in[I_WLCONV] + (size_t)k * LW + ch0, wk[k]);
        ld8f(p.in[I_BLCONV] + ch0, bb);
        float x0[8], x1[8], x2[8], x3[8];
        unpack8(raw[0], x0); unpack8(raw[1], x1); unpack8(raw[2], x2);
#pragma unroll
        for (int i = 0; i < 8; ++i) { unpack8(raw[3 + i], x3); float o[8];
#pragma unroll
            for (int e = 0; e < 8; ++e) { o[e] = bb[e] + x0[e] * wk[0][e] + x1[e] * wk[1][e] + x2[e] * wk[2][e] + x3[e] * wk[3][e]; x0[e] = x1[e]; x1[e] = x2[e]; x2[e] = x3[e]; }
            *(u32x4*)(XC + (size_t)(r0 + i) * LW + ch0) = pack8(o); }
    }
    for (int it = gt; it < 1024 * 256; it += NGT) {
        const int row = MPROMPT + (it >> 8), ch0 = (it & 255) * 8;
        float acc[8]; ld8f(p.in[I_BLCONV] + ch0, acc);
        const int t = (row - MPROMPT) & 7, b = (row - MPROMPT) >> 3;
#pragma unroll
        for (int k = 0; k < 4; ++k) { const int tt = t - 3 + k; float x[8];
            if (tt >= 0) unpack8(*(const u32x4*)(Z + (size_t)(row - 3 + k) * INW + PW + ch0), x);
            else ld8f(p.in[I_SLCONV] + ((size_t)b * 3 + (3 + tt)) * LW + ch0, x);
            float wv[8]; ld8f(p.in[I_WLCONV] + (size_t)k * LW + ch0, wv);
#pragma unroll
            for (int e = 0; e < 8; ++e) acc[e] += x[e] * wv[e]; }
        *(u32x4*)(XC + (size_t)row * LW + ch0) = pack8(acc);
    }
    float* out = p.out;
    for (int i = gt; i < 4 * 15 * PW / 8; i += NGT) { const int ch = (i & 127) * 8, q = i >> 7, b = q / 15, r = q % 15;
        float x[8]; unpack8(*(const u32x4*)(Z + (size_t)(b * SEQ + SEQ - 15 + r) * INW + ch), x);
        float* o = out + O_POOLP + (size_t)q * PW + ch; *(f32x4*)o = (f32x4){x[0], x[1], x[2], x[3]}; *(f32x4*)(o + 4) = (f32x4){x[4], x[5], x[6], x[7]}; }
    for (int i = gt; i < 128 * 15 * PW / 8; i += NGT) { const int ch = (i & 127) * 8, q = i >> 7, b = q / 15, r = q % 15;
        float x[8];
        if (r < 7) ld8f(p.in[I_SPOOL] + ((size_t)b * 15 + 8 + r) * PW + ch, x); else unpack8(*(const u32x4*)(Z + (size_t)(MPROMPT + b * 8 + r - 7) * INW + ch), x);
        float* o = out + O_POOLS + (size_t)q * PW + ch; *(f32x4*)o = (f32x4){x[0], x[1], x[2], x[3]}; *(f32x4*)(o + 4) = (f32x4){x[4], x[5], x[6], x[7]}; }
    for (int i = gt; i < 4 * 3 * LW / 8; i += NGT) { const int ch = (i & 255) * 8, q = i >> 8, b = q / 3, r = q % 3;
        float x[8]; unpack8(*(const u32x4*)(Z + (size_t)(b * SEQ + SEQ - 3 + r) * INW + PW + ch), x);
        float* o = out + O_LCONVP + (size_t)q * LW + ch; *(f32x4*)o = (f32x4){x[0], x[1], x[2], x[3]}; *(f32x4*)(o + 4) = (f32x4){x[4], x[5], x[6], x[7]}; }
    for (int i = gt; i < 128 * 3 * LW / 8; i += NGT) { const int ch = (i & 255) * 8, q = i >> 8, b = q / 3, r = q % 3;
        float x[8]; unpack8(*(const u32x4*)(Z + (size_t)(MPROMPT + b * 8 + 5 + r) * INW + PW + ch), x);
        float* o = out + O_LCONVS + (size_t)q * LW + ch; *(f32x4*)o = (f32x4){x[0], x[1], x[2], x[3]}; *(f32x4*)(o + 4) = (f32x4){x[4], x[5], x[6], x[7]}; }
}

__device__ __forceinline__ void phase_scan(const Params& p, LAS unsigned char* lds) {
    const int tid = threadIdx.x;
    const unsigned* LU = (const unsigned*)(p.ws + WS_LA); bf16_t* YL = (bf16_t*)(p.ws + WS_YL);
    LAS float* sA = (LAS float*)lds; LAS float* sH = sA + 512;
    for (int item = blockIdx.x; item < 256; item += gridDim.x) {
        const int b = item >> 6, c32 = tid & 31, ch = (item & 63) * 32 + c32, chunk = tid >> 5;
        const size_t base = (size_t)(b * SEQ + chunk * 128) * LW + ch;
        float h = 0.f, sla = 0.f;
#pragma unroll 8
        for (int s = 0; s < 128; ++s) { const unsigned lw = LU[base + (size_t)s * LW]; const float la = bflo(lw), u = bfhi(lw); h = __expf(la) * h + u; sla += la; }
        sA[chunk * 32 + c32] = __expf(sla); sH[chunk * 32 + c32] = h;
        __syncthreads();
        float hin = 0.f;
        for (int j = 0; j < chunk; ++j) hin = sA[j * 32 + c32] * hin + sH[j * 32 + c32];
        h = hin;
#pragma unroll 8
        for (int s = 0; s < 128; ++s) { const unsigned lw = LU[base + (size_t)s * LW]; const float la = bflo(lw), u = bfhi(lw); h = __expf(la) * h + u;
            YL[base + (size_t)s * LW] = (bf16_t)(pk2(h, h) & 0xffffu); }
        if (chunk == 15) p.out[O_LHP + b * LW + ch] = h;
        __syncthreads();
    }
    const int gt = blockIdx.x * NTHREADS + tid, NGT = gridDim.x * NTHREADS;
    for (int i = gt; i < 128 * LW; i += NGT) { const int b = i >> 11, ch = i & 2047;
        float h = p.in[I_SLH][i]; const size_t base = (size_t)(MPROMPT + b * 8) * LW + ch;
#pragma unroll
        for (int s = 0; s < 8; ++s) { const unsigned lw = LU[base + (size_t)s * LW]; const float la = bflo(lw), u = bfhi(lw); h = __expf(la) * h + u;
            YL[base + (size_t)s * LW] = (bf16_t)(pk2(h, h) & 0xffffu); }
        p.out[O_LHS + i] = h; }
}

__device__ __forceinline__ void load_mo_row(f32x4 (&v)[8], const bf16_t* Ob, const float* Os, int row, int lane) {
    if (row < MPROMPT) { const u32x2* mr = (const u32x2*)(Ob + (size_t)row * DM) + lane;
#pragma unroll
        for (int j = 0; j < 8; ++j) { const u32x2 w = __builtin_nontemporal_load(mr + 64 * j); v[j] = (f32x4){bflo(w.x), bfhi(w.x), bflo(w.y), bfhi(w.y)}; } }
    else { const f32x4* mr = (const f32x4*)(Os + (size_t)(row - MPROMPT) * DM) + lane;
#pragma unroll
        for (int j = 0; j < 8; ++j) v[j] = __builtin_nontemporal_load(mr + 64 * j);
#pragma unroll 1
        for (int k0 = 1; k0 < 8; k0 += 4) { f32x4 t[4][8];
#pragma unroll
            for (int q = 0; q < 4; ++q)
#pragma unroll
                for (int j = 0; j < 8; ++j) t[q][j] = (k0 + q < 8) ? mr[(size_t)(k0 + q) * (1024 * DM / 4) + 64 * j] : (f32x4){0.f, 0.f, 0.f, 0.f};
#pragma unroll
            for (int q = 0; q < 4; ++q)
#pragma unroll
                for (int j = 0; j < 8; ++j) v[j] += t[q][j]; } }
}
__device__ __forceinline__ void mid_row(const Params& p, const f32x4 (&x)[8], f32x4 (&v)[8], const f32x4 (&G1)[8], const f32x4 (&S2)[8], const f32x4 (&sh2)[8], int row, int lane) {
    bf16_t* H = (bf16_t*)(p.ws + WS_H2);
    float ss = 0.f;
#pragma unroll
    for (int j = 0; j < 8; ++j) ss += (v[j].x * v[j].x + v[j].y * v[j].y) + (v[j].z * v[j].z + v[j].w * v[j].w);
    const float rstd = 1.0f / sqrtf(wave_sum(ss) * (1.0f / DM) + EPS);
    float ss2 = 0.f;
#pragma unroll
    for (int j = 0; j < 8; ++j) { const int col = 4 * lane + 256 * j;
        v[j] = x[j] + G1[j] * (v[j] * rstd);
        __builtin_nontemporal_store(v[j], (f32x4*)(p.out + (size_t)row * DM + col));
        ss2 += (v[j].x * v[j].x + v[j].y * v[j].y) + (v[j].z * v[j].z + v[j].w * v[j].w); }
    const float rstd2 = 1.0f / sqrtf(wave_sum(ss2) * (1.0f / DM) + EPS);
#pragma unroll
    for (int j = 0; j < 8; ++j) { const int col = 4 * lane + 256 * j;
        const f32x4 h = v[j] * rstd2 * S2[j] + sh2[j];
        u32x2 w; w.x = pk2(h.x, h.y); w.y = pk2(h.z, h.w);
        *(u32x2*)(H + (size_t)row * DM + col) = w; }
}
__device__ __forceinline__ void phase_mid(const Params& p) {
    const int tid = threadIdx.x, lane = tid & 63, wave = tid >> 6;
    const int gw = blockIdx.x * NWAVES + wave, NGW = gridDim.x * NWAVES;
    const float* ada = (const float*)(p.ws + WS_ADA);
    const bf16_t* Ob = (const bf16_t*)(p.ws + WS_MO); const float* Os = (const float*)(p.ws + WS_MOS);
    {
        f32x4 x[8], xn[8]; u32x2 mb[8], mbn[8];
        if (gw < MPROMPT) { const f32x4* xr = (const f32x4*)(p.in[I_XP] + (size_t)gw * DM) + lane; const u32x2* mr = (const u32x2*)(Ob + (size_t)gw * DM) + lane;
#pragma unroll
            for (int j = 0; j < 8; ++j) { x[j] = __builtin_nontemporal_load(xr + 64 * j); mb[j] = __builtin_nontemporal_load(mr + 64 * j); } }
        for (int row = gw; row < MPROMPT; row += NGW) {
            const float* ar = ada + (size_t)(row >> 11) * NADA;
            f32x4 G1[8], S2[8], sh2[8];
#pragma unroll
            for (int j = 0; j < 8; ++j) { const int col = 4 * lane + 256 * j; G1[j] = *(const f32x4*)(ar + 2 * DM + col); }
            if (row + NGW < MPROMPT) { const f32x4* xr = (const f32x4*)(p.in[I_XP] + (size_t)(row + NGW) * DM) + lane; const u32x2* mr = (const u32x2*)(Ob + (size_t)(row + NGW) * DM) + lane;
#pragma unroll
                for (int j = 0; j < 8; ++j) { xn[j] = __builtin_nontemporal_load(xr + 64 * j); mbn[j] = __builtin_nontemporal_load(mr + 64 * j); } }
#pragma unroll
            for (int j = 0; j < 8; ++j) { const int col = 4 * lane + 256 * j; S2[j] = *(const f32x4*)(ar + 4 * DM + col); sh2[j] = *(const f32x4*)(ar + 3 * DM + col); }
            f32x4 v[8];
#pragma unroll
            for (int j = 0; j < 8; ++j) v[j] = (f32x4){bflo(mb[j].x), bfhi(mb[j].x), bflo(mb[j].y), bfhi(mb[j].y)};
            mid_row(p, x, v, G1, S2, sh2, row, lane);
#pragma unroll
            for (int j = 0; j < 8; ++j) { x[j] = xn[j]; mb[j] = mbn[j]; }
        }
    }
    for (int row = MPROMPT + (gw >> 1); (gw & 1) == 0 && row < MTOK; row += (NGW >> 1)) {
        const float* ar = ada + (size_t)seq_of_row(row) * NADA;
        f32x4 v[8]; load_mo_row(v, Ob, Os, row, lane);
        f32x4 x[8], G1[8], S2[8], sh2[8]; const f32x4* xr = (const f32x4*)xrow_ptr(p, row) + lane;
#pragma unroll
        for (int j = 0; j < 8; ++j) { const int col = 4 * lane + 256 * j; x[j] = __builtin_nontemporal_load(xr + 64 * j); G1[j] = *(const f32x4*)(ar + 2 * DM + col); S2[j] = *(const f32x4*)(ar + 4 * DM + col); sh2[j] = *(const f32x4*)(ar + 3 * DM + col); }
        mid_row(p, x, v, G1, S2, sh2, row, lane);
    }
}

__device__ __forceinline__ void phase_ffnconv(const Params& p) {
    const int gt = blockIdx.x * NTHREADS + threadIdx.x, NGT = gridDim.x * NTHREADS;
    const bf16_t* UP = (const bf16_t*)(p.ws + WS_UP); bf16_t* F = (bf16_t*)(p.ws + WS_F2);
    constexpr int NCH = DFF / 8;
    const bf16_t* UPB = (const bf16_t*)(p.ws + WS_UPB);
    for (int it = gt; it < 128 * 2 * NCH; it += NGT) {
        const int c = it % NCH, q = it / NCH, sl = q & 1, blk = q >> 1, j0 = 8 * c, colg = (j0 >> 7) * 256 + (j0 & 127);
        const int row = blk * 64 + sl; const bool first = (blk & 31) == 0;
        float wg[3][8], wv[3][8], ag[8], av[8];
#pragma unroll
        for (int k = 0; k < 3; ++k) { ld8f(p.in[I_WFCONV] + (size_t)k * 2 * DFF + j0, wg[k]); ld8f(p.in[I_WFCONV] + (size_t)k * 2 * DFF + DFF + j0, wv[k]); }
        ld8f(p.in[I_BFCONV] + j0, ag); ld8f(p.in[I_BFCONV] + DFF + j0, av);
#pragma unroll
        for (int k = 0; k < 3; ++k) { const int d = k - 2 + sl;
            if (d < 0 && first) continue;
            const size_t ub = d < 0 ? (size_t)((blk - 1) * 4 + 4 + d) : (size_t)(blk * 4 + d);
            float xg[8], xv[8]; unpack8(*(const u32x4*)(UPB + ub * (2 * DFF) + colg), xg); unpack8(*(const u32x4*)(UPB + ub * (2 * DFF) + colg + 128), xv);
#pragma unroll
            for (int e = 0; e < 8; ++e) { ag[e] += xg[e] * wg[k][e]; av[e] += xv[e] * wv[k][e]; } }
        float f[8];
#pragma unroll
        for (int e = 0; e < 8; ++e) f[e] = gelu_tanh(ag[e]) * av[e];
        *(u32x4*)(F + (size_t)row * DFF + j0) = pack8(f);
    }
    if (gt < 170 * NCH) {
        const int c = gt % NCH, slot = gt / NCH, j0 = 8 * c, colg = (j0 >> 7) * 256 + (j0 & 127);
        float wg[3][8], wv[3][8], bg[8], bv[8];
#pragma unroll
        for (int k = 0; k < 3; ++k) { ld8f(p.in[I_WFCONV] + (size_t)k * 2 * DFF + j0, wg[k]); ld8f(p.in[I_WFCONV] + (size_t)k * 2 * DFF + DFF + j0, wv[k]); }
        ld8f(p.in[I_BFCONV] + j0, bg); ld8f(p.in[I_BFCONV] + DFF + j0, bv);
        for (int rs = slot; rs < 1024; rs += 170) {
            const int row = MPROMPT + rs, t = rs & 7, b = rs >> 3;
            float xg[3][8], xv[3][8];
#pragma unroll
            for (int k = 0; k < 3; ++k) { const int tt = t - 2 + k;
                if (tt >= 0) { unpack8(*(const u32x4*)(UP + (size_t)(row - 2 + k) * 2 * DFF + colg), xg[k]); unpack8(*(const u32x4*)(UP + (size_t)(row - 2 + k) * 2 * DFF + colg + 128), xv[k]); }
                else { const float* sp = p.in[I_SFCONV] + ((size_t)b * 2 + (2 + tt)) * 2 * DFF; ld8f(sp + j0, xg[k]); ld8f(sp + DFF + j0, xv[k]); } }
            float f[8];
#pragma unroll
            for (int e = 0; e < 8; ++e) { const float cg_ = bg[e] + xg[0][e] * wg[0][e] + xg[1][e] * wg[1][e] + xg[2][e] * wg[2][e];
                const float cv_ = bv[e] + xv[0][e] * wv[0][e] + xv[1][e] * wv[1][e] + xv[2][e] * wv[2][e]; f[e] = gelu_tanh(cg_) * cv_; }
            *(u32x4*)(F + (size_t)row * DFF + j0) = pack8(f);
        }
    }
    for (int i = gt; i < NSEQ * 2 * (2 * DFF / 8); i += NGT) { const int c = i % 1536, q = i / 1536, r = q & 1, s = q >> 1, n0 = 8 * c;
        const int j0 = n0 < DFF ? n0 : n0 - DFF, col = (j0 >> 7) * 256 + (n0 < DFF ? 0 : 128) + (j0 & 127);
        const int row = s < 4 ? s * SEQ + SEQ - 2 + r : MPROMPT + (s - 4) * 8 + 6 + r;
        float x[8];
        if (s < 4) unpack8(*(const u32x4*)(UPB + ((size_t)(s * 32 + 31) * 4 + 2 + r) * (2 * DFF) + col), x); else unpack8(*(const u32x4*)(UP + (size_t)row * 2 * DFF + col), x);
        float* o = p.out + (s < 4 ? O_FCONVP + ((size_t)s * 2 + r) * 2 * DFF : O_FCONVS + ((size_t)(s - 4) * 2 + r) * 2 * DFF) + n0;
        *(f32x4*)o = (f32x4){x[0], x[1], x[2], x[3]}; *(f32x4*)(o + 4) = (f32x4){x[4], x[5], x[6], x[7]}; }
}

__device__ __forceinline__ void phase_final(const Params& p) {
    const int tid = threadIdx.x, lane = tid & 63, wave = tid >> 6;
    const int gw = blockIdx.x * NWAVES + wave, NGW = gridDim.x * NWAVES;
    const float* ada = (const float*)(p.ws + WS_ADA);
    const bf16_t* Ob = (const bf16_t*)(p.ws + WS_FO); const float* Os = (const float*)(p.ws + WS_FOS2);
    {
        f32x4 x[8], xn[8]; u32x2 mb[8], mbn[8];
        if (gw < MPROMPT) { const f32x4* xr = (const f32x4*)(p.out + (size_t)gw * DM) + lane; const u32x2* mr = (const u32x2*)(Ob + (size_t)gw * DM) + lane;
#pragma unroll
            for (int j = 0; j < 8; ++j) { x[j] = __builtin_nontemporal_load(xr + 64 * j); mb[j] = __builtin_nontemporal_load(mr + 64 * j); } }
        for (int row = gw; row < MPROMPT; row += NGW) {
            const float* ar = ada + (size_t)(row >> 11) * NADA;
            f32x4 gt2[8];
#pragma unroll
            for (int j = 0; j < 8; ++j) { const int col = 4 * lane + 256 * j; gt2[j] = *(const f32x4*)(ar + 5 * DM + col); }
            if (row + NGW < MPROMPT) { const f32x4* xr = (const f32x4*)(p.out + (size_t)(row + NGW) * DM) + lane; const u32x2* mr = (const u32x2*)(Ob + (size_t)(row + NGW) * DM) + lane;
#pragma unroll
                for (int j = 0; j < 8; ++j) { xn[j] = __builtin_nontemporal_load(xr + 64 * j); mbn[j] = __builtin_nontemporal_load(mr + 64 * j); } }
            f32x4 v[8]; float ss = 0.f;
#pragma unroll
            for (int j = 0; j < 8; ++j) { v[j] = (f32x4){bflo(mb[j].x), bfhi(mb[j].x), bflo(mb[j].y), bfhi(mb[j].y)}; ss += (v[j].x * v[j].x + v[j].y * v[j].y) + (v[j].z * v[j].z + v[j].w * v[j].w); }
            const float rstd = 1.0f / sqrtf(wave_sum(ss) * (1.0f / DM) + EPS);
#pragma unroll
            for (int j = 0; j < 8; ++j) { const int col = 4 * lane + 256 * j;
                __builtin_nontemporal_store(x[j] + gt2[j] * (v[j] * rstd), (f32x4*)(p.out + (size_t)row * DM + col)); }
#pragma unroll
            for (int j = 0; j < 8; ++j) { x[j] = xn[j]; mb[j] = mbn[j]; }
        }
    }
    for (int row = MPROMPT + (gw >> 1); (gw & 1) == 0 && row < MTOK; row += (NGW >> 1)) {
        f32x4 v[8]; float ss = 0.f;
        load_mo_row(v, Ob, Os, row, lane);
#pragma unroll
        for (int j = 0; j < 8; ++j) ss += (v[j].x * v[j].x + v[j].y * v[j].y) + (v[j].z * v[j].z + v[j].w * v[j].w);
        const float rstd = 1.0f / sqrtf(wave_sum(ss) * (1.0f / DM) + EPS);
        const float* ar = ada + (size_t)seq_of_row(row) * NADA;
#pragma unroll
        for (int j = 0; j < 8; ++j) { const int col = 4 * lane + 256 * j;
            const f32x4 gt2 = *(const f32x4*)(ar + 5 * DM + col);
            float* o = p.out + (size_t)row * DM + col; const f32x4 x1 = *(const f32x4*)o;
            *(f32x4*)o = x1 + gt2 * (v[j] * rstd); }
    }
}

__global__ void __launch_bounds__(NTHREADS, 2) fwd_megakernel(Params p) {
    extern __shared__ __attribute__((aligned(16))) unsigned char lds_raw[];
    LAS unsigned char* lds = (LAS unsigned char*)lds_raw;
    cg::grid_group grid = cg::this_grid();
    unsigned char* ws = p.ws;
    if (ws == nullptr) grid.sync();
    volatile LAS unsigned* xst = (volatile LAS unsigned*)(lds + LDS_MAIN);
    if (threadIdx.x < 4) xst[threadIdx.x] = 0u;
    __syncthreads();
    const XcdBarrier xbar = xcd_barrier_post((unsigned*)(ws + WS_BAR), xst);
    const int G = gridDim.x, c = blockIdx.x;
    using namespace pg8;
    const size_t TA = 256ull * 2;

    if (PHASE_MASK & 1u) phase0<0>(p, lds);
    xcd_barrier(xbar);
    if (c < 48) {
        Sched S{(const char*)(ws + WS_SADA), (const char*)(ws + WS_WADA), TA * DM, TA * DM, 1, NADA / 256, DM / 64, G, c, 0, 0};
        EpiAda E{(float*)(ws + WS_ADA), p.in[I_BADA], p.in[I_GPRE1], p.in[I_GPOST1], p.in[I_GPRE2], p.in[I_GPOST2]};
        gemm_phase(lds, DM, DM, S, E);
        if (threadIdx.x == 0) { __builtin_amdgcn_fence(__ATOMIC_RELEASE, "agent"); asm volatile("s_waitcnt vmcnt(0)" ::: "memory");
            __hip_atomic_fetch_add((unsigned*)(ws + WS_BAR) + ADA_FLAG, 1u, __ATOMIC_RELAXED, __HIP_MEMORY_SCOPE_AGENT); }
    } else phase0<1>(p, lds);
    if (threadIdx.x == 0) { unsigned* f = (unsigned*)(ws + WS_BAR) + ADA_FLAG; unsigned sp = 0;
        while (__hip_atomic_load(f, __ATOMIC_RELAXED, __HIP_MEMORY_SCOPE_AGENT) < 48u) { __builtin_amdgcn_s_sleep(2); if (++sp > (1u << 20)) break; }
        __builtin_amdgcn_fence(__ATOMIC_ACQUIRE, "agent"); asm volatile("s_waitcnt vmcnt(0)" ::: "memory"); }
    __syncthreads();
    if (PHASE_MASK & 4u) phase_norm1(p);
    xcd_barrier(xbar);
    if (PHASE_MASK & 8u) {
        Sched S{(const char*)(ws + WS_H), (const char*)(ws + WS_WIN), TA * DM, TA * DM, MTOK / 256, INW / 256, DM / 64, G, c, 0, 0};
        EpiBf16 E{(bf16_t*)(ws + WS_Z), INW, 12};
        gemm_phase(lds, DM, DM, S, E);
    }
    xcd_barrier(xbar);
    if (PHASE_MASK & 16u) phase_mixprep(p);
    xcd_barrier(xbar);
    if (PHASE_MASK & 32u) {
        { Sched S{(const char*)(ws + WS_DP), (const char*)(ws + WS_WGRP), TA * PW, TA * 256, MTOK / 256, 4, 4, G, c, 0, 512};
          EpiPool E{(bf16_t*)(ws + WS_YP), p.in[I_PSCALE]};
          gemm_phase(lds, PW, 256, S, E); }
        { Sched S{(const char*)(ws + WS_XC), (const char*)(ws + WS_WGATE), TA * LW, TA * 256, MTOK / 256, 16, 4, G, (c + 80) & 255, 1, 512};
          EpiGates E{(const bf16_t*)(ws + WS_XC), (unsigned*)(ws + WS_LA), p.in[I_BRG], p.in[I_BIG], (const float*)(ws + WS_CTL)};
          gemm_phase(lds, LW, 256, S, E); }
    }
    xcd_barrier(xbar);
    if (PHASE_MASK & 64u) phase_scan(p, lds);
    xcd_barrier(xbar);
    if (PHASE_MASK & 128u) {
        { SchedP7 S{Sched{(const char*)(ws + WS_YP), (const char*)(ws + WS_WPU), TA * PW, TA * PW, 32, DM / 256, PW / 64, G, c, 0, 0}, 0, 1000};
          EpiMerge<false> E{(bf16_t*)(ws + WS_MG), (const bf16_t*)(ws + WS_Z), PW + LW, (unsigned*)(ws + WS_BAR)};
          gemm_phase(lds, PW, PW, S, E); }
        { SchedP7 S{Sched{(const char*)(ws + WS_YL), (const char*)(ws + WS_WLU), TA * LW, TA * LW, 32, DM / 256, LW / 64, G, c, 0, 0}, 32, 2000};
          EpiMerge<true> E{(bf16_t*)(ws + WS_MG), (const bf16_t*)(ws + WS_Z), PW + LW + DM, (unsigned*)(ws + WS_BAR)};
          gemm_phase(lds, LW, LW, S, E); }
        phase0<2>(p, lds);
    }
    xcd_barrier(xbar);
    if (PHASE_MASK & 256u) {
        SchedSplit S{Sched{(const char*)(ws + WS_MG), (const char*)(ws + WS_WOUT), TA * DM, TA * DM, 32, DM / 256, DM / 64, G, c, 0, 0}, 4, 0, 8, 0};
        EpiOut E{(bf16_t*)(ws + WS_MO), (float*)(ws + WS_MOS)};
        gemm_phase(lds, DM, DM, S, E);
    }
    xcd_barrier(xbar);
    if (PHASE_MASK & 512u) phase_mid(p);
    xcd_barrier(xbar);
    if (PHASE_MASK & 1024u) {
        Sched S{(const char*)(ws + WS_H2), (const char*)(ws + WS_WUP), TA * DM, TA * DM, MTOK / 256, 2 * DFF / 256, DM / 64, G, c, 0, 0};
        EpiUpFused E{(bf16_t*)(ws + WS_UP), (bf16_t*)(ws + WS_F2), (bf16_t*)(ws + WS_UPB), p.in[I_WFCONV], p.in[I_BFCONV]};
        gemm_phase(lds, DM, DM, S, E);
        phase0<3>(p, lds);
    }
    xcd_barrier(xbar);
    if (PHASE_MASK & 2048u) phase_ffnconv(p);
    xcd_barrier(xbar);
    if (PHASE_MASK & 4096u) {
        SchedSplit S{Sched{(const char*)(ws + WS_F2), (const char*)(ws + WS_WDOWN), TA * DFF, TA * DFF, 32, DM / 256, DFF / 64, G, c, 0, 0}, 12, 0, 8, 0};
        EpiOut E{(bf16_t*)(ws + WS_FO), (float*)(ws + WS_FOS2)};
        gemm_phase(lds, DFF, DFF, S, E);
    }
    xcd_barrier(xbar);
    if (PHASE_MASK & 8192u) phase_final(p);
}

extern "C" void kernel_launch(void* const* d_in, const int* in_sizes, int n_in, void* d_out, int out_size, void* d_ws, size_t ws_size, hipStream_t stream) {
    constexpr size_t kDynLds = LDS_MAIN + 64;
    static int grid_blocks = 0;
    if (!grid_blocks) {
        int dev = 0, cus = 0, per_cu = 0;
        (void)hipGetDevice(&dev);
        (void)hipDeviceGetAttribute(&cus, hipDeviceAttributeMultiprocessorCount, dev);
        (void)hipFuncSetAttribute((const void*)fwd_megakernel, hipFuncAttributeMaxDynamicSharedMemorySize, (int)kDynLds);
        (void)hipOccupancyMaxActiveBlocksPerMultiprocessor(&per_cu, (const void*)fwd_megakernel, NTHREADS, kDynLds);
        if (per_cu < 1) per_cu = 1;
        grid_blocks = cus;
        if (n_in != N_IN) fprintf(stderr, "kernel_launch: expected %d inputs, got %d\n", (int)N_IN, n_in);
    }
    Params p{};
    for (int i = 0; i < N_IN; ++i) p.in[i] = (const float*)d_in[i];
    p.out = (float*)d_out; p.ws = (unsigned char*)d_ws;
    (void)hipMemsetAsync((unsigned char*)d_ws + WS_BAR, 0, BAR_ZERO_WORDS * 4, stream);
    void* args[] = {&p};
    hipError_t e = hipLaunchCooperativeKernel((const void*)fwd_megakernel, dim3(grid_blocks), dim3(NTHREADS), args, kDynLds, stream);
    if (e != hipSuccess) fprintf(stderr, "cooperative launch failed: %s (grid %d)\n", hipGetErrorString(e), grid_blocks);
}
```

```cpp
#include <hip/hip_runtime.h>
#include <hip/hip_cooperative_groups.h>
#include <cstdio>
namespace cg = cooperative_groups;

#define LAS __attribute__((address_space(3)))
typedef unsigned short bf16_t;
typedef short bf16x8 __attribute__((ext_vector_type(8)));
typedef float f32x4 __attribute__((ext_vector_type(4)));
typedef float f32x2 __attribute__((ext_vector_type(2)));
typedef unsigned u32x4 __attribute__((ext_vector_type(4)));
typedef unsigned u32x2 __attribute__((ext_vector_type(2)));

#ifndef PHASE_MASK
#define PHASE_MASK 0xFFFFFFFFu
#endif

constexpr int DM = 2048, MTOK = 9216, MPROMPT = 8192, SEQ = 2048, NSEQ = 132;
constexpr int PW = 1024, LW = 2048, INW = 7168, DFF = 6144, NADA = 12288;
constexpr float EPS = 1e-6f;
constexpr int NTHREADS = 512, NWAVES = 8;

enum { I_XP = 0, I_XS, I_CP, I_CS, I_SPOOL, I_SLCONV, I_SLH, I_SFCONV, I_WADA, I_BADA, I_GPRE1, I_GPOST1, I_GPRE2, I_GPOST2,
       I_WIN, I_WGRP, I_PSCALE, I_WLCONV, I_BLCONV, I_WRG, I_BRG, I_WIG, I_BIG, I_LAM, I_WPU, I_WLU, I_WOUT, I_WUP, I_WFCONV, I_BFCONV, I_WDOWN, N_IN };

constexpr size_t O_YP = 0, O_YS = 16777216, O_POOLP = 18874368, O_LCONVP = O_POOLP + 61440, O_LHP = O_LCONVP + 24576, O_FCONVP = O_LHP + 8192,
                 O_POOLS = O_FCONVP + 98304, O_LCONVS = O_POOLS + 1966080, O_LHS = O_LCONVS + 786432, O_FCONVS = O_LHS + 262144;

constexpr size_t MiB = 1ull << 20;
constexpr size_t WS_ADA = 0, WS_CTL = 12 * MiB, WS_SADA = 13 * MiB, WS_WDOWN = 14 * MiB, WS_WUP = 38 * MiB,
                 WS_WGRP = 86 * MiB, WS_WGATE = 86 * MiB + 512 * 1024, WS_WPU = 89 * MiB, WS_WLU = 93 * MiB, WS_WOUT = 101 * MiB,
                 WS_WADA = 109 * MiB, WS_WIN = 157 * MiB, WS_H = 185 * MiB, WS_Z = 221 * MiB, WS_DP = 347 * MiB, WS_XC = 365 * MiB, WS_YP = 401 * MiB,
                 WS_LA = 109 * MiB, WS_UU = 181 * MiB, WS_YL = 347 * MiB, WS_MG = 109 * MiB, WS_MO = 221 * MiB, WS_UP = 221 * MiB, WS_F = 109 * MiB;

constexpr size_t WS_BAR = WS_CTL + 64 * 1024;
constexpr size_t WS_MOS = 253 * MiB;
constexpr size_t WS_MGS = 145 * MiB;
constexpr size_t WS_H2 = 109 * MiB;
constexpr size_t WS_UPB = 145 * MiB;
constexpr size_t WS_F2 = 221 * MiB;
constexpr size_t WS_FO = 109 * MiB;
constexpr size_t WS_FOS2 = 329 * MiB;
constexpr size_t WS_FOS = 253 * MiB;
constexpr int LDS_MAIN = 8 * 16640;
struct Params { const float* in[N_IN]; float* out; unsigned char* ws; };

__device__ __forceinline__ unsigned pk2(float lo, float hi) { unsigned r; asm("v_cvt_pk_bf16_f32 %0, %1, %2" : "=v"(r) : "v"(lo), "v"(hi)); return r; }
__device__ __forceinline__ float bflo(unsigned w) { return __uint_as_float(w << 16); }
__device__ __forceinline__ float bfhi(unsigned w) { return __uint_as_float(w & 0xffff0000u); }
__device__ __forceinline__ float bf1(bf16_t b) { return __uint_as_float(((unsigned)b) << 16); }
__device__ __forceinline__ float sigmoidf_(float x) { return __builtin_amdgcn_rcpf(1.0f + __expf(-x)); }
__device__ __forceinline__ float wave_sum(float v) {
#pragma unroll
    for (int o = 1; o < 64; o <<= 1) v += __shfl_xor(v, o);
    return v;
}
__device__ __forceinline__ int seq_of_row(int r) { return r < MPROMPT ? (r >> 11) : 4 + ((r - MPROMPT) >> 3); }
__device__ __forceinline__ void unpack8(const u32x4 w, float (&f)[8]) {
    f[0] = bflo(w.x); f[1] = bfhi(w.x); f[2] = bflo(w.y); f[3] = bfhi(w.y); f[4] = bflo(w.z); f[5] = bfhi(w.z); f[6] = bflo(w.w); f[7] = bfhi(w.w);
}
__device__ __forceinline__ u32x4 pack8(const float (&f)[8]) { u32x4 w; w.x = pk2(f[0], f[1]); w.y = pk2(f[2], f[3]); w.z = pk2(f[4], f[5]); w.w = pk2(f[6], f[7]); return w; }


#define XB_TMO      128
#define XB_XCNT(j)  (256  + 64 * (j))
#define XB_XSUB(j)  (1280 + 64 * (j))
#define XB_XGEN(j)  (2304 + 64 * (j))
#define XB_TOP      3328
#define XB_TOPGEN   3392
#define XCD_BAR_WORDS 3456
#define P7_FLAG(t) (XCD_BAR_WORDS + 64 * (t))
#define ADA_FLAG (XCD_BAR_WORDS + 64 * 32)
#define BAR_ZERO_WORDS (XCD_BAR_WORDS + 64 * 33)
#define XB_SPIN_CAP (1u << 18)
__device__ __forceinline__ unsigned xb_ld(unsigned* p)              { return __hip_atomic_load(p, __ATOMIC_RELAXED, __HIP_MEMORY_SCOPE_AGENT); }
__device__ __forceinline__ unsigned xb_add(unsigned* p, unsigned v) { return __hip_atomic_fetch_add(p, v, __ATOMIC_RELAXED, __HIP_MEMORY_SCOPE_AGENT); }
__device__ __forceinline__ unsigned xb_xcc_id() { return (unsigned)__builtin_amdgcn_s_getreg((3 << 11) | 20) & 0xFu; }
#define XB_SPIN(cond, bar) do { unsigned _sp = 0; while (cond) { __builtin_amdgcn_s_sleep(1); \
    if ((++_sp & 255u) == 0u) { if (xb_ld(&(bar)[XB_TMO])) break; if (_sp > XB_SPIN_CAP) { atomicAdd(&(bar)[XB_TMO], 1u); break; } } } } while (0)
struct XcdBarrier { unsigned* bar; unsigned x; volatile LAS unsigned* st; };
__device__ __forceinline__ XcdBarrier xcd_barrier_post(unsigned* bar, volatile LAS unsigned* st) {
    XcdBarrier b; b.bar = bar; b.x = xb_xcc_id(); b.st = st;
    if (threadIdx.x == 0) (void)xb_add(&bar[XB_XCNT(b.x)], 1u);
    return b;
}
__device__ __forceinline__ void xcd_barrier_complete(unsigned* bar, unsigned x, unsigned& nloc, unsigned& nx) {
    const unsigned G = gridDim.x * gridDim.y * gridDim.z;
    unsigned sum, cnt, mine, sp = 0u;
    for (;;) {
        sum = 0u; cnt = 0u; mine = 0u;
#pragma unroll
        for (unsigned j = 0; j < 16; ++j) { const unsigned c = xb_ld(&bar[XB_XCNT(j)]); sum += c; cnt += (c > 0u) ? 1u : 0u; mine = (j == x) ? c : mine; }
        if (sum == G) break;
        __builtin_amdgcn_s_sleep(1);
        if ((++sp & 255u) == 0u) { if (xb_ld(&bar[XB_TMO])) break; if (sp > XB_SPIN_CAP) { atomicAdd(&bar[XB_TMO], 1u); break; } }
    }
    nloc = mine > 0u ? mine : 1u; nx = cnt > 0u ? cnt : 1u;
}
__device__ __forceinline__ void xcd_barrier(const XcdBarrier& b) {
    asm volatile("s_waitcnt vmcnt(0)" ::: "memory");
    __syncthreads();
    if (threadIdx.x == 0) {
        unsigned* bar = b.bar;
        __builtin_amdgcn_s_waitcnt(0);
        unsigned nloc = b.st[0], nx = b.st[1];
        if (nloc == 0u) { xcd_barrier_complete(bar, b.x, nloc, nx); b.st[0] = nloc; b.st[1] = nx; }
        const unsigned old = xb_add(&bar[XB_XSUB(b.x)], 1u);
        const unsigned gen = old / nloc;
        if (old + 1u == (gen + 1u) * nloc) {
            __builtin_amdgcn_fence(__ATOMIC_RELEASE, "agent");
            asm volatile("s_waitcnt vmcnt(0)" ::: "memory");
            const unsigned og = xb_add(&bar[XB_TOP], 1u);
            const unsigned tg = og / nx;
            if (og + 1u == (tg + 1u) * nx) xb_add(&bar[XB_TOPGEN], 1u);
            else XB_SPIN(xb_ld(&bar[XB_TOPGEN]) == tg, bar);
            __builtin_amdgcn_fence(__ATOMIC_ACQUIRE, "agent");
            xb_add(&bar[XB_XGEN(b.x)], 1u);
            asm volatile("s_waitcnt vmcnt(0)" ::: "memory");
        } else {
            XB_SPIN(xb_ld(&bar[XB_XGEN(b.x)]) == gen, bar);
            __builtin_amdgcn_fence(__ATOMIC_ACQUIRE, "agent");
            asm volatile("s_waitcnt vmcnt(0)" ::: "memory");
        }
    }
    __syncthreads();
}

__device__ __forceinline__ void ld8f(const float* p, float (&x)[8]);
__device__ __forceinline__ float gelu_tanh(float x) { const float y = 1.5957691216f * (x + 0.044715f * x * x * x); return x * __builtin_amdgcn_rcpf(1.0f + __expf(-y)); }
namespace pg8 {
constexpr int BM = 256, BK = 64, HALF = 128, HTB = HALF * BK * 2, STAGE_BYTES = 8 * HTB;
__device__ __forceinline__ int lds_byte(int r, int c) { const int st = (r >> 4) * 2 + (c >> 5), rr = r & 15, cc = c & 31, ob = rr * 64 + cc * 2; return st * 1024 + (ob ^ (((ob >> 9) & 1) << 5)); }
__device__ __forceinline__ void stage_rc(int b, int& R, int& C) { const int st = b / 1024, sb = b % 1024, swz = sb ^ (((sb >> 9) & 1) << 5); R = (st >> 1) * 16 + swz / 64; C = (st & 1) * 32 + (swz % 64) / 2; }
__device__ __forceinline__ int perm32(int rho) { const int n = rho >> 4, i = rho & 15; return 8 * (i >> 2) + 4 * n + (i & 3); }

struct Unit { const char* A; const char* B; int nt, pm, pn, tag; };

struct Sched {
    const char* A; const char* B; size_t a_tile, b_tile; int nM, nN, nt, G, c, a_sh, a_mul;
    __device__ __forceinline__ bool next(int i, Unit& u) const {
        const long L = (long)i * G + c; const int nwg = nM * nN; if (L >= nwg) return false;
        int wgid = (int)L; { const int q = nwg / 8, r = nwg % 8, xcd = wgid % 8, off = wgid / 8; wgid = (xcd < r ? xcd * (q + 1) : r * (q + 1) + (xcd - r) * q) + off; }
        const int nig = 8 * nN, gid = wgid / nig, fm = gid * 8, gsz = (nM - fm) < 8 ? (nM - fm) : 8;
        u.pm = fm + ((wgid % nig) % gsz); u.pn = (wgid % nig) / gsz; u.tag = 0;
        u.A = A + (size_t)u.pm * a_tile + (size_t)((u.pn >> a_sh) * a_mul); u.B = B + (size_t)u.pn * b_tile; u.nt = nt; return true;
    }
};

template <class Epi, class S_t>
__device__ __forceinline__ void gemm_phase(LAS unsigned char* lds, int lda, int ldb, const S_t& S, const Epi& E) {
    int tid = threadIdx.x; asm volatile("" : "+v"(tid));
    const int wid = __builtin_amdgcn_readfirstlane(tid >> 6), lane = tid & 63, wr = wid >> 2, wc = wid & 3, fr = lane & 15, fq = lane >> 4;
    unsigned voffA[2], voffB[2];
#pragma unroll
    for (int i = 0; i < 2; ++i) { int R, C; stage_rc(tid * 16 + i * 8192, R, C); const int Rb = Epi::PERM ? ((R & ~31) + perm32(R & 31)) : R;
        voffA[i] = (unsigned)(R * lda + C) * 2u; voffB[i] = (unsigned)(Rb * ldb + C) * 2u; }
    const size_t kstep = (size_t)(BK * 2);
    const size_t hstepA = (size_t)HALF * lda * 2, hstepB = (size_t)HALF * ldb * 2;
    const unsigned ldsw = (unsigned)wid * 1024u;
    const int aoff = lds_byte(wr * 64 + fr, fq * 8), boff = lds_byte(wc * 32 + fr, fq * 8);
#define PG8_SA(b, h) (((b) * 2 + (h)) * HTB)
#define PG8_SB(b, h) ((4 + (b) * 2 + (h)) * HTB)
#define PG8_STAGE(bufoff, gbase, voff) do { _Pragma("unroll") for (int _i = 0; _i < 2; ++_i) \
        __builtin_amdgcn_global_load_lds((const unsigned*)((const char*)(gbase) + (voff)[_i]), (LAS unsigned*)(lds + (bufoff) + ldsw + _i * 8192), 16, 0, 0); } while (0)
#define PG8_LDA(dst, b, h) do { _Pragma("unroll") for (int m = 0; m < 4; ++m) _Pragma("unroll") for (int k = 0; k < 2; ++k) dst[m][k] = *(const LAS bf16x8*)(lds + PG8_SA(b, h) + aoff + m * 2048 + k * 1024); } while (0)
#define PG8_LDB(dst, b, h) do { _Pragma("unroll") for (int n = 0; n < 2; ++n) _Pragma("unroll") for (int k = 0; k < 2; ++k) dst[n][k] = *(const LAS bf16x8*)(lds + PG8_SB(b, h) + boff + n * 2048 + k * 1024); } while (0)
#define PG8_MMA(ai, bj, At, Bt) do { __builtin_amdgcn_s_setprio(1); _Pragma("unroll") for (int m = 0; m < 4; ++m) _Pragma("unroll") for (int n = 0; n < 2; ++n) _Pragma("unroll") for (int k = 0; k < 2; ++k) \
        acc[ai][bj][m][n] = __builtin_amdgcn_mfma_f32_16x16x32_bf16(Bt[n][k], At[m][k], acc[ai][bj][m][n], 0, 0, 0); __builtin_amdgcn_s_setprio(0); } while (0)
#define PG8_WAIT_V(n) asm volatile("s_waitcnt vmcnt(" #n ")" ::: "memory")
#define PG8_WAIT_L(n) asm volatile("s_waitcnt lgkmcnt(" #n ")" ::: "memory")
#define PG8_BAR __builtin_amdgcn_s_barrier()
#define PG8_SCHED __builtin_amdgcn_sched_barrier(0)
    Unit cur, nxt; int ui = 0;
    if (!S.next(0, cur)) return;
    f32x4 acc[2][2][4][2];
#pragma unroll
    for (int a = 0; a < 2; ++a)
#pragma unroll
        for (int b = 0; b < 2; ++b)
#pragma unroll
            for (int m = 0; m < 4; ++m)
#pragma unroll
                for (int n = 0; n < 2; ++n) acc[a][b][m][n] = (f32x4){0.f, 0.f, 0.f, 0.f};
    bf16x8 At[4][2], B0[2][2], B1[2][2];
    const char* cA = cur.A; const char* cB = cur.B;
    PG8_STAGE(PG8_SB(0, 0), cB, voffB); PG8_STAGE(PG8_SA(0, 0), cA, voffA); PG8_STAGE(PG8_SB(0, 1), cB + hstepB, voffB); PG8_STAGE(PG8_SA(0, 1), cA + hstepA, voffA);
    if (wr == 1) PG8_BAR;
    PG8_WAIT_V(4); PG8_BAR;
    PG8_STAGE(PG8_SB(1, 0), cB + kstep, voffB); PG8_STAGE(PG8_SA(1, 0), cA + kstep, voffA); PG8_STAGE(PG8_SB(1, 1), cB + hstepB + kstep, voffB);
    PG8_WAIT_V(6); PG8_BAR;
    for (;;) {
        const bool has_next = S.next(ui + 1, nxt);
        const char* nA = has_next ? nxt.A : cA; const char* nB = has_next ? nxt.B : cB;
        const int nt = cur.nt;
        for (int t = 0; t < nt; t += 2) {
            const bool last = (t == nt - 2);
            const char* a1 = cA + (size_t)(t + 1) * kstep;
            const char* a2 = last ? nA : cA + (size_t)(t + 2) * kstep; const char* b2 = last ? nB : cB + (size_t)(t + 2) * kstep;
            const char* a3 = a2 + kstep; const char* b3 = b2 + kstep;
            PG8_LDB(B0, 0, 0); PG8_SCHED; PG8_LDA(At, 0, 0); PG8_STAGE(PG8_SA(1, 1), a1 + hstepA, voffA);
            PG8_WAIT_L(8); PG8_BAR; PG8_WAIT_L(0); PG8_MMA(0, 0, At, B0); PG8_BAR; PG8_SCHED;
            PG8_LDB(B1, 0, 1); PG8_STAGE(PG8_SB(0, 0), b2, voffB);
            PG8_BAR; PG8_WAIT_L(0); PG8_MMA(0, 1, At, B1); PG8_BAR;
            PG8_LDA(At, 0, 1); PG8_STAGE(PG8_SA(0, 0), a2, voffA);
            PG8_BAR; PG8_WAIT_L(0); PG8_MMA(1, 0, At, B0); PG8_BAR; PG8_SCHED;
            PG8_STAGE(PG8_SB(0, 1), b2 + hstepB, voffB);
            PG8_WAIT_V(6); PG8_BAR; PG8_MMA(1, 1, At, B1); PG8_BAR;
            PG8_LDB(B0, 1, 0); PG8_SCHED; PG8_LDA(At, 1, 0); PG8_STAGE(PG8_SA(0, 1), a2 + hstepA, voffA);
            PG8_WAIT_L(8); PG8_BAR; PG8_WAIT_L(0); PG8_MMA(0, 0, At, B0); PG8_BAR; PG8_SCHED;
            PG8_LDB(B1, 1, 1); PG8_STAGE(PG8_SB(1, 0), b3, voffB);
            PG8_BAR; PG8_WAIT_L(0); PG8_MMA(0, 1, At, B1); PG8_BAR;
            PG8_LDA(At, 1, 1); PG8_STAGE(PG8_SA(1, 0), a3, voffA);
            PG8_BAR; PG8_WAIT_L(0); PG8_MMA(1, 0, At, B0); PG8_BAR; PG8_SCHED;
            PG8_STAGE(PG8_SB(1, 1), b3 + hstepB, voffB);
            PG8_WAIT_V(6); PG8_BAR; PG8_MMA(1, 1, At, B1); PG8_BAR;
        }
        E(acc, cur, wr, wc, fr, fq);
        if (!has_next) break;
#pragma unroll
        for (int a = 0; a < 2; ++a)
#pragma unroll
            for (int b = 0; b < 2; ++b)
#pragma unroll
                for (int m = 0; m < 4; ++m)
#pragma unroll
                    for (int n = 0; n < 2; ++n) acc[a][b][m][n] = (f32x4){0.f, 0.f, 0.f, 0.f};
        cur = nxt; cA = nA; cB = nB; ++ui;
    }
    PG8_WAIT_V(0);
    if (wr == 0) PG8_BAR;
    PG8_BAR;
#undef PG8_SA
#undef PG8_SB
#undef PG8_STAGE
#undef PG8_LDA
#undef PG8_LDB
#undef PG8_MMA
#undef PG8_WAIT_V
#undef PG8_WAIT_L
#undef PG8_BAR
#undef PG8_SCHED
}

struct EpiF32 {
    static constexpr bool PERM = false;
    float* C; int ldc; const float* bias;
    __device__ __forceinline__ void operator()(const f32x4 (&acc)[2][2][4][2], const Unit& u, int wr, int wc, int fr, int fq) const {
        const int row0 = u.pm * BM + wr * 64 + fr, col0 = u.pn * BM + wc * 32 + 4 * fq;
        f32x4 bv[2][2];
#pragma unroll
        for (int bj = 0; bj < 2; ++bj)
#pragma unroll
            for (int n = 0; n < 2; ++n) bv[bj][n] = bias ? *(const f32x4*)(bias + col0 + bj * HALF + n * 16) : (f32x4){0.f, 0.f, 0.f, 0.f};
#pragma unroll
        for (int ai = 0; ai < 2; ++ai)
#pragma unroll
            for (int m = 0; m < 4; ++m) { float* rowp = C + (size_t)(row0 + ai * HALF + m * 16) * ldc + col0;
#pragma unroll
                for (int bj = 0; bj < 2; ++bj)
#pragma unroll
                    for (int n = 0; n < 2; ++n) *(f32x4*)(rowp + bj * HALF + n * 16) = acc[ai][bj][m][n] + bv[bj][n]; }
    }
};
struct EpiAda {
    static constexpr bool PERM = false;
    float* C; const float* bias; const float* g1; const float* g2; const float* g4; const float* g5;
    __device__ __forceinline__ void operator()(const f32x4 (&acc)[2][2][4][2], const Unit& u, int wr, int wc, int fr, int fq) const {
        const int row0 = wr * 64 + fr, col0 = u.pn * BM + wc * 32 + 4 * fq, kind = u.pn >> 3;
        const float* gm = kind == 2 ? g2 : kind == 4 ? g4 : kind == 5 ? g5 : g1;
        const float one = (kind == 1 || kind == 4) ? 1.0f : 0.0f, gs = (kind == 0 || kind == 3) ? 0.0f : 1.0f;
#pragma unroll
        for (int bj = 0; bj < 2; ++bj)
#pragma unroll
            for (int n = 0; n < 2; ++n) { const int col = col0 + bj * HALF + n * 16;
                const f32x4 bv = *(const f32x4*)(bias + col) + one, gv = *(const f32x4*)(gm + (col & (DM - 1))) * gs + (1.0f - gs);
#pragma unroll
                for (int ai = 0; ai < 2; ++ai)
#pragma unroll
                    for (int m = 0; m < 4; ++m) *(f32x4*)(C + (size_t)(row0 + ai * HALF + m * 16) * NADA + col) = (acc[ai][bj][m][n] + bv) * gv; }
    }
};
struct EpiBf16 {
    static constexpr bool PERM = true;
    bf16_t* O; int ldc; int sig_pn;
    __device__ __forceinline__ void operator()(const f32x4 (&acc)[2][2][4][2], const Unit& u, int wr, int wc, int fr, int fq) const {
        const int row0 = u.pm * BM + wr * 64 + fr, col0 = u.pn * BM + wc * 32 + 8 * fq;
        const bool sg = u.pn >= sig_pn;
#pragma unroll
        for (int ai = 0; ai < 2; ++ai)
#pragma unroll
            for (int m = 0; m < 4; ++m) { bf16_t* rowp = O + (size_t)(row0 + ai * HALF + m * 16) * ldc + col0;
#pragma unroll
                for (int bj = 0; bj < 2; ++bj) { f32x4 v0 = acc[ai][bj][m][0], v1 = acc[ai][bj][m][1];
                    if (sg) {
#pragma unroll
                        for (int j = 0; j < 4; ++j) { v0[j] = sigmoidf_(v0[j]); v1[j] = sigmoidf_(v1[j]); } }
                    u32x4 w; w.x = pk2(v0[0], v0[1]); w.y = pk2(v0[2], v0[3]); w.z = pk2(v1[0], v1[1]); w.w = pk2(v1[2], v1[3]);
                    *(u32x4*)(rowp + bj * HALF) = w; } }
    }
};
struct EpiPool {
    static constexpr bool PERM = true;
    bf16_t* O; const float* scale;
    __device__ __forceinline__ void operator()(const f32x4 (&acc)[2][2][4][2], const Unit& u, int wr, int wc, int fr, int fq) const {
        const int row0 = u.pm * BM + wr * 64 + fr, col0 = u.pn * BM + wc * 32 + 8 * fq;
        f32x4 sv[2][2];
#pragma unroll
        for (int bj = 0; bj < 2; ++bj)
#pragma unroll
            for (int n = 0; n < 2; ++n) sv[bj][n] = *(const f32x4*)(scale + col0 + bj * HALF + 4 * n);
#pragma unroll
        for (int ai = 0; ai < 2; ++ai)
#pragma unroll
            for (int m = 0; m < 4; ++m) { bf16_t* rowp = O + (size_t)(row0 + ai * HALF + m * 16) * PW + col0;
#pragma unroll
                for (int bj = 0; bj < 2; ++bj) { const f32x4 v0 = acc[ai][bj][m][0] * sv[bj][0], v1 = acc[ai][bj][m][1] * sv[bj][1];
                    u32x4 w; w.x = pk2(v0[0], v0[1]); w.y = pk2(v0[2], v0[3]); w.z = pk2(v1[0], v1[1]); w.w = pk2(v1[2], v1[3]);
                    *(u32x4*)(rowp + bj * HALF) = w; } }
    }
};
struct EpiGates {
    static constexpr bool PERM = true;
    const bf16_t* XC; unsigned* LU; const float* brg; const float* big; const float* spl;
    __device__ __forceinline__ void operator()(const f32x4 (&acc)[2][2][4][2], const Unit& u, int wr, int wc, int fr, int fq) const {
        const int row0 = u.pm * BM + wr * 64 + fr, ch0 = u.pn * HALF + wc * 32 + 8 * fq;
        float br[8], bi[8], sp[8];
#pragma unroll
        for (int q = 0; q < 2; ++q) { const f32x4 a = *(const f32x4*)(brg + ch0 + 4 * q), b = *(const f32x4*)(big + ch0 + 4 * q), c = *(const f32x4*)(spl + ch0 + 4 * q);
#pragma unroll
            for (int j = 0; j < 4; ++j) { br[4 * q + j] = a[j]; bi[4 * q + j] = b[j]; sp[4 * q + j] = c[j]; } }
        u32x4 xraw[2][4];
#pragma unroll
        for (int ai = 0; ai < 2; ++ai)
#pragma unroll
            for (int m = 0; m < 4; ++m) xraw[ai][m] = *(const u32x4*)(XC + (size_t)(row0 + ai * HALF + m * 16) * LW + ch0);
        asm volatile("" ::: "memory");
#pragma unroll
        for (int ai = 0; ai < 2; ++ai)
#pragma unroll
            for (int m = 0; m < 4; ++m) { const size_t off = (size_t)(row0 + ai * HALF + m * 16) * LW + ch0;
                float xc[8]; unpack8(xraw[ai][m], xc);
                float la[8], uu[8];
#pragma unroll
                for (int n = 0; n < 2; ++n)
#pragma unroll
                    for (int j = 0; j < 4; ++j) { const int e = 4 * n + j;
                        const float r = sigmoidf_(acc[ai][0][m][n][j] + br[e]), ig = sigmoidf_(acc[ai][1][m][n][j] + bi[e]);
                        const float l = -8.0f * r * sp[e]; la[e] = l;
                        const float x2 = 2.0f * l;
                        const float om = x2 > -0.03125f ? -x2 * (1.0f + x2 * (0.5f + x2 * (0.16666667f + x2 * 0.041666668f))) : 1.0f - __expf(x2);
                        uu[e] = __builtin_amdgcn_sqrtf(om) * (ig * xc[e]); }
                u32x4 w0, w1; w0.x = pk2(la[0], uu[0]); w0.y = pk2(la[1], uu[1]); w0.z = pk2(la[2], uu[2]); w0.w = pk2(la[3], uu[3]);
                w1.x = pk2(la[4], uu[4]); w1.y = pk2(la[5], uu[5]); w1.z = pk2(la[6], uu[6]); w1.w = pk2(la[7], uu[7]);
                *(u32x4*)(LU + off) = w0; *(u32x4*)(LU + off + 4) = w1; }
    }
};
template <bool ADD> struct EpiMerge {
    static constexpr bool PERM = true;
    bf16_t* MG; const bf16_t* Z; int gcol0; unsigned* flags;
    __device__ __forceinline__ void operator()(const f32x4 (&acc)[2][2][4][2], const Unit& u, int wr, int wc, int fr, int fq) const {
        const int row0 = u.pm * BM + wr * 64 + fr, col0 = u.pn * BM + wc * 32 + 8 * fq;
        if (ADD && u.tag >= 2000) {
            unsigned* f = flags + P7_FLAG(u.tag - 2000); unsigned sp = 0;
            while ((unsigned)__builtin_amdgcn_readfirstlane(__hip_atomic_load(f, __ATOMIC_RELAXED, __HIP_MEMORY_SCOPE_AGENT)) < 8u) { __builtin_amdgcn_s_sleep(2); if (++sp > (1u << 20)) break; }
            __builtin_amdgcn_fence(__ATOMIC_ACQUIRE, "agent");
            asm volatile("s_waitcnt vmcnt(0)" ::: "memory");
        }
#pragma unroll
        for (int ai = 0; ai < 2; ++ai) {
            u32x4 gr[4][2], orw[4][2];
            asm volatile("" ::: "memory");
#pragma unroll
            for (int m = 0; m < 4; ++m)
#pragma unroll
                for (int bj = 0; bj < 2; ++bj) { const int row = row0 + ai * HALF + m * 16, col = col0 + bj * HALF;
                    gr[m][bj] = *(const u32x4*)(Z + (size_t)row * INW + gcol0 + col);
                    if (ADD) orw[m][bj] = *(const u32x4*)(MG + (size_t)row * DM + col); }
            asm volatile("" ::: "memory");
#pragma unroll
            for (int m = 0; m < 4; ++m)
#pragma unroll
                for (int bj = 0; bj < 2; ++bj) { const int row = row0 + ai * HALF + m * 16, col = col0 + bj * HALF;
                    float g[8], o[8]; unpack8(gr[m][bj], g);
                    if (ADD) unpack8(orw[m][bj], o);
#pragma unroll
                    for (int n = 0; n < 2; ++n)
#pragma unroll
                        for (int j = 0; j < 4; ++j) { const int e = 4 * n + j; o[e] = ADD ? o[e] + g[e] * acc[ai][bj][m][n][j] : g[e] * acc[ai][bj][m][n][j]; }
                    *(u32x4*)(MG + (size_t)row * DM + col) = pack8(o); }
        }
        if (!ADD && u.tag >= 1000) {
            asm volatile("s_waitcnt vmcnt(0)" ::: "memory");
            __builtin_amdgcn_fence(__ATOMIC_RELEASE, "agent");
            asm volatile("s_waitcnt vmcnt(0)" ::: "memory");
            if ((threadIdx.x & 63) == 0) __hip_atomic_fetch_add(flags + P7_FLAG(u.tag - 1000), 1u, __ATOMIC_RELAXED, __HIP_MEMORY_SCOPE_AGENT);
        }
    }
};
struct SchedSplit {
    Sched base; int ntp, kz_lo, kz_hi, mode;
    __device__ __forceinline__ bool next(int i, Unit& u) const {
        if (i == 0) return base.next(0, u);
        if (i > 1) return false;
        const int tile = base.c >> 3, kz = base.c & 7;
        if (kz < kz_lo || kz >= kz_hi) return false;
        const int k = kz - kz_lo; int koff, nt;
        if (mode == 0) { koff = k * ntp; nt = ntp; } else { koff = k < 4 ? 6 * k : 24 + 4 * (k - 4); nt = k < 4 ? 6 : 4; }
        u.pm = 32 + (tile >> 3); u.pn = tile & 7; u.tag = 1 + kz; u.nt = nt;
        u.A = base.A + (size_t)u.pm * base.a_tile + (size_t)koff * 128; u.B = base.B + (size_t)u.pn * base.b_tile + (size_t)koff * 128; return true;
    }
};
struct SchedP7 {
    Sched base; int lo, tg;
    __device__ __forceinline__ bool next(int i, Unit& u) const {
        if (i == 0) return base.next(0, u);
        const int t = base.c - lo;
        if (i > 1 || t < 0 || t >= 32) return false;
        u.pm = 32 + (t >> 3); u.pn = t & 7; u.tag = tg + t; u.nt = base.nt;
        u.A = base.A + (size_t)u.pm * base.a_tile; u.B = base.B + (size_t)u.pn * base.b_tile; return true;
    }
};
struct EpiOut {
    static constexpr bool PERM = true;
    bf16_t* Ob; float* Os;
    __device__ __forceinline__ void operator()(const f32x4 (&acc)[2][2][4][2], const Unit& u, int wr, int wc, int fr, int fq) const {
        const int col0 = u.pn * BM + wc * 32 + 8 * fq;
        if (u.tag == 0) {
            const int row0 = u.pm * BM + wr * 64 + fr;
#pragma unroll
            for (int ai = 0; ai < 2; ++ai)
#pragma unroll
                for (int m = 0; m < 4; ++m) { bf16_t* rowp = Ob + (size_t)(row0 + ai * HALF + m * 16) * DM + col0;
#pragma unroll
                    for (int bj = 0; bj < 2; ++bj) { const f32x4 v0 = acc[ai][bj][m][0], v1 = acc[ai][bj][m][1];
                        u32x4 w; w.x = pk2(v0[0], v0[1]); w.y = pk2(v0[2], v0[3]); w.z = pk2(v1[0], v1[1]); w.w = pk2(v1[2], v1[3]);
                        *(u32x4*)(rowp + bj * HALF) = w; } }
        } else {
            const int row0 = (u.pm - 32) * BM + wr * 64 + fr;
            float* Op = Os + (size_t)(u.tag - 1) * (1024ull * DM);
#pragma unroll
            for (int ai = 0; ai < 2; ++ai)
#pragma unroll
                for (int m = 0; m < 4; ++m) { float* rowp = Op + (size_t)(row0 + ai * HALF + m * 16) * DM + col0;
#pragma unroll
                    for (int bj = 0; bj < 2; ++bj)
#pragma unroll
                        for (int n = 0; n < 2; ++n) *(f32x4*)(rowp + bj * HALF + 4 * n) = acc[ai][bj][m][n]; }
        }
    }
};
__device__ __forceinline__ float dpp_shr1(float old, float src) { return __int_as_float(__builtin_amdgcn_update_dpp(__float_as_int(old), __float_as_int(src), 0x111, 0xf, 0xf, false)); }
__device__ __forceinline__ float dpp_shr2(float old, float src) { return __int_as_float(__builtin_amdgcn_update_dpp(__float_as_int(old), __float_as_int(src), 0x112, 0xf, 0xf, false)); }
__device__ __forceinline__ float dpp_ror1(float src) { return __int_as_float(__builtin_amdgcn_update_dpp(0, __float_as_int(src), 0x121, 0xf, 0xf, false)); }
__device__ __forceinline__ float dpp_ror2(float src) { return __int_as_float(__builtin_amdgcn_update_dpp(0, __float_as_int(src), 0x122, 0xf, 0xf, false)); }
struct EpiUpFused {
    static constexpr bool PERM = true;
    bf16_t* UP; bf16_t* F; bf16_t* UPB; const float* wconv; const float* bconv;
    __device__ __forceinline__ void operator()(const f32x4 (&acc)[2][2][4][2], const Unit& u, int wr, int wc, int fr, int fq) const {
        const int row0 = u.pm * BM + wr * 64 + fr, col0 = u.pn * BM + wc * 32 + 8 * fq;
        if (u.pm >= 32) {
#pragma unroll
            for (int ai = 0; ai < 2; ++ai)
#pragma unroll
                for (int m = 0; m < 4; ++m) { bf16_t* rowp = UP + (size_t)(row0 + ai * HALF + m * 16) * (2 * DFF) + col0;
#pragma unroll
                    for (int bj = 0; bj < 2; ++bj) { const f32x4 v0 = acc[ai][bj][m][0], v1 = acc[ai][bj][m][1];
                        u32x4 w; w.x = pk2(v0[0], v0[1]); w.y = pk2(v0[2], v0[3]); w.z = pk2(v1[0], v1[1]); w.w = pk2(v1[2], v1[3]);
                        *(u32x4*)(rowp + bj * HALF) = w; } }
            return;
        }
        const int j0 = u.pn * HALF + wc * 32 + 8 * fq;
        u32x2 res0[8];
#pragma unroll
        for (int n = 0; n < 2; ++n) {
            asm volatile("" ::: "memory");
            const int jc = j0 + 4 * n;
            const f32x4 wg0 = *(const f32x4*)(wconv + jc), wg1 = *(const f32x4*)(wconv + 2 * DFF + jc), wg2 = *(const f32x4*)(wconv + 4 * DFF + jc), bg = *(const f32x4*)(bconv + jc);
            const f32x4 wv0 = *(const f32x4*)(wconv + DFF + jc), wv1 = *(const f32x4*)(wconv + 3 * DFF + jc), wv2 = *(const f32x4*)(wconv + 5 * DFF + jc), bv = *(const f32x4*)(bconv + DFF + jc);
#pragma unroll
            for (int ai = 0; ai < 2; ++ai)
#pragma unroll
                for (int m = 0; m < 4; ++m) { const int row = row0 + ai * HALF + m * 16;
                    const f32x4 g0 = acc[ai][0][m][n], v0 = acc[ai][1][m][n];
                    f32x4 gp = (f32x4){0.f, 0.f, 0.f, 0.f}, vp = gp;
                    if (m > 0) { gp = acc[ai][0][m > 0 ? m - 1 : 0][n]; vp = acc[ai][1][m > 0 ? m - 1 : 0][n]; }
                    f32x4 f;
#pragma unroll
                    for (int j = 0; j < 4; ++j) {
                        const float g1 = dpp_shr1(dpp_ror1(gp[j]), g0[j]), g2 = dpp_shr2(dpp_ror2(gp[j]), g0[j]);
                        const float v1 = dpp_shr1(dpp_ror1(vp[j]), v0[j]), v2 = dpp_shr2(dpp_ror2(vp[j]), v0[j]);
                        const float cg_ = bg[j] + g2 * wg0[j] + g1 * wg1[j] + g0[j] * wg2[j];
                        const float cv_ = bv[j] + v2 * wv0[j] + v1 * wv1[j] + v0[j] * wv2[j];
                        f[j] = gelu_tanh(cg_) * cv_; }
                    u32x2 w; w.x = pk2(f[0], f[1]); w.y = pk2(f[2], f[3]);
                    if (n == 0) res0[ai * 4 + m] = w;
                    else if (m > 0 || fr >= 2) { u32x4 w4; w4.x = res0[ai * 4 + m].x; w4.y = res0[ai * 4 + m].y; w4.z = w.x; w4.w = w.y; *(u32x4*)(F + (size_t)row * DFF + j0) = w4; }
                    if (n == 1 && ((m == 0 && fr < 2) || (m == 3 && fr >= 14))) { const int slot = m == 0 ? fr : fr - 12;
                        const f32x4 ga = acc[ai][0][m][0], va = acc[ai][1][m][0];
                        bf16_t* bp = UPB + ((size_t)(row >> 6) * 4 + slot) * (2 * DFF) + col0;
                        u32x4 wg_, wv_; wg_.x = pk2(ga[0], ga[1]); wg_.y = pk2(ga[2], ga[3]); wg_.z = pk2(g0[0], g0[1]); wg_.w = pk2(g0[2], g0[3]);
                        wv_.x = pk2(va[0], va[1]); wv_.y = pk2(va[2], va[3]); wv_.z = pk2(v0[0], v0[1]); wv_.w = pk2(v0[2], v0[3]);
                        *(u32x4*)bp = wg_; *(u32x4*)(bp + HALF) = wv_; } }
        }
    }
};
}

template <bool NTS> __device__ __forceinline__ void cvt_item_t(const float* __restrict__ W, int N, bf16_t* WT, int K, int k0, int n0, int drow0, LAS float* scr, int lane) {
    float v[64];
#pragma unroll
    for (int kk = 0; kk < 64; ++kk) v[kk] = __builtin_nontemporal_load(W + (size_t)(k0 + kk) * N + n0 + lane);
#pragma unroll
    for (int kk = 0; kk < 64; ++kk) scr[kk * 65 + lane] = v[kk];
    asm volatile("s_waitcnt lgkmcnt(0)" ::: "memory");
    const int c = lane & 7;
#pragma unroll
    for (int j = 0; j < 8; ++j) { const int n = (lane >> 3) + 8 * j; const LAS float* s = scr + (8 * c) * 65 + n;
        u32x4 o; o.x = pk2(s[0 * 65], s[1 * 65]); o.y = pk2(s[2 * 65], s[3 * 65]); o.z = pk2(s[4 * 65], s[5 * 65]); o.w = pk2(s[6 * 65], s[7 * 65]);
        if (NTS) __builtin_nontemporal_store(o, (u32x4*)(WT + (size_t)(drow0 + n) * K + k0 + 8 * c)); else *(u32x4*)(WT + (size_t)(drow0 + n) * K + k0 + 8 * c) = o; }
    asm volatile("s_waitcnt lgkmcnt(0)" ::: "memory");
}
__device__ __forceinline__ void cvt_item(const float* W, int N, bf16_t* WT, int K, int k0, int n0, int drow0, LAS float* scr, int lane) { cvt_item_t<true>(W, N, WT, K, k0, n0, drow0, scr, lane); }
__device__ __forceinline__ void cvt_item_now(const float* W, int N, bf16_t* WT, int K, int k0, int n0, int drow0, LAS float* scr, int lane) { cvt_item_t<false>(W, N, WT, K, k0, n0, drow0, scr, lane); }

template <int PART> __device__ __forceinline__ void phase0(const Params& p, LAS unsigned char* lds) {
    constexpr int SKIP = PART == 0 ? 0 : PART == 1 ? 48 : 192;
    const int tid = threadIdx.x, lane = tid & 63, wave = tid >> 6;
    const int gw = ((int)blockIdx.x - SKIP) * NWAVES + wave, NGW = ((int)gridDim.x - SKIP) * NWAVES;
    if (gw < 0) return;
    const int gt = blockIdx.x * NTHREADS + tid, NGT = gridDim.x * NTHREADS;
    unsigned char* ws = p.ws;
    LAS float* scr = (LAS float*)(lds + wave * 16640);
    constexpr int I0 = 32 * 192, I1 = 32 * 112, I2 = 32 * 192, I3 = 96 * 32, I4 = 32 * 32, I5 = 32 * 32, I6 = 16 * 32, I7 = 64, I8 = 128, I9 = 128;
    constexpr int NIT = I0 + I1 + I2 + I3 + I4 + I5 + I6 + I7 + I8 + I9;
    constexpr int U0 = I0 + I1, U1 = U0 + I2 / 2, D0 = I0 + I1 + I2, D1 = D0 + I3;
    constexpr int CUT = (U1 - U0) + I3;
    constexpr int LO = PART == 0 ? 0 : PART == 1 ? I0 : PART == 2 ? U0 : D0, HI = PART == 0 ? I0 : PART == 1 ? NIT - CUT : PART == 2 ? U1 : D1;
    for (int it0 = LO + gw; it0 < HI; it0 += NGW) {
        int it = it0;
        if (PART == 1) { if (it >= U0) it += U1 - U0; if (it >= D0) it += I3; }
        int r = it;
        if (r < I0) { const int nb = r % 192, kb = r / 192; cvt_item_now(p.in[I_WADA], NADA, (bf16_t*)(ws + WS_WADA), DM, 64 * kb, 64 * nb, 64 * nb, scr, lane); continue; } r -= I0;
        if (r < I1) { const int nb = r % 112, kb = r / 112; cvt_item_now(p.in[I_WIN], INW, (bf16_t*)(ws + WS_WIN), DM, 64 * kb, 64 * nb, 64 * nb, scr, lane); continue; } r -= I1;
        if (r < I2) { const int nb = r % 192, kb = r / 192; const int n0 = 64 * nb; const int j0 = n0 < DFF ? n0 : n0 - DFF;
            const int drow = (j0 >> 7) * 256 + (n0 < DFF ? 0 : 128) + (j0 & 127);
            cvt_item(p.in[I_WUP], 2 * DFF, (bf16_t*)(ws + WS_WUP), DM, 64 * kb, n0, drow, scr, lane); continue; } r -= I2;
        if (r < I3) { const int nb = r % 32, kb = r / 32; cvt_item(p.in[I_WDOWN], DM, (bf16_t*)(ws + WS_WDOWN), DFF, 64 * kb, 64 * nb, 64 * nb, scr, lane); continue; } r -= I3;
        if (r < I4) { const int nb = r % 32, kb = r / 32; cvt_item(p.in[I_WOUT], DM, (bf16_t*)(ws + WS_WOUT), DM, 64 * kb, 64 * nb, 64 * nb, scr, lane); continue; } r -= I4;
        if (r < I5) { const int nb = r % 32, kb = r / 32; cvt_item(p.in[I_WLU], DM, (bf16_t*)(ws + WS_WLU), LW, 64 * kb, 64 * nb, 64 * nb, scr, lane); continue; } r -= I5;
        if (r < I6) { const int nb = r % 32, kb = r / 32; cvt_item(p.in[I_WPU], DM, (bf16_t*)(ws + WS_WPU), PW, 64 * kb, 64 * nb, 64 * nb, scr, lane); continue; } r -= I6;
        if (r < I7) { const int g = r >> 4, q = r & 15, kb = q >> 2, nb = q & 3;
            cvt_item(p.in[I_WGRP] + (size_t)g * 65536, 256, (bf16_t*)(ws + WS_WGRP) + (size_t)g * 65536, 256, 64 * kb, 64 * nb, 64 * nb, scr, lane); continue; } r -= I7;
        { const bool isig = r >= I8; if (isig) r -= I8;
          const int blk = r >> 4, q = r & 15, kb = q >> 2, nb = q & 3, n0 = 64 * nb;
          const int drow = (blk * 2 + (n0 >> 7)) * 256 + (isig ? 128 : 0) + (n0 & 127);
          cvt_item(p.in[isig ? I_WIG : I_WRG] + (size_t)blk * 65536, 256, (bf16_t*)(ws + WS_WGATE), 256, 64 * kb, n0, drow, scr, lane); }
    }
    if (PART != 0) return;
    bf16_t* sada = (bf16_t*)(ws + WS_SADA);
    for (int i = gt; i < 256 * DM; i += NGT) { const int r = i >> 11, k = i & 2047;
        float v = 0.f; if (r < 4) v = p.in[I_CP][r * DM + k]; else if (r < NSEQ) v = p.in[I_CS][(r - 4) * DM + k];
        const float s = v * sigmoidf_(v);
        sada[i] = (bf16_t)(pk2(s, s) & 0xffffu); }
    float* spl = (float*)(ws + WS_CTL);
    for (int i = gt; i < LW; i += NGT) spl[i] = log1pf(expf(-p.in[I_LAM][i]));
}

__device__ __forceinline__ const float* xrow_ptr(const Params& p, int row) { return row < MPROMPT ? p.in[I_XP] + (size_t)row * DM : p.in[I_XS] + (size_t)(row - MPROMPT) * DM; }

__device__ __forceinline__ void norm1_row(const Params& p, const f32x4 (&v)[8], const f32x4 (&sc)[8], const f32x4 (&sh)[8], int row, int lane) {
    bf16_t* H = (bf16_t*)(p.ws + WS_H);
    float ss = 0.f;
#pragma unroll
    for (int j = 0; j < 8; ++j) ss += (v[j].x * v[j].x + v[j].y * v[j].y) + (v[j].z * v[j].z + v[j].w * v[j].w);
    const float rstd = 1.0f / sqrtf(wave_sum(ss) * (1.0f / DM) + EPS);
#pragma unroll
    for (int j = 0; j < 8; ++j) { const int col = 4 * lane + 256 * j;
        const f32x4 h = v[j] * rstd * sc[j] + sh[j];
        u32x2 w; w.x = pk2(h.x, h.y); w.y = pk2(h.z, h.w);
        *(u32x2*)(H + (size_t)row * DM + col) = w; }
}
__device__ __forceinline__ void phase_norm1(const Params& p) {
    const int tid = threadIdx.x, lane = tid & 63, wave = tid >> 6;
    const int gw = blockIdx.x * NWAVES + wave, NGW = gridDim.x * NWAVES;
    const float* ada = (const float*)(p.ws + WS_ADA);
    f32x4 v[8], vn[8];
    if (gw < MPROMPT) { const f32x4* xr = (const f32x4*)(p.in[I_XP] + (size_t)gw * DM) + lane;
#pragma unroll
        for (int j = 0; j < 8; ++j) v[j] = __builtin_nontemporal_load(xr + 64 * j); }
    for (int row = gw; row < MPROMPT; row += NGW) {
        const float* ar = ada + (size_t)(row >> 11) * NADA;
        f32x4 sc[8], sh[8];
#pragma unroll
        for (int j = 0; j < 8; ++j) { const int col = 4 * lane + 256 * j; sc[j] = *(const f32x4*)(ar + DM + col); sh[j] = *(const f32x4*)(ar + col); }
        if (row + NGW < MPROMPT) { const f32x4* xr = (const f32x4*)(p.in[I_XP] + (size_t)(row + NGW) * DM) + lane;
#pragma unroll
            for (int j = 0; j < 8; ++j) vn[j] = __builtin_nontemporal_load(xr + 64 * j); }
        norm1_row(p, v, sc, sh, row, lane);
#pragma unroll
        for (int j = 0; j < 8; ++j) v[j] = vn[j];
    }
    for (int row = MPROMPT + (gw >> 1); (gw & 1) == 0 && row < MTOK; row += (NGW >> 1)) {
        const float* ar = ada + (size_t)seq_of_row(row) * NADA; const f32x4* xr = (const f32x4*)xrow_ptr(p, row) + lane;
        f32x4 x[8], sc[8], sh[8];
#pragma unroll
        for (int j = 0; j < 8; ++j) { const int col = 4 * lane + 256 * j; x[j] = __builtin_nontemporal_load(xr + 64 * j); sc[j] = *(const f32x4*)(ar + DM + col); sh[j] = *(const f32x4*)(ar + col); }
        norm1_row(p, x, sc, sh, row, lane);
    }
}

__device__ __forceinline__ void ld8f(const float* p, float (&x)[8]) { const f32x4 a = *(const f32x4*)p, c = *(const f32x4*)(p + 4); x[0] = a.x; x[1] = a.y; x[2] = a.z; x[3] = a.w; x[4] = c.x; x[5] = c.y; x[6] = c.z; x[7] = c.w; }
template <int W> __device__ __forceinline__ void pool_run(const bf16_t* zp, bf16_t* dp, int t0) {
    u32x2 raw[15 + W];
#pragma unroll
    for (int i = 0; i < 15 + W; ++i) { const int rr = i - (W - 1); raw[i] = (u32x2){0u, 0u}; if (t0 + rr >= 0) raw[i] = *(const u32x2*)(zp + (ptrdiff_t)rr * INW); }
    float s[4] = {0.f, 0.f, 0.f, 0.f};
#pragma unroll
    for (int i = 0; i < W - 1; ++i) { s[0] += bflo(raw[i].x); s[1] += bfhi(raw[i].x); s[2] += bflo(raw[i].y); s[3] += bfhi(raw[i].y); }
#pragma unroll
    for (int i = 0; i < 16; ++i) { const u32x2 cu = raw[i + W - 1]; const float u0 = bflo(cu.x), u1 = bfhi(cu.x), u2 = bflo(cu.y), u3 = bfhi(cu.y);
        s[0] += u0; s[1] += u1; s[2] += u2; s[3] += u3;
        const int t = t0 + i; const float inv = 1.0f / (float)((t + 1) < W ? (t + 1) : W);
        u32x2 o; o.x = pk2(s[0] * inv - u0, s[1] * inv - u1); o.y = pk2(s[2] * inv - u2, s[3] * inv - u3);
        *(u32x2*)(dp + (size_t)i * PW) = o;
        const u32x2 od = raw[i]; s[0] -= bflo(od.x); s[1] -= bfhi(od.x); s[2] -= bflo(od.y); s[3] -= bfhi(od.y); }
}
__device__ __forceinline__ void phase_mixprep(const Params& p) {
    const int gt = blockIdx.x * NTHREADS + threadIdx.x, NGT = gridDim.x * NTHREADS;
    const bf16_t* Z = (const bf16_t*)(p.ws + WS_Z); bf16_t* Dp = (bf16_t*)(p.ws + WS_DP); bf16_t* XC = (bf16_t*)(p.ws + WS_XC);
    for (int it = gt; it < (MPROMPT / 16) * 256; it += NGT) {
        const int c4 = it & 255, run = it >> 8, ch0 = 4 * c4, g = ch0 >> 8, r0 = run * 16, t0 = r0 & (SEQ - 1);
        const bf16_t* zp = Z + (size_t)r0 * INW + ch0;
        switch (g) { case 0: pool_run<2>(zp, Dp + (size_t)r0 * PW + ch0, t0); break; case 1: pool_run<4>(zp, Dp + (size_t)r0 * PW + ch0, t0); break;
                     case 2: pool_run<8>(zp, Dp + (size_t)r0 * PW + ch0, t0); break; default: pool_run<16>(zp, Dp + (size_t)r0 * PW + ch0, t0); break; }
    }
    for (int it = gt; it < 1024 * 128; it += NGT) {
        const int row = MPROMPT + (it >> 7), ch0 = (it & 127) * 8, g = ch0 >> 8, w = 2 << g;
        const int b = (row - MPROMPT) >> 3, t = (row - MPROMPT) & 7;
        u32x4 zr[8]; f32x4 sa[15], sb[15];
#pragma unroll
        for (int j = 0; j < 8; ++j) { zr[j] = (u32x4){0u, 0u, 0u, 0u}; if (j <= t && j < w) zr[j] = *(const u32x4*)(Z + (size_t)(row - j) * INW + ch0); }
#pragma unroll
        for (int k = 0; k < 15; ++k) { const int j = t + 15 - k;
            sa[k] = (f32x4){0.f, 0.f, 0.f, 0.f}; sb[k] = sa[k];
            if (j < w) { const float* sp = p.in[I_SPOOL] + ((size_t)b * 15 + k) * PW + ch0; sa[k] = *(const f32x4*)sp; sb[k] = *(const f32x4*)(sp + 4); } }
        float s[8], u[8]; unpack8(zr[0], u);
#pragma unroll
        for (int e = 0; e < 8; ++e) s[e] = u[e];
#pragma unroll
        for (int j = 1; j < 8; ++j) { float x[8]; unpack8(zr[j], x);
#pragma unroll
            for (int e = 0; e < 8; ++e) s[e] += x[e]; }
#pragma unroll
        for (int k = 0; k < 15; ++k) { s[0] += sa[k].x; s[1] += sa[k].y; s[2] += sa[k].z; s[3] += sa[k].w; s[4] += sb[k].x; s[5] += sb[k].y; s[6] += sb[k].z; s[7] += sb[k].w; }
        const float inv = 1.0f / (float)w; float d[8];
#pragma unroll
        for (int e = 0; e < 8; ++e) d[e] = s[e] * inv - u[e];
        *(u32x4*)(Dp + (size_t)row * PW + ch0) = pack8(d);
    }
    for (int it = gt; it < (MPROMPT / 8) * 256; it += NGT) {
        const int c8 = it & 255, run = it >> 8, ch0 = 8 * c8, r0 = run * 8, t0 = r0 & (SEQ - 1);
        u32x4 raw[11];
#pragma unroll
        for (int i = 0; i < 11; ++i) { const int tt = t0 - 3 + i; raw[i] = (u32x4){0u, 0u, 0u, 0u}; if (tt >= 0) raw[i] = *(const u32x4*)(Z + (size_t)(r0 - 3 + i) * INW + PW + ch0); }
        float wk[4][8], bb[8];
#pragma unroll
        for (int k = 0; k < 4; ++k) ld8f(p.in[I_WLCONV] + (size_t)k * LW + ch0, wk[k]);
        ld8f(p.in[I_BLCONV] + ch0, bb);
        float x0[8], x1[8], x2[8], x3[8];
        unpack8(raw[0], x0); unpack8(raw[1], x1); unpack8(raw[2], x2);
#pragma unroll
        for (int i = 0; i < 8; ++i) { unpack8(raw[3 + i], x3); float o[8];
#pragma unroll
            for (int e = 0; e < 8; ++e) { o[e] = bb[e] + x0[e] * wk[0][e] + x1[e] * wk[1][e] + x2[e] * wk[2][e] + x3[e] * wk[3][e]; x0[e] = x1[e]; x1[e] = x2[e]; x2[e] = x3[e]; }
            *(u32x4*)(XC + (size_t)(r0 + i) * LW + ch0) = pack8(o); }
    }
    for (int it = gt; it < 1024 * 256; it += NGT) {
        const int row = MPROMPT + (it >> 8), ch0 = (it & 255) * 8;
        float acc[8]; ld8f(p.in[I_BLCONV] + ch0, acc);
        const int t = (row - MPROMPT) & 7, b = (row - MPROMPT) >> 3;
#pragma unroll
        for (int k = 0; k < 4; ++k) { const int tt = t - 3 + k; float x[8];
            if (tt >= 0) unpack8(*(const u32x4*)(Z + (size_t)(row - 3 + k) * INW + PW + ch0), x);
            else ld8f(p.in[I_SLCONV] + ((size_t)b * 3 + (3 + tt)) * LW + ch0, x);
            float wv[8]; ld8f(p.in[I_WLCONV] + (size_t)k * LW + ch0, wv);
#pragma unroll
            for (int e = 0; e < 8; ++e) acc[e] += x[e] * wv[e]; }
        *(u32x4*)(XC + (size_t)row * LW + ch0) = pack8(acc);
    }
    float* out = p.out;
    for (int i = gt; i < 4 * 15 * PW / 8; i += NGT) { const int ch = (i & 127) * 8, q = i >> 7, b = q / 15, r = q % 15;
        float x[8]; unpack8(*(const u32x4*)(Z + (size_t)(b * SEQ + SEQ - 15 + r) * INW + ch), x);
        float* o = out + O_POOLP + (size_t)q * PW + ch; *(f32x4*)o = (f32x4){x[0], x[1], x[2], x[3]}; *(f32x4*)(o + 4) = (f32x4){x[4], x[5], x[6], x[7]}; }
    for (int i = gt; i < 128 * 15 * PW / 8; i += NGT) { const int ch = (i & 127) * 8, q = i >> 7, b = q / 15, r = q % 15;
        float x[8];
        if (r < 7) ld8f(p.in[I_SPOOL] + ((size_t)b * 15 + 8 + r) * PW + ch, x); else unpack8(*(const u32x4*)(Z + (size_t)(MPROMPT + b * 8 + r - 7) * INW + ch), x);
        float* o = out + O_POOLS + (size_t)q * PW + ch; *(f32x4*)o = (f32x4){x[0], x[1], x[2], x[3]}; *(f32x4*)(o + 4) = (f32x4){x[4], x[5], x[6], x[7]}; }
    for (int i = gt; i < 4 * 3 * LW / 8; i += NGT) { const int ch = (i & 255) * 8, q = i >> 8, b = q / 3, r = q % 3;
        float x[8]; unpack8(*(const u32x4*)(Z + (size_t)(b * SEQ + SEQ - 3 + r) * INW + PW + ch), x);
        float* o = out + O_LCONVP + (size_t)q * LW + ch; *(f32x4*)o = (f32x4){x[0], x[1], x[2], x[3]}; *(f32x4*)(o + 4) = (f32x4){x[4], x[5], x[6], x[7]}; }
    for (int i = gt; i < 128 * 3 * LW / 8; i += NGT) { const int ch = (i & 255) * 8, q = i >> 8, b = q / 3, r = q % 3;
        float x[8]; unpack8(*(const u32x4*)(Z + (size_t)(MPROMPT + b * 8 + 5 + r) * INW + PW + ch), x);
        float* o = out + O_LCONVS + (size_t)q * LW + ch; *(f32x4*)o = (f32x4){x[0], x[1], x[2], x[3]}; *(f32x4*)(o + 4) = (f32x4){x[4], x[5], x[6], x[7]}; }
}

__device__ __forceinline__ void phase_scan(const Params& p, LAS unsigned char* lds) {
    const int tid = threadIdx.x;
    const unsigned* LU = (const unsigned*)(p.ws + WS_LA); bf16_t* YL = (bf16_t*)(p.ws + WS_YL);
    LAS float* sA = (LAS float*)lds; LAS float* sH = sA + 512;
    for (int item = blockIdx.x; item < 256; item += gridDim.x) {
        const int b = item >> 6, c32 = tid & 31, ch = (item & 63) * 32 + c32, chunk = tid >> 5;
        const size_t base = (size_t)(b * SEQ + chunk * 128) * LW + ch;
        float h = 0.f, sla = 0.f;
#pragma unroll 8
        for (int s = 0; s < 128; ++s) { const unsigned lw = LU[base + (size_t)s * LW]; const float la = bflo(lw), u = bfhi(lw); h = __expf(la) * h + u; sla += la; }
        sA[chunk * 32 + c32] = __expf(sla); sH[chunk * 32 + c32] = h;
        __syncthreads();
        float hin = 0.f;
        for (int j = 0; j < chunk; ++j) hin = sA[j * 32 + c32] * hin + sH[j * 32 + c32];
        h = hin;
#pragma unroll 8
        for (int s = 0; s < 128; ++s) { const unsigned lw = LU[base + (size_t)s * LW]; const float la = bflo(lw), u = bfhi(lw); h = __expf(la) * h + u;
            YL[base + (size_t)s * LW] = (bf16_t)(pk2(h, h) & 0xffffu); }
        if (chunk == 15) p.out[O_LHP + b * LW + ch] = h;
        __syncthreads();
    }
    const int gt = blockIdx.x * NTHREADS + tid, NGT = gridDim.x * NTHREADS;
    for (int i = gt; i < 128 * LW; i += NGT) { const int b = i >> 11, ch = i & 2047;
        float h = p.in[I_SLH][i]; const size_t base = (size_t)(MPROMPT + b * 8) * LW + ch;
#pragma unroll
        for (int s = 0; s < 8; ++s) { const unsigned lw = LU[base + (size_t)s * LW]; const float la = bflo(lw), u = bfhi(lw); h = __expf(la) * h + u;
            YL[base + (size_t)s * LW] = (bf16_t)(pk2(h, h) & 0xffffu); }
        p.out[O_LHS + i] = h; }
}

__device__ __forceinline__ void load_mo_row(f32x4 (&v)[8], const bf16_t* Ob, const float* Os, int row, int lane) {
    if (row < MPROMPT) { const u32x2* mr = (const u32x2*)(Ob + (size_t)row * DM) + lane;
#pragma unroll
        for (int j = 0; j < 8; ++j) { const u32x2 w = __builtin_nontemporal_load(mr + 64 * j); v[j] = (f32x4){bflo(w.x), bfhi(w.x), bflo(w.y), bfhi(w.y)}; } }
    else { const f32x4* mr = (const f32x4*)(Os + (size_t)(row - MPROMPT) * DM) + lane;
#pragma unroll
        for (int j = 0; j < 8; ++j) v[j] = __builtin_nontemporal_load(mr + 64 * j);
#pragma unroll 1
        for (int k0 = 1; k0 < 8; k0 += 4) { f32x4 t[4][8];
#pragma unroll
            for (int q = 0; q < 4; ++q)
#pragma unroll
                for (int j = 0; j < 8; ++j) t[q][j] = (k0 + q < 8) ? mr[(size_t)(k0 + q) * (1024 * DM / 4) + 64 * j] : (f32x4){0.f, 0.f, 0.f, 0.f};
#pragma unroll
            for (int q = 0; q < 4; ++q)
#pragma unroll
                for (int j = 0; j < 8; ++j) v[j] += t[q][j]; } }
}
__device__ __forceinline__ void mid_row(const Params& p, const f32x4 (&x)[8], f32x4 (&v)[8], const f32x4 (&G1)[8], const f32x4 (&S2)[8], const f32x4 (&sh2)[8], int row, int lane) {
    bf16_t* H = (bf16_t*)(p.ws + WS_H2);
    float ss = 0.f;
#pragma unroll
    for (int j = 0; j < 8; ++j) ss += (v[j].x * v[j].x + v[j].y * v[j].y) + (v[j].z * v[j].z + v[j].w * v[j].w);
    const float rstd = 1.0f / sqrtf(wave_sum(ss) * (1.0f / DM) + EPS);
    float ss2 = 0.f;
#pragma unroll
    for (int j = 0; j < 8; ++j) { const int col = 4 * lane + 256 * j;
        v[j] = x[j] + G1[j] * (v[j] * rstd);
        __builtin_nontemporal_store(v[j], (f32x4*)(p.out + (size_t)row * DM + col));
        ss2 += (v[j].x * v[j].x + v[j].y * v[j].y) + (v[j].z * v[j].z + v[j].w * v[j].w); }
    const float rstd2 = 1.0f / sqrtf(wave_sum(ss2) * (1.0f / DM) + EPS);
#pragma unroll
    for (int j = 0; j < 8; ++j) { const int col = 4 * lane + 256 * j;
        const f32x4 h = v[j] * rstd2 * S2[j] + sh2[j];
        u32x2 w; w.x = pk2(h.x, h.y); w.y = pk2(h.z, h.w);
        *(u32x2*)(H + (size_t)row * DM + col) = w; }
}
__device__ __forceinline__ void phase_mid(const Params& p) {
    const int tid = threadIdx.x, lane = tid & 63, wave = tid >> 6;
    const int gw = blockIdx.x * NWAVES + wave, NGW = gridDim.x * NWAVES;
    const float* ada = (const float*)(p.ws + WS_ADA);
    const bf16_t* Ob = (const bf16_t*)(p.ws + WS_MO); const float* Os = (const float*)(p.ws + WS_MOS);
    {
        f32x4 x[8], xn[8]; u32x2 mb[8], mbn[8];
        if (gw < MPROMPT) { const f32x4* xr = (const f32x4*)(p.in[I_XP] + (size_t)gw * DM) + lane; const u32x2* mr = (const u32x2*)(Ob + (size_t)gw * DM) + lane;
#pragma unroll
            for (int j = 0; j < 8; ++j) { x[j] = __builtin_nontemporal_load(xr + 64 * j); mb[j] = __builtin_nontemporal_load(mr + 64 * j); } }
        for (int row = gw; row < MPROMPT; row += NGW) {
            const float* ar = ada + (size_t)(row >> 11) * NADA;
            f32x4 G1[8], S2[8], sh2[8];
#pragma unroll
            for (int j = 0; j < 8; ++j) { const int col = 4 * lane + 256 * j; G1[j] = *(const f32x4*)(ar + 2 * DM + col); }
            if (row + NGW < MPROMPT) { const f32x4* xr = (const f32x4*)(p.in[I_XP] + (size_t)(row + NGW) * DM) + lane; const u32x2* mr = (const u32x2*)(Ob + (size_t)(row + NGW) * DM) + lane;
#pragma unroll
                for (int j = 0; j < 8; ++j) { xn[j] = __builtin_nontemporal_load(xr + 64 * j); mbn[j] = __builtin_nontemporal_load(mr + 64 * j); } }
#pragma unroll
            for (int j = 0; j < 8; ++j) { const int col = 4 * lane + 256 * j; S2[j] = *(const f32x4*)(ar + 4 * DM + col); sh2[j] = *(const f32x4*)(ar + 3 * DM + col); }
            f32x4 v[8];
#pragma unroll
            for (int j = 0; j < 8; ++j) v[j] = (f32x4){bflo(mb[j].x), bfhi(mb[j].x), bflo(mb[j].y), bfhi(mb[j].y)};
            mid_row(p, x, v, G1, S2, sh2, row, lane);
#pragma unroll
            for (int j = 0; j < 8; ++j) { x[j] = xn[j]; mb[j] = mbn[j]; }
        }
    }
    for (int row = MPROMPT + (gw >> 1); (gw & 1) == 0 && row < MTOK; row += (NGW >> 1)) {
        const float* ar = ada + (size_t)seq_of_row(row) * NADA;
        f32x4 v[8]; load_mo_row(v, Ob, Os, row, lane);
        f32x4 x[8], G1[8], S2[8], sh2[8]; const f32x4* xr = (const f32x4*)xrow_ptr(p, row) + lane;
#pragma unroll
        for (int j = 0; j < 8; ++j) { const int col = 4 * lane + 256 * j; x[j] = __builtin_nontemporal_load(xr + 64 * j); G1[j] = *(const f32x4*)(ar + 2 * DM + col); S2[j] = *(const f32x4*)(ar + 4 * DM + col); sh2[j] = *(const f32x4*)(ar + 3 * DM + col); }
        mid_row(p, x, v, G1, S2, sh2, row, lane);
    }
}

__device__ __forceinline__ void phase_ffnconv(const Params& p) {
    const int gt = blockIdx.x * NTHREADS + threadIdx.x, NGT = gridDim.x * NTHREADS;
    const bf16_t* UP = (const bf16_t*)(p.ws + WS_UP); bf16_t* F = (bf16_t*)(p.ws + WS_F2);
    constexpr int NCH = DFF / 8;
    const bf16_t* UPB = (const bf16_t*)(p.ws + WS_UPB);
    for (int it = gt; it < 128 * 2 * NCH; it += NGT) {
        const int c = it % NCH, q = it / NCH, sl = q & 1, blk = q >> 1, j0 = 8 * c, colg = (j0 >> 7) * 256 + (j0 & 127);
        const int row = blk * 64 + sl; const bool first = (blk & 31) == 0;
        float wg[3][8], wv[3][8], ag[8], av[8];
#pragma unroll
        for (int k = 0; k < 3; ++k) { ld8f(p.in[I_WFCONV] + (size_t)k * 2 * DFF + j0, wg[k]); ld8f(p.in[I_WFCONV] + (size_t)k * 2 * DFF + DFF + j0, wv[k]); }
        ld8f(p.in[I_BFCONV] + j0, ag); ld8f(p.in[I_BFCONV] + DFF + j0, av);
#pragma unroll
        for (int k = 0; k < 3; ++k) { const int d = k - 2 + sl;
            if (d < 0 && first) continue;
            const size_t ub = d < 0 ? (size_t)((blk - 1) * 4 + 4 + d) : (size_t)(blk * 4 + d);
            float xg[8], xv[8]; unpack8(*(const u32x4*)(UPB + ub * (2 * DFF) + colg), xg); unpack8(*(const u32x4*)(UPB + ub * (2 * DFF) + colg + 128), xv);
#pragma unroll
            for (int e = 0; e < 8; ++e) { ag[e] += xg[e] * wg[k][e]; av[e] += xv[e] * wv[k][e]; } }
        float f[8];
#pragma unroll
        for (int e = 0; e < 8; ++e) f[e] = gelu_tanh(ag[e]) * av[e];
        *(u32x4*)(F + (size_t)row * DFF + j0) = pack8(f);
    }
    if (gt < 170 * NCH) {
        const int c = gt % NCH, slot = gt / NCH, j0 = 8 * c, colg = (j0 >> 7) * 256 + (j0 & 127);
        float wg[3][8], wv[3][8], bg[8], bv[8];
#pragma unroll
        for (int k = 0; k < 3; ++k) { ld8f(p.in[I_WFCONV] + (size_t)k * 2 * DFF + j0, wg[k]); ld8f(p.in[I_WFCONV] + (size_t)k * 2 * DFF + DFF + j0, wv[k]); }
        ld8f(p.in[I_BFCONV] + j0, bg); ld8f(p.in[I_BFCONV] + DFF + j0, bv);
        for (int rs = slot; rs < 1024; rs += 170) {
            const int row = MPROMPT + rs, t = rs & 7, b = rs >> 3;
            float xg[3][8], xv[3][8];
#pragma unroll
            for (int k = 0; k < 3; ++k) { const int tt = t - 2 + k;
                if (tt >= 0) { unpack8(*(const u32x4*)(UP + (size_t)(row - 2 + k) * 2 * DFF + colg), xg[k]); unpack8(*(const u32x4*)(UP + (size_t)(row - 2 + k) * 2 * DFF + colg + 128), xv[k]); }
                else { const float* sp = p.in[I_SFCONV] + ((size_t)b * 2 + (2 + tt)) * 2 * DFF; ld8f(sp + j0, xg[k]); ld8f(sp + DFF + j0, xv[k]); } }
            float f[8];
#pragma unroll
            for (int e = 0; e < 8; ++e) { const float cg_ = bg[e] + xg[0][e] * wg[0][e] + xg[1][e] * wg[1][e] + xg[2][e] * wg[2][e];
                const float cv_ = bv[e] + xv[0][e] * wv[0][e] + xv[1][e] * wv[1][e] + xv[2][e] * wv[2][e]; f[e] = gelu_tanh(cg_) * cv_; }
            *(u32x4*)(F + (size_t)row * DFF + j0) = pack8(f);
        }
    }
    for (int i = gt; i < NSEQ * 2 * (2 * DFF / 8); i += NGT) { const int c = i % 1536, q = i / 1536, r = q & 1, s = q >> 1, n0 = 8 * c;
        const int j0 = n0 < DFF ? n0 : n0 - DFF, col = (j0 >> 7) * 256 + (n0 < DFF ? 0 : 128) + (j0 & 127);
        const int row = s < 4 ? s * SEQ + SEQ - 2 + r : MPROMPT + (s - 4) * 8 + 6 + r;
        float x[8];
        if (s < 4) unpack8(*(const u32x4*)(UPB + ((size_t)(s * 32 + 31) * 4 + 2 + r) * (2 * DFF) + col), x); else unpack8(*(const u32x4*)(UP + (size_t)row * 2 * DFF + col), x);
        float* o = p.out + (s < 4 ? O_FCONVP + ((size_t)s * 2 + r) * 2 * DFF : O_FCONVS + ((size_t)(s - 4) * 2 + r) * 2 * DFF) + n0;
        *(f32x4*)o = (f32x4){x[0], x[1], x[2], x[3]}; *(f32x4*)(o + 4) = (f32x4){x[4], x[5], x[6], x[7]}; }
}

__device__ __forceinline__ void phase_final(const Params& p) {
    const int tid = threadIdx.x, lane = tid & 63, wave = tid >> 6;
    const int gw = blockIdx.x * NWAVES + wave, NGW = gridDim.x * NWAVES;
    const float* ada = (const float*)(p.ws + WS_ADA);
    const bf16_t* Ob = (const bf16_t*)(p.ws + WS_FO); const float* Os = (const float*)(p.ws + WS_FOS2);
    {
        f32x4 x[8], xn[8]; u32x2 mb[8], mbn[8];
        if (gw < MPROMPT) { const f32x4* xr = (const f32x4*)(p.out + (size_t)gw * DM) + lane; const u32x2* mr = (const u32x2*)(Ob + (size_t)gw * DM) + lane;
#pragma unroll
            for (int j = 0; j < 8; ++j) { x[j] = __builtin_nontemporal_load(xr + 64 * j); mb[j] = __builtin_nontemporal_load(mr + 64 * j); } }
        for (int row = gw; row < MPROMPT; row += NGW) {
            const float* ar = ada + (size_t)(row >> 11) * NADA;
            f32x4 gt2[8];
#pragma unroll
            for (int j = 0; j < 8; ++j) { const int col = 4 * lane + 256 * j; gt2[j] = *(const f32x4*)(ar + 5 * DM + col); }
            if (row + NGW < MPROMPT) { const f32x4* xr = (const f32x4*)(p.out + (size_t)(row + NGW) * DM) + lane; const u32x2* mr = (const u32x2*)(Ob + (size_t)(row + NGW) * DM) + lane;
#pragma unroll
                for (int j = 0; j < 8; ++j) { xn[j] = __builtin_nontemporal_load(xr + 64 * j); mbn[j] = __builtin_nontemporal_load(mr + 64 * j); } }
            f32x4 v[8]; float ss = 0.f;
#pragma unroll
            for (int j = 0; j < 8; ++j) { v[j] = (f32x4){bflo(mb[j].x), bfhi(mb[j].x), bflo(mb[j].y), bfhi(mb[j].y)}; ss += (v[j].x * v[j].x + v[j].y * v[j].y) + (v[j].z * v[j].z + v[j].w * v[j].w); }
            const float rstd = 1.0f / sqrtf(wave_sum(ss) * (1.0f / DM) + EPS);
#pragma unroll
            for (int j = 0; j < 8; ++j) { const int col = 4 * lane + 256 * j;
                __builtin_nontemporal_store(x[j] + gt2[j] * (v[j] * rstd), (f32x4*)(p.out + (size_t)row * DM + col)); }
#pragma unroll
            for (int j = 0; j < 8; ++j) { x[j] = xn[j]; mb[j] = mbn[j]; }
        }
    }
    for (int row = MPROMPT + (gw >> 1); (gw & 1) == 0 && row < MTOK; row += (NGW >> 1)) {
        f32x4 v[8]; float ss = 0.f;
        load_mo_row(v, Ob, Os, row, lane);
#pragma unroll
        for (int j = 0; j < 8; ++j) ss += (v[j].x * v[j].x + v[j].y * v[j].y) + (v[j].z * v[j].z + v[j].w * v[j].w);
        const float rstd = 1.0f / sqrtf(wave_sum(ss) * (1.0f / DM) + EPS);
        const float* ar = ada + (size_t)seq_of_row(row) * NADA;
#pragma unroll
        for (int j = 0; j < 8; ++j) { const int col = 4 * lane + 256 * j;
            const f32x4 gt2 = *(const f32x4*)(ar + 5 * DM + col);
            float* o = p.out + (size_t)row * DM + col; const f32x4 x1 = *(const f32x4*)o;
            *(f32x4*)o = x1 + gt2 * (v[j] * rstd); }
    }
}

__global__ void __launch_bounds__(NTHREADS, 2) fwd_megakernel(Params p) {
    extern __shared__ __attribute__((aligned(16))) unsigned char lds_raw[];
    LAS unsigned char* lds = (LAS unsigned char*)lds_raw;
    cg::grid_group grid = cg::this_grid();
    unsigned char* ws = p.ws;
    if (ws == nullptr) grid.sync();
    volatile LAS unsigned* xst = (volatile LAS unsigned*)(lds + LDS_MAIN);
    if (threadIdx.x < 4) xst[threadIdx.x] = 0u;
    __syncthreads();
    const XcdBarrier xbar = xcd_barrier_post((unsigned*)(ws + WS_BAR), xst);
    const int G = gridDim.x, c = blockIdx.x;
    using namespace pg8;
    const size_t TA = 256ull * 2;

    if (PHASE_MASK & 1u) phase0<0>(p, lds);
    xcd_barrier(xbar);
    if (c < 48) {
        Sched S{(const char*)(ws + WS_SADA), (const char*)(ws + WS_WADA), TA * DM, TA * DM, 1, NADA / 256, DM / 64, G, c, 0, 0};
        EpiAda E{(float*)(ws + WS_ADA), p.in[I_BADA], p.in[I_GPRE1], p.in[I_GPOST1], p.in[I_GPRE2], p.in[I_GPOST2]};
        gemm_phase(lds, DM, DM, S, E);
        if (threadIdx.x == 0) { __builtin_amdgcn_fence(__ATOMIC_RELEASE, "agent"); asm volatile("s_waitcnt vmcnt(0)" ::: "memory");
            __hip_atomic_fetch_add((unsigned*)(ws + WS_BAR) + ADA_FLAG, 1u, __ATOMIC_RELAXED, __HIP_MEMORY_SCOPE_AGENT); }
    } else phase0<1>(p, lds);
    if (threadIdx.x == 0) { unsigned* f = (unsigned*)(ws + WS_BAR) + ADA_FLAG; unsigned sp = 0;
        while (__hip_atomic_load(f, __ATOMIC_RELAXED, __HIP_MEMORY_SCOPE_AGENT) < 48u) { __builtin_amdgcn_s_sleep(2); if (++sp > (1u << 20)) break; }
        __builtin_amdgcn_fence(__ATOMIC_ACQUIRE, "agent"); asm volatile("s_waitcnt vmcnt(0)" ::: "memory"); }
    __syncthreads();
    if (PHASE_MASK & 4u) phase_norm1(p);
    xcd_barrier(xbar);
    if (PHASE_MASK & 8u) {
        Sched S{(const char*)(ws + WS_H), (const char*)(ws + WS_WIN), TA * DM, TA * DM, MTOK / 256, INW / 256, DM / 64, G, c, 0, 0};
        EpiBf16 E{(bf16_t*)(ws + WS_Z), INW, 12};
        gemm_phase(lds, DM, DM, S, E);
    }
    xcd_barrier(xbar);
    if (PHASE_MASK & 16u) phase_mixprep(p);
    xcd_barrier(xbar);
    if (PHASE_MASK & 32u) {
        { Sched S{(const char*)(ws + WS_DP), (const char*)(ws + WS_WGRP), TA * PW, TA * 256, MTOK / 256, 4, 4, G, c, 0, 512};
          EpiPool E{(bf16_t*)(ws + WS_YP), p.in[I_PSCALE]};
          gemm_phase(lds, PW, 256, S, E); }
        { Sched S{(const char*)(ws + WS_XC), (const char*)(ws + WS_WGATE), TA * LW, TA * 256, MTOK / 256, 16, 4, G, (c + 80) & 255, 1, 512};
          EpiGates E{(const bf16_t*)(ws + WS_XC), (unsigned*)(ws + WS_LA), p.in[I_BRG], p.in[I_BIG], (const float*)(ws + WS_CTL)};
          gemm_phase(lds, LW, 256, S, E); }
    }
    xcd_barrier(xbar);
    if (PHASE_MASK & 64u) phase_scan(p, lds);
    xcd_barrier(xbar);
    if (PHASE_MASK & 128u) {
        { SchedP7 S{Sched{(const char*)(ws + WS_YP), (const char*)(ws + WS_WPU), TA * PW, TA * PW, 32, DM / 256, PW / 64, G, c, 0, 0}, 0, 1000};
          EpiMerge<false> E{(bf16_t*)(ws + WS_MG), (const bf16_t*)(ws + WS_Z), PW + LW, (unsigned*)(ws + WS_BAR)};
          gemm_phase(lds, PW, PW, S, E); }
        { SchedP7 S{Sched{(const char*)(ws + WS_YL), (const char*)(ws + WS_WLU), TA * LW, TA * LW, 32, DM / 256, LW / 64, G, c, 0, 0}, 32, 2000};
          EpiMerge<true> E{(bf16_t*)(ws + WS_MG), (const bf16_t*)(ws + WS_Z), PW + LW + DM, (unsigned*)(ws + WS_BAR)};
          gemm_phase(lds, LW, LW, S, E); }
        phase0<2>(p, lds);
    }
    xcd_barrier(xbar);
    if (PHASE_MASK & 256u) {
        SchedSplit S{Sched{(const char*)(ws + WS_MG), (const char*)(ws + WS_WOUT), TA * DM, TA * DM, 32, DM / 256, DM / 64, G, c, 0, 0}, 4, 0, 8, 0};
        EpiOut E{(bf16_t*)(ws + WS_MO), (float*)(ws + WS_MOS)};
        gemm_phase(lds, DM, DM, S, E);
    }
    xcd_barrier(xbar);
    if (PHASE_MASK & 512u) phase_mid(p);
    xcd_barrier(xbar);
    if (PHASE_MASK & 1024u) {
        Sched S{(const char*)(ws + WS_H2), (const char*)(ws + WS_WUP), TA * DM, TA * DM, MTOK / 256, 2 * DFF / 256, DM / 64, G, c, 0, 0};
        EpiUpFused E{(bf16_t*)(ws + WS_UP), (bf16_t*)(ws + WS_F2), (bf16_t*)(ws + WS_UPB), p.in[I_WFCONV], p.in[I_BFCONV]};
        gemm_phase(lds, DM, DM, S, E);
        phase0<3>(p, lds);
    }
    xcd_barrier(xbar);
    if (PHASE_MASK & 2048u) phase_ffnconv(p);
    xcd_barrier(xbar);
    if (PHASE_MASK & 4096u) {
        SchedSplit S{Sched{(const char*)(ws + WS_F2), (const char*)(ws + WS_WDOWN), TA * DFF, TA * DFF, 32, DM / 256, DFF / 64, G, c, 0, 0}, 12, 0, 8, 0};
        EpiOut E{(bf16_t*)(ws + WS_FO), (float*)(ws + WS_FOS2)};
        gemm_phase(lds, DFF, DFF, S, E);
    }
    xcd_barrier(xbar);
    if (PHASE_MASK & 8192u) phase_final(p);
}

extern "C" void kernel_launch(void* const* d_in, const int* in_sizes, int n_in, void* d_out, int out_size, void* d_ws, size_t ws_size, hipStream_t stream) {
    constexpr size_t kDynLds = LDS_MAIN + 64;
    static int grid_blocks = 0;
    if (!grid_blocks) {
        int dev = 0, cus = 0, per_cu = 0;
        (void)hipGetDevice(&dev);
        (void)hipDeviceGetAttribute(&cus, hipDeviceAttributeMultiprocessorCount, dev);
        (void)hipFuncSetAttribute((const void*)fwd_megakernel, hipFuncAttributeMaxDynamicSharedMemorySize, (int)kDynLds);
        (void)hipOccupancyMaxActiveBlocksPerMultiprocessor(&per_cu, (const void*)fwd_megakernel, NTHREADS, kDynLds);
        if (per_cu < 1) per_cu = 1;
        grid_blocks = cus;
        if (n_in != N_IN) fprintf(stderr, "kernel_launch: expected %d inputs, got %d\n", (int)N_IN, n_in);
    }
    Params p{};
    for (int i = 0; i < N_IN; ++i) p.in[i] = (const float*)d_in[i];
    p.out = (float*)d_out; p.ws = (unsigned char*)d_ws;
    (void)hipMemsetAsync((unsigned char*)d_ws + WS_BAR, 0, BAR_ZERO_WORDS * 4, stream);
    void* args[] = {&p};
    hipError_t e = hipLaunchCooperativeKernel((const void*)fwd_megakernel, dim3(grid_blocks), dim3(NTHREADS), args, kDynLds, stream);
    if (e != hipSuccess) fprintf(stderr, "cooperative launch failed: %s (grid %d)\n", hipGetErrorString(e), grid_blocks);
}
```

```cpp
#include <hip/hip_runtime.h>
#include <hip/hip_cooperative_groups.h>
#include <cstdio>
namespace cg = cooperative_groups;

#define LAS __attribute__((address_space(3)))
typedef unsigned short bf16_t;
typedef short bf16x8 __attribute__((ext_vector_type(8)));
typedef float f32x4 __attribute__((ext_vector_type(4)));
typedef float f32x2 __attribute__((ext_vector_type(2)));
typedef unsigned u32x4 __attribute__((ext_vector_type(4)));
typedef unsigned u32x2 __attribute__((ext_vector_type(2)));

#ifndef PHASE_MASK
#define PHASE_MASK 0xFFFFFFFFu
#endif

constexpr int DM = 2048, MTOK = 9216, MPROMPT = 8192, SEQ = 2048, NSEQ = 132;
constexpr int PW = 1024, LW = 2048, INW = 7168, DFF = 6144, NADA = 12288;
constexpr float EPS = 1e-6f;
constexpr int NTHREADS = 512, NWAVES = 8;

enum { I_XP = 0, I_XS, I_CP, I_CS, I_SPOOL, I_SLCONV, I_SLH, I_SFCONV, I_WADA, I_BADA, I_GPRE1, I_GPOST1, I_GPRE2, I_GPOST2,
       I_WIN, I_WGRP, I_PSCALE, I_WLCONV, I_BLCONV, I_WRG, I_BRG, I_WIG, I_BIG, I_LAM, I_WPU, I_WLU, I_WOUT, I_WUP, I_WFCONV, I_BFCONV, I_WDOWN, N_IN };

constexpr size_t O_YP = 0, O_YS = 16777216, O_POOLP = 18874368, O_LCONVP = O_POOLP + 61440, O_LHP = O_LCONVP + 24576, O_FCONVP = O_LHP + 8192,
                 O_POOLS = O_FCONVP + 98304, O_LCONVS = O_POOLS + 1966080, O_LHS = O_LCONVS + 786432, O_FCONVS = O_LHS + 262144;

constexpr size_t MiB = 1ull << 20;
constexpr size_t WS_ADA = 0, WS_CTL = 12 * MiB, WS_SADA = 13 * MiB, WS_WDOWN = 14 * MiB, WS_WUP = 38 * MiB,
                 WS_WGRP = 86 * MiB, WS_WGATE = 86 * MiB + 512 * 1024, WS_WPU = 89 * MiB, WS_WLU = 93 * MiB, WS_WOUT = 101 * MiB,
                 WS_WADA = 109 * MiB, WS_WIN = 157 * MiB, WS_H = 185 * MiB, WS_Z = 221 * MiB, WS_DP = 347 * MiB, WS_XC = 365 * MiB, WS_YP = 401 * MiB,
                 WS_LA = 109 * MiB, WS_UU = 181 * MiB, WS_YL = 347 * MiB, WS_MG = 109 * MiB, WS_MO = 221 * MiB, WS_UP = 221 * MiB, WS_F = 109 * MiB;

constexpr size_t WS_BAR = WS_CTL + 64 * 1024;
constexpr size_t WS_MOS = 253 * MiB;
constexpr size_t WS_MGS = 145 * MiB;
constexpr size_t WS_H2 = 109 * MiB;
constexpr size_t WS_UPB = 145 * MiB;
constexpr size_t WS_F2 = 221 * MiB;
constexpr size_t WS_FO = 109 * MiB;
constexpr size_t WS_FOS2 = 329 * MiB;
constexpr size_t WS_FOS = 253 * MiB;
constexpr int LDS_MAIN = 8 * 16640;
struct Params { const float* in[N_IN]; float* out; unsigned char* ws; };

__device__ __forceinline__ unsigned pk2(float lo, float hi) { unsigned r; asm("v_cvt_pk_bf16_f32 %0, %1, %2" : "=v"(r) : "v"(lo), "v"(hi)); return r; }
__device__ __forceinline__ float bflo(unsigned w) { return __uint_as_float(w << 16); }
__device__ __forceinline__ float bfhi(unsigned w) { return __uint_as_float(w & 0xffff0000u); }
__device__ __forceinline__ float bf1(bf16_t b) { return __uint_as_float(((unsigned)b) << 16); }
__device__ __forceinline__ float sigmoidf_(float x) { return __builtin_amdgcn_rcpf(1.0f + __expf(-x)); }
__device__ __forceinline__ float wave_sum(float v) {
#pragma unroll
    for (int o = 1; o < 64; o <<= 1) v += __shfl_xor(v, o);
    return v;
}
__device__ __forceinline__ int seq_of_row(int r) { return r < MPROMPT ? (r >> 11) : 4 + ((r - MPROMPT) >> 3); }
__device__ __forceinline__ void unpack8(const u32x4 w, float (&f)[8]) {
    f[0] = bflo(w.x); f[1] = bfhi(w.x); f[2] = bflo(w.y); f[3] = bfhi(w.y); f[4] = bflo(w.z); f[5] = bfhi(w.z); f[6] = bflo(w.w); f[7] = bfhi(w.w);
}
__device__ __forceinline__ u32x4 pack8(const float (&f)[8]) { u32x4 w; w.x = pk2(f[0], f[1]); w.y = pk2(f[2], f[3]); w.z = pk2(f[4], f[5]); w.w = pk2(f[6], f[7]); return w; }


#define XB_TMO      128
#define XB_XCNT(j)  (256  + 64 * (j))
#define XB_XSUB(j)  (1280 + 64 * (j))
#define XB_XGEN(j)  (2304 + 64 * (j))
#define XB_TOP      3328
#define XB_TOPGEN   3392
#define XCD_BAR_WORDS 3456
#define P7_FLAG(t) (XCD_BAR_WORDS + 64 * (t))
#define ADA_FLAG (XCD_BAR_WORDS + 64 * 32)
#define BAR_ZERO_WORDS (XCD_BAR_WORDS + 64 * 33)
#define XB_SPIN_CAP (1u << 18)
__device__ __forceinline__ unsigned xb_ld(unsigned* p)              { return __hip_atomic_load(p, __ATOMIC_RELAXED, __HIP_MEMORY_SCOPE_AGENT); }
__device__ __forceinline__ unsigned xb_add(unsigned* p, unsigned v) { return __hip_atomic_fetch_add(p, v, __ATOMIC_RELAXED, __HIP_MEMORY_SCOPE_AGENT); }
__device__ __forceinline__ unsigned xb_xcc_id() { return (unsigned)__builtin_amdgcn_s_getreg((3 << 11) | 20) & 0xFu; }
#define XB_SPIN(cond, bar) do { unsigned _sp = 0; while (cond) { __builtin_amdgcn_s_sleep(1); \
    if ((++_sp & 255u) == 0u) { if (xb_ld(&(bar)[XB_TMO])) break; if (_sp > XB_SPIN_CAP) { atomicAdd(&(bar)[XB_TMO], 1u); break; } } } } while (0)
struct XcdBarrier { unsigned* bar; unsigned x; volatile LAS unsigned* st; };
__device__ __forceinline__ XcdBarrier xcd_barrier_post(unsigned* bar, volatile LAS unsigned* st) {
    XcdBarrier b; b.bar = bar; b.x = xb_xcc_id(); b.st = st;
    if (threadIdx.x == 0) (void)xb_add(&bar[XB_XCNT(b.x)], 1u);
    return b;
}
__device__ __forceinline__ void xcd_barrier_complete(unsigned* bar, unsigned x, unsigned& nloc, unsigned& nx) {
    const unsigned G = gridDim.x * gridDim.y * gridDim.z;
    unsigned sum, cnt, mine, sp = 0u;
    for (;;) {
        sum = 0u; cnt = 0u; mine = 0u;
#pragma unroll
        for (unsigned j = 0; j < 16; ++j) { const unsigned c = xb_ld(&bar[XB_XCNT(j)]); sum += c; cnt += (c > 0u) ? 1u : 0u; mine = (j == x) ? c : mine; }
        if (sum == G) break;
        __builtin_amdgcn_s_sleep(1);
        if ((++sp & 255u) == 0u) { if (xb_ld(&bar[XB_TMO])) break; if (sp > XB_SPIN_CAP) { atomicAdd(&bar[XB_TMO], 1u); break; } }
    }
    nloc = mine > 0u ? mine : 1u; nx = cnt > 0u ? cnt : 1u;
}
__device__ __forceinline__ void xcd_barrier(const XcdBarrier& b) {
    asm volatile("s_waitcnt vmcnt(0)" ::: "memory");
    __syncthreads();
    if (threadIdx.x == 0) {
        unsigned* bar = b.bar;
        __builtin_amdgcn_s_waitcnt(0);
        unsigned nloc = b.st[0], nx = b.st[1];
        if (nloc == 0u) { xcd_barrier_complete(bar, b.x, nloc, nx); b.st[0] = nloc; b.st[1] = nx; }
        const unsigned old = xb_add(&bar[XB_XSUB(b.x)], 1u);
        const unsigned gen = old / nloc;
        if (old + 1u == (gen + 1u) * nloc) {
            __builtin_amdgcn_fence(__ATOMIC_RELEASE, "agent");
            asm volatile("s_waitcnt vmcnt(0)" ::: "memory");
            const unsigned og = xb_add(&bar[XB_TOP], 1u);
            const unsigned tg = og / nx;
            if (og + 1u == (tg + 1u) * nx) xb_add(&bar[XB_TOPGEN], 1u);
            else XB_SPIN(xb_ld(&bar[XB_TOPGEN]) == tg, bar);
            __builtin_amdgcn_fence(__ATOMIC_ACQUIRE, "agent");
            xb_add(&bar[XB_XGEN(b.x)], 1u);
            asm volatile("s_waitcnt vmcnt(0)" ::: "memory");
        } else {
            XB_SPIN(xb_ld(&bar[XB_XGEN(b.x)]) == gen, bar);
            __builtin_amdgcn_fence(__ATOMIC_ACQUIRE, "agent");
            asm volatile("s_waitcnt vmcnt(0)" ::: "memory");
        }
    }
    __syncthreads();
}

__device__ __forceinline__ void ld8f(const float* p, float (&x)[8]);
__device__ __forceinline__ float gelu_tanh(float x) { const float y = 1.5957691216f * (x + 0.044715f * x * x * x); return x * __builtin_amdgcn_rcpf(1.0f + __expf(-y)); }
namespace pg8 {
constexpr int BM = 256, BK = 64, HALF = 128, HTB = HALF * BK * 2, STAGE_BYTES = 8 * HTB;
__device__ __forceinline__ int lds_byte(int r, int c) { const int st = (r >> 4) * 2 + (c >> 5), rr = r & 15, cc = c & 31, ob = rr * 64 + cc * 2; return st * 1024 + (ob ^ (((ob >> 9) & 1) << 5)); }
__device__ __forceinline__ void stage_rc(int b, int& R, int& C) { const int st = b / 1024, sb = b % 1024, swz = sb ^ (((sb >> 9) & 1) << 5); R = (st >> 1) * 16 + swz / 64; C = (st & 1) * 32 + (swz % 64) / 2; }
__device__ __forceinline__ int perm32(int rho) { const int n = rho >> 4, i = rho & 15; return 8 * (i >> 2) + 4 * n + (i & 3); }

struct Unit { const char* A; const char* B; int nt, pm, pn, tag; };

struct Sched {
    const char* A; const char* B; size_t a_tile, b_tile; int nM, nN, nt, G, c, a_sh, a_mul;
    __device__ __forceinline__ bool next(int i, Unit& u) const {
        const long L = (long)i * G + c; const int nwg = nM * nN; if (L >= nwg) return false;
        int wgid = (int)L; { const int q = nwg / 8, r = nwg % 8, xcd = wgid % 8, off = wgid / 8; wgid = (xcd < r ? xcd * (q + 1) : r * (q + 1) + (xcd - r) * q) + off; }
        const int nig = 8 * nN, gid = wgid / nig, fm = gid * 8, gsz = (nM - fm) < 8 ? (nM - fm) : 8;
        u.pm = fm + ((wgid % nig) % gsz); u.pn = (wgid % nig) / gsz; u.tag = 0;
        u.A = A + (size_t)u.pm * a_tile + (size_t)((u.pn >> a_sh) * a_mul); u.B = B + (size_t)u.pn * b_tile; u.nt = nt; return true;
    }
};

template <class Epi, class S_t>
__device__ __forceinline__ void gemm_phase(LAS unsigned char* lds, int lda, int ldb, const S_t& S, const Epi& E) {
    int tid = threadIdx.x; asm volatile("" : "+v"(tid));
    const int wid = __builtin_amdgcn_readfirstlane(tid >> 6), lane = tid & 63, wr = wid >> 2, wc = wid & 3, fr = lane & 15, fq = lane >> 4;
    unsigned voffA[2], voffB[2];
#pragma unroll
    for (int i = 0; i < 2; ++i) { int R, C; stage_rc(tid * 16 + i * 8192, R, C); const int Rb = Epi::PERM ? ((R & ~31) + perm32(R & 31)) : R;
        voffA[i] = (unsigned)(R * lda + C) * 2u; voffB[i] = (unsigned)(Rb * ldb + C) * 2u; }
    const size_t kstep = (size_t)(BK * 2);
    const size_t hstepA = (size_t)HALF * lda * 2, hstepB = (size_t)HALF * ldb * 2;
    const unsigned ldsw = (unsigned)wid * 1024u;
    const int aoff = lds_byte(wr * 64 + fr, fq * 8), boff = lds_byte(wc * 32 + fr, fq * 8);
#define PG8_SA(b, h) (((b) * 2 + (h)) * HTB)
#define PG8_SB(b, h) ((4 + (b) * 2 + (h)) * HTB)
#define PG8_STAGE(bufoff, gbase, voff) do { _Pragma("unroll") for (int _i = 0; _i < 2; ++_i) \
        __builtin_amdgcn_global_load_lds((const unsigned*)((const char*)(gbase) + (voff)[_i]), (LAS unsigned*)(lds + (bufoff) + ldsw + _i * 8192), 16, 0, 0); } while (0)
#define PG8_LDA(dst, b, h) do { _Pragma("unroll") for (int m = 0; m < 4; ++m) _Pragma("unroll") for (int k = 0; k < 2; ++k) dst[m][k] = *(const LAS bf16x8*)(lds + PG8_SA(b, h) + aoff + m * 2048 + k * 1024); } while (0)
#define PG8_LDB(dst, b, h) do { _Pragma("unroll") for (int n = 0; n < 2; ++n) _Pragma("unroll") for (int k = 0; k < 2; ++k) dst[n][k] = *(const LAS bf16x8*)(lds + PG8_SB(b, h) + boff + n * 2048 + k * 1024); } while (0)
#define PG8_MMA(ai, bj, At, Bt) do { __builtin_amdgcn_s_setprio(1); _Pragma("unroll") for (int m = 0; m < 4; ++m) _Pragma("unroll") for (int n = 0; n < 2; ++n) _Pragma("unroll") for (int k = 0; k < 2; ++k) \
        acc[ai][bj][m][n] = __builtin_amdgcn_mfma_f32_16x16x32_bf16(Bt[n][k], At[m][k], acc[ai][bj][m][n], 0, 0, 0); __builtin_amdgcn_s_setprio(0); } while (0)
#define PG8_WAIT_V(n) asm volatile("s_waitcnt vmcnt(" #n ")" ::: "memory")
#define PG8_WAIT_L(n) asm volatile("s_waitcnt lgkmcnt(" #n ")" ::: "memory")
#define PG8_BAR __builtin_amdgcn_s_barrier()
#define PG8_SCHED __builtin_amdgcn_sched_barrier(0)
    Unit cur, nxt; int ui = 0;
    if (!S.next(0, cur)) return;
    f32x4 acc[2][2][4][2];
#pragma unroll
    for (int a = 0; a < 2; ++a)
#pragma unroll
        for (int b = 0; b < 2; ++b)
#pragma unroll
            for (int m = 0; m < 4; ++m)
#pragma unroll
                for (int n = 0; n < 2; ++n) acc[a][b][m][n] = (f32x4){0.f, 0.f, 0.f, 0.f};
    bf16x8 At[4][2], B0[2][2], B1[2][2];
    const char* cA = cur.A; const char* cB = cur.B;
    PG8_STAGE(PG8_SB(0, 0), cB, voffB); PG8_STAGE(PG8_SA(0, 0), cA, voffA); PG8_STAGE(PG8_SB(0, 1), cB + hstepB, voffB); PG8_STAGE(PG8_SA(0, 1), cA + hstepA, voffA);
    if (wr == 1) PG8_BAR;
    PG8_WAIT_V(4); PG8_BAR;
    PG8_STAGE(PG8_SB(1, 0), cB + kstep, voffB); PG8_STAGE(PG8_SA(1, 0), cA + kstep, voffA); PG8_STAGE(PG8_SB(1, 1), cB + hstepB + kstep, voffB);
    PG8_WAIT_V(6); PG8_BAR;
    for (;;) {
        const bool has_next = S.next(ui + 1, nxt);
        const char* nA = has_next ? nxt.A : cA; const char* nB = has_next ? nxt.B : cB;
        const int nt = cur.nt;
        for (int t = 0; t < nt; t += 2) {
            const bool last = (t == nt - 2);
            const char* a1 = cA + (size_t)(t + 1) * kstep;
            const char* a2 = last ? nA : cA + (size_t)(t + 2) * kstep; const char* b2 = last ? nB : cB + (size_t)(t + 2) * kstep;
            const char* a3 = a2 + kstep; const char* b3 = b2 + kstep;
            PG8_LDB(B0, 0, 0); PG8_SCHED; PG8_LDA(At, 0, 0); PG8_STAGE(PG8_SA(1, 1), a1 + hstepA, voffA);
            PG8_WAIT_L(8); PG8_BAR; PG8_WAIT_L(0); PG8_MMA(0, 0, At, B0); PG8_BAR; PG8_SCHED;
            PG8_LDB(B1, 0, 1); PG8_STAGE(PG8_SB(0, 0), b2, voffB);
            PG8_BAR; PG8_WAIT_L(0); PG8_MMA(0, 1, At, B1); PG8_BAR;
            PG8_LDA(At, 0, 1); PG8_STAGE(PG8_SA(0, 0), a2, voffA);
            PG8_BAR; PG8_WAIT_L(0); PG8_MMA(1, 0, At, B0); PG8_BAR; PG8_SCHED;
            PG8_STAGE(PG8_SB(0, 1), b2 + hstepB, voffB);
            PG8_WAIT_V(6); PG8_BAR; PG8_MMA(1, 1, At, B1); PG8_BAR;
            PG8_LDB(B0, 1, 0); PG8_SCHED; PG8_LDA(At, 1, 0); PG8_STAGE(PG8_SA(0, 1), a2 + hstepA, voffA);
            PG8_WAIT_L(8); PG8_BAR; PG8_WAIT_L(0); PG8_MMA(0, 0, At, B0); PG8_BAR; PG8_SCHED;
            PG8_LDB(B1, 1, 1); PG8_STAGE(PG8_SB(1, 0), b3, voffB);
            PG8_BAR; PG8_WAIT_L(0); PG8_MMA(0, 1, At, B1); PG8_BAR;
            PG8_LDA(At, 1, 1); PG8_STAGE(PG8_SA(1, 0), a3, voffA);
            PG8_BAR; PG8_WAIT_L(0); PG8_MMA(1, 0, At, B0); PG8_BAR; PG8_SCHED;
            PG8_STAGE(PG8_SB(1, 1), b3 + hstepB, voffB);
            PG8_WAIT_V(6); PG8_BAR; PG8_MMA(1, 1, At, B1); PG8_BAR;
        }
        E(acc, cur, wr, wc, fr, fq);
        if (!has_next) break;
#pragma unroll
        for (int a = 0; a < 2; ++a)
#pragma unroll
            for (int b = 0; b < 2; ++b)
#pragma unroll
                for (int m = 0; m < 4; ++m)
#pragma unroll
                    for (int n = 0; n < 2; ++n) acc[a][b][m][n] = (f32x4){0.f, 0.f, 0.f, 0.f};
        cur = nxt; cA = nA; cB = nB; ++ui;
    }
    PG8_WAIT_V(0);
    if (wr == 0) PG8_BAR;
    PG8_BAR;
#undef PG8_SA
#undef PG8_SB
#undef PG8_STAGE
#undef PG8_LDA
#undef PG8_LDB
#undef PG8_MMA
#undef PG8_WAIT_V
#undef PG8_WAIT_L
#undef PG8_BAR
#undef PG8_SCHED
}

struct EpiF32 {
    static constexpr bool PERM = false;
    float* C; int ldc; const float* bias;
    __device__ __forceinline__ void operator()(const f32x4 (&acc)[2][2][4][2], const Unit& u, int wr, int wc, int fr, int fq) const {
        const int row0 = u.pm * BM + wr * 64 + fr, col0 = u.pn * BM + wc * 32 + 4 * fq;
        f32x4 bv[2][2];
#pragma unroll
        for (int bj = 0; bj < 2; ++bj)
#pragma unroll
            for (int n = 0; n < 2; ++n) bv[bj][n] = bias ? *(const f32x4*)(bias + col0 + bj * HALF + n * 16) : (f32x4){0.f, 0.f, 0.f, 0.f};
#pragma unroll
        for (int ai = 0; ai < 2; ++ai)
#pragma unroll
            for (int m = 0; m < 4; ++m) { float* rowp = C + (size_t)(row0 + ai * HALF + m * 16) * ldc + col0;
#pragma unroll
                for (int bj = 0; bj < 2; ++bj)
#pragma unroll
                    for (int n = 0; n < 2; ++n) *(f32x4*)(rowp + bj * HALF + n * 16) = acc[ai][bj][m][n] + bv[bj][n]; }
    }
};
struct EpiAda {
    static constexpr bool PERM = false;
    float* C; const float* bias; const float* g1; const float* g2; const float* g4; const float* g5;
    __device__ __forceinline__ void operator()(const f32x4 (&acc)[2][2][4][2], const Unit& u, int wr, int wc, int fr, int fq) const {
        const int row0 = wr * 64 + fr, col0 = u.pn * BM + wc * 32 + 4 * fq, kind = u.pn >> 3;
        const float* gm = kind == 2 ? g2 : kind == 4 ? g4 : kind == 5 ? g5 : g1;
        const float one = (kind == 1 || kind == 4) ? 1.0f : 0.0f, gs = (kind == 0 || kind == 3) ? 0.0f : 1.0f;
#pragma unroll
        for (int bj = 0; bj < 2; ++bj)
#pragma unroll
            for (int n = 0; n < 2; ++n) { const int col = col0 + bj * HALF + n * 16;
                const f32x4 bv = *(const f32x4*)(bias + col) + one, gv = *(const f32x4*)(gm + (col & (DM - 1))) * gs + (1.0f - gs);
#pragma unroll
                for (int ai = 0; ai < 2; ++ai)
#pragma unroll
                    for (int m = 0; m < 4; ++m) *(f32x4*)(C + (size_t)(row0 + ai * HALF + m * 16) * NADA + col) = (acc[ai][bj][m][n] + bv) * gv; }
    }
};
struct EpiBf16 {
    static constexpr bool PERM = true;
    bf16_t* O; int ldc; int sig_pn;
    __device__ __forceinline__ void operator()(const f32x4 (&acc)[2][2][4][2], const Unit& u, int wr, int wc, int fr, int fq) const {
        const int row0 = u.pm * BM + wr * 64 + fr, col0 = u.pn * BM + wc * 32 + 8 * fq;
        const bool sg = u.pn >= sig_pn;
#pragma unroll
        for (int ai = 0; ai < 2; ++ai)
#pragma unroll
            for (int m = 0; m < 4; ++m) { bf16_t* rowp = O + (size_t)(row0 + ai * HALF + m * 16) * ldc + col0;
#pragma unroll
                for (int bj = 0; bj < 2; ++bj) { f32x4 v0 = acc[ai][bj][m][0], v1 = acc[ai][bj][m][1];
                    if (sg) {
#pragma unroll
                        for (int j = 0; j < 4; ++j) { v0[j] = sigmoidf_(v0[j]); v1[j] = sigmoidf_(v1[j]); } }
                    u32x4 w; w.x = pk2(v0[0], v0[1]); w.y = pk2(v0[2], v0[3]); w.z = pk2(v1[0], v1[1]); w.w = pk2(v1[2], v1[3]);
                    *(u32x4*)(rowp + bj * HALF) = w; } }
    }
};
struct EpiPool {
    static constexpr bool PERM = true;
    bf16_t* O; const float* scale;
    __device__ __forceinline__ void operator()(const f32x4 (&acc)[2][2][4][2], const Unit& u, int wr, int wc, int fr, int fq) const {
        const int row0 = u.pm * BM + wr * 64 + fr, col0 = u.pn * BM + wc * 32 + 8 * fq;
        f32x4 sv[2][2];
#pragma unroll
        for (int bj = 0; bj < 2; ++bj)
#pragma unroll
            for (int n = 0; n < 2; ++n) sv[bj][n] = *(const f32x4*)(scale + col0 + bj * HALF + 4 * n);
#pragma unroll
        for (int ai = 0; ai < 2; ++ai)
#pragma unroll
            for (int m = 0; m < 4; ++m) { bf16_t* rowp = O + (size_t)(row0 + ai * HALF + m * 16) * PW + col0;
#pragma unroll
                for (int bj = 0; bj < 2; ++bj) { const f32x4 v0 = acc[ai][bj][m][0] * sv[bj][0], v1 = acc[ai][bj][m][1] * sv[bj][1];
                    u32x4 w; w.x = pk2(v0[0], v0[1]); w.y = pk2(v0[2], v0[3]); w.z = pk2(v1[0], v1[1]); w.w = pk2(v1[2], v1[3]);
                    *(u32x4*)(rowp + bj * HALF) = w; } }
    }
};
struct EpiGates {
    static constexpr bool PERM = true;
    const bf16_t* XC; unsigned* LU; const float* brg; const float* big; const float* spl;
    __device__ __forceinline__ void operator()(const f32x4 (&acc)[2][2][4][2], const Unit& u, int wr, int wc, int fr, int fq) const {
        const int row0 = u.pm * BM + wr * 64 + fr, ch0 = u.pn * HALF + wc * 32 + 8 * fq;
        float br[8], bi[8], sp[8];
#pragma unroll
        for (int q = 0; q < 2; ++q) { const f32x4 a = *(const f32x4*)(brg + ch0 + 4 * q), b = *(const f32x4*)(big + ch0 + 4 * q), c = *(const f32x4*)(spl + ch0 + 4 * q);
#pragma unroll
            for (int j = 0; j < 4; ++j) { br[4 * q + j] = a[j]; bi[4 * q + j] = b[j]; sp[4 * q + j] = c[j]; } }
        u32x4 xraw[2][4];
#pragma unroll
        for (int ai = 0; ai < 2; ++ai)
#pragma unroll
            for (int m = 0; m < 4; ++m) xraw[ai][m] = *(const u32x4*)(XC + (size_t)(row0 + ai * HALF + m * 16) * LW + ch0);
        asm volatile("" ::: "memory");
#pragma unroll
        for (int ai = 0; ai < 2; ++ai)
#pragma unroll
            for (int m = 0; m < 4; ++m) { const size_t off = (size_t)(row0 + ai * HALF + m * 16) * LW + ch0;
                float xc[8]; unpack8(xraw[ai][m], xc);
                float la[8], uu[8];
#pragma unroll
                for (int n = 0; n < 2; ++n)
#pragma unroll
                    for (int j = 0; j < 4; ++j) { const int e = 4 * n + j;
                        const float r = sigmoidf_(acc[ai][0][m][n][j] + br[e]), ig = sigmoidf_(acc[ai][1][m][n][j] + bi[e]);
                        const float l = -8.0f * r * sp[e]; la[e] = l;
                        const float x2 = 2.0f * l;
                        const float om = x2 > -0.03125f ? -x2 * (1.0f + x2 * (0.5f + x2 * (0.16666667f + x2 * 0.041666668f))) : 1.0f - __expf(x2);
                        uu[e] = __builtin_amdgcn_sqrtf(om) * (ig * xc[e]); }
                u32x4 w0, w1; w0.x = pk2(la[0], uu[0]); w0.y = pk2(la[1], uu[1]); w0.z = pk2(la[2], uu[2]); w0.w = pk2(la[3], uu[3]);
                w1.x = pk2(la[4], uu[4]); w1.y = pk2(la[5], uu[5]); w1.z = pk2(la[6], uu[6]); w1.w = pk2(la[7], uu[7]);
                *(u32x4*)(LU + off) = w0; *(u32x4*)(LU + off + 4) = w1; }
    }
};
template <bool ADD> struct EpiMerge {
    static constexpr bool PERM = true;
    bf16_t* MG; const bf16_t* Z; int gcol0; unsigned* flags;
    __device__ __forceinline__ void operator()(const f32x4 (&acc)[2][2][4][2], const Unit& u, int wr, int wc, int fr, int fq) const {
        const int row0 = u.pm * BM + wr * 64 + fr, col0 = u.pn * BM + wc * 32 + 8 * fq;
        if (ADD && u.tag >= 2000) {
            unsigned* f = flags + P7_FLAG(u.tag - 2000); unsigned sp = 0;
            while ((unsigned)__builtin_amdgcn_readfirstlane(__hip_atomic_load(f, __ATOMIC_RELAXED, __HIP_MEMORY_SCOPE_AGENT)) < 8u) { __builtin_amdgcn_s_sleep(2); if (++sp > (1u << 20)) break; }
            __builtin_amdgcn_fence(__ATOMIC_ACQUIRE, "agent");
            asm volatile("s_waitcnt vmcnt(0)" ::: "memory");
        }
#pragma unroll
        for (int ai = 0; ai < 2; ++ai) {
            u32x4 gr[4][2], orw[4][2];
            asm volatile("" ::: "memory");
#pragma unroll
            for (int m = 0; m < 4; ++m)
#pragma unroll
                for (int bj = 0; bj < 2; ++bj) { const int row = row0 + ai * HALF + m * 16, col = col0 + bj * HALF;
                    gr[m][bj] = *(const u32x4*)(Z + (size_t)row * INW + gcol0 + col);
                    if (ADD) orw[m][bj] = *(const u32x4*)(MG + (size_t)row * DM + col); }
            asm volatile("" ::: "memory");
#pragma unroll
            for (int m = 0; m < 4; ++m)
#pragma unroll
                for (int bj = 0; bj < 2; ++bj) { const int row = row0 + ai * HALF + m * 16, col = col0 + bj * HALF;
                    float g[8], o[8]; unpack8(gr[m][bj], g);
                    if (ADD) unpack8(orw[m][bj], o);
#pragma unroll
                    for (int n = 0; n < 2; ++n)
#pragma unroll
                        for (int j = 0; j < 4; ++j) { const int e = 4 * n + j; o[e] = ADD ? o[e] + g[e] * acc[ai][bj][m][n][j] : g[e] * acc[ai][bj][m][n][j]; }
                    *(u32x4*)(MG + (size_t)row * DM + col) = pack8(o); }
        }
        if (!ADD && u.tag >= 1000) {
            asm volatile("s_waitcnt vmcnt(0)" ::: "memory");
            __builtin_amdgcn_fence(__ATOMIC_RELEASE, "agent");
            asm volatile("s_waitcnt vmcnt(0)" ::: "memory");
            if ((threadIdx.x & 63) == 0) __hip_atomic_fetch_add(flags + P7_FLAG(u.tag - 1000), 1u, __ATOMIC_RELAXED, __HIP_MEMORY_SCOPE_AGENT);
        }
    }
};
struct SchedSplit {
    Sched base; int ntp, kz_lo, kz_hi, mode;
    __device__ __forceinline__ bool next(int i, Unit& u) const {
        if (i == 0) return base.next(0, u);
        if (i > 1) return false;
        const int tile = base.c >> 3, kz = base.c & 7;
        if (kz < kz_lo || kz >= kz_hi) return false;
        const int k = kz - kz_lo; int koff, nt;
        if (mode == 0) { koff = k * ntp; nt = ntp; } else { koff = k < 4 ? 6 * k : 24 + 4 * (k - 4); nt = k < 4 ? 6 : 4; }
        u.pm = 32 + (tile >> 3); u.pn = tile & 7; u.tag = 1 + kz; u.nt = nt;
        u.A = base.A + (size_t)u.pm * base.a_tile + (size_t)koff * 128; u.B = base.B + (size_t)u.pn * base.b_tile + (size_t)koff * 128; return true;
    }
};
struct SchedP7 {
    Sched base; int lo, tg;
    __device__ __forceinline__ bool next(int i, Unit& u) const {
        if (i == 0) return base.next(0, u);
        const int t = base.c - lo;
        if (i > 1 || t < 0 || t >= 32) return false;
        u.pm = 32 + (t >> 3); u.pn = t & 7; u.tag = tg + t; u.nt = base.nt;
        u.A = base.A + (size_t)u.pm * base.a_tile; u.B = base.B + (size_t)u.pn * base.b_tile; return true;
    }
};
struct EpiOut {
    static constexpr bool PERM = true;
    bf16_t* Ob; float* Os;
    __device__ __forceinline__ void operator()(const f32x4 (&acc)[2][2][4][2], const Unit& u, int wr, int wc, int fr, int fq) const {
        const int col0 = u.pn * BM + wc * 32 + 8 * fq;
        if (u.tag == 0) {
            const int row0 = u.pm * BM + wr * 64 + fr;
#pragma unroll
            for (int ai = 0; ai < 2; ++ai)
#pragma unroll
                for (int m = 0; m < 4; ++m) { bf16_t* rowp = Ob + (size_t)(row0 + ai * HALF + m * 16) * DM + col0;
#pragma unroll
                    for (int bj = 0; bj < 2; ++bj) { const f32x4 v0 = acc[ai][bj][m][0], v1 = acc[ai][bj][m][1];
                        u32x4 w; w.x = pk2(v0[0], v0[1]); w.y = pk2(v0[2], v0[3]); w.z = pk2(v1[0], v1[1]); w.w = pk2(v1[2], v1[3]);
                        *(u32x4*)(rowp + bj * HALF) = w; } }
        } else {
            const int row0 = (u.pm - 32) * BM + wr * 64 + fr;
            float* Op = Os + (size_t)(u.tag - 1) * (1024ull * DM);
#pragma unroll
            for (int ai = 0; ai < 2; ++ai)
#pragma unroll
                for (int m = 0; m < 4; ++m) { float* rowp = Op + (size_t)(row0 + ai * HALF + m * 16) * DM + col0;
#pragma unroll
                    for (int bj = 0; bj < 2; ++bj)
#pragma unroll
                        for (int n = 0; n < 2; ++n) *(f32x4*)(rowp + bj * HALF + 4 * n) = acc[ai][bj][m][n]; }
        }
    }
};
__device__ __forceinline__ float dpp_shr1(float old, float src) { return __int_as_float(__builtin_amdgcn_update_dpp(__float_as_int(old), __float_as_int(src), 0x111, 0xf, 0xf, false)); }
__device__ __forceinline__ float dpp_shr2(float old, float src) { return __int_as_float(__builtin_amdgcn_update_dpp(__float_as_int(old), __float_as_int(src), 0x112, 0xf, 0xf, false)); }
__device__ __forceinline__ float dpp_ror1(float src) { return __int_as_float(__builtin_amdgcn_update_dpp(0, __float_as_int(src), 0x121, 0xf, 0xf, false)); }
__device__ __forceinline__ float dpp_ror2(float src) { return __int_as_float(__builtin_amdgcn_update_dpp(0, __float_as_int(src), 0x122, 0xf, 0xf, false)); }
struct EpiUpFused {
    static constexpr bool PERM = true;
    bf16_t* UP; bf16_t* F; bf16_t* UPB; const float* wconv; const float* bconv;
    __device__ __forceinline__ void operator()(const f32x4 (&acc)[2][2][4][2], const Unit& u, int wr, int wc, int fr, int fq) const {
        const int row0 = u.pm * BM + wr * 64 + fr, col0 = u.pn * BM + wc * 32 + 8 * fq;
        if (u.pm >= 32) {
#pragma unroll
            for (int ai = 0; ai < 2; ++ai)
#pragma unroll
                for (int m = 0; m < 4; ++m) { bf16_t* rowp = UP + (size_t)(row0 + ai * HALF + m * 16) * (2 * DFF) + col0;
#pragma unroll
                    for (int bj = 0; bj < 2; ++bj) { const f32x4 v0 = acc[ai][bj][m][0], v1 = acc[ai][bj][m][1];
                        u32x4 w; w.x = pk2(v0[0], v0[1]); w.y = pk2(v0[2], v0[3]); w.z = pk2(v1[0], v1[1]); w.w = pk2(v1[2], v1[3]);
                        *(u32x4*)(rowp + bj * HALF) = w; } }
            return;
        }
        const int j0 = u.pn * HALF + wc * 32 + 8 * fq;
        u32x2 res0[8];
#pragma unroll
        for (int n = 0; n < 2; ++n) {
            asm volatile("" ::: "memory");
            const int jc = j0 + 4 * n;
            const f32x4 wg0 = *(const f32x4*)(wconv + jc), wg1 = *(const f32x4*)(wconv + 2 * DFF + jc), wg2 = *(const f32x4*)(wconv + 4 * DFF + jc), bg = *(const f32x4*)(bconv + jc);
            const f32x4 wv0 = *(const f32x4*)(wconv + DFF + jc), wv1 = *(const f32x4*)(wconv + 3 * DFF + jc), wv2 = *(const f32x4*)(wconv + 5 * DFF + jc), bv = *(const f32x4*)(bconv + DFF + jc);
#pragma unroll
            for (int ai = 0; ai < 2; ++ai)
#pragma unroll
                for (int m = 0; m < 4; ++m) { const int row = row0 + ai * HALF + m * 16;
                    const f32x4 g0 = acc[ai][0][m][n], v0 = acc[ai][1][m][n];
                    f32x4 gp = (f32x4){0.f, 0.f, 0.f, 0.f}, vp = gp;
                    if (m > 0) { gp = acc[ai][0][m > 0 ? m - 1 : 0][n]; vp = acc[ai][1][m > 0 ? m - 1 : 0][n]; }
                    f32x4 f;
#pragma unroll
                    for (int j = 0; j < 4; ++j) {
                        const float g1 = dpp_shr1(dpp_ror1(gp[j]), g0[j]), g2 = dpp_shr2(dpp_ror2(gp[j]), g0[j]);
                        const float v1 = dpp_shr1(dpp_ror1(vp[j]), v0[j]), v2 = dpp_shr2(dpp_ror2(vp[j]), v0[j]);
                        const float cg_ = bg[j] + g2 * wg0[j] + g1 * wg1[j] + g0[j] * wg2[j];
                        const float cv_ = bv[j] + v2 * wv0[j] + v1 * wv1[j] + v0[j] * wv2[j];
                        f[j] = gelu_tanh(cg_) * cv_; }
                    u32x2 w; w.x = pk2(f[0], f[1]); w.y = pk2(f[2], f[3]);
                    if (n == 0) res0[ai * 4 + m] = w;
                    else if (m > 0 || fr >= 2) { u32x4 w4; w4.x = res0[ai * 4 + m].x; w4.y = res0[ai * 4 + m].y; w4.z = w.x; w4.w = w.y; *(u32x4*)(F + (size_t)row * DFF + j0) = w4; }
                    if (n == 1 && ((m == 0 && fr < 2) || (m == 3 && fr >= 14))) { const int slot = m == 0 ? fr : fr - 12;
                        const f32x4 ga = acc[ai][0][m][0], va = acc[ai][1][m][0];
                        bf16_t* bp = UPB + ((size_t)(row >> 6) * 4 + slot) * (2 * DFF) + col0;
                        u32x4 wg_, wv_; wg_.x = pk2(ga[0], ga[1]); wg_.y = pk2(ga[2], ga[3]); wg_.z = pk2(g0[0], g0[1]); wg_.w = pk2(g0[2], g0[3]);
                        wv_.x = pk2(va[0], va[1]); wv_.y = pk2(va[2], va[3]); wv_.z = pk2(v0[0], v0[1]); wv_.w = pk2(v0[2], v0[3]);
                        *(u32x4*)bp = wg_; *(u32x4*)(bp + HALF) = wv_; } }
        }
    }
};
}

__device__ __forceinline__ void cvt_item(const float* __restrict__ W, int N, bf16_t* WT, int K, int k0, int n0, int drow0, LAS float* scr, int lane) {
    float v[64];
#pragma unroll
    for (int kk = 0; kk < 64; ++kk) v[kk] = __builtin_nontemporal_load(W + (size_t)(k0 + kk) * N + n0 + lane);
#pragma unroll
    for (int kk = 0; kk < 64; ++kk) scr[kk * 65 + lane] = v[kk];
    asm volatile("s_waitcnt lgkmcnt(0)" ::: "memory");
    const int c = lane & 7;
#pragma unroll
    for (int j = 0; j < 8; ++j) { const int n = (lane >> 3) + 8 * j; const LAS float* s = scr + (8 * c) * 65 + n;
        u32x4 o; o.x = pk2(s[0 * 65], s[1 * 65]); o.y = pk2(s[2 * 65], s[3 * 65]); o.z = pk2(s[4 * 65], s[5 * 65]); o.w = pk2(s[6 * 65], s[7 * 65]);
        *(u32x4*)(WT + (size_t)(drow0 + n) * K + k0 + 8 * c) = o; }
    asm volatile("s_waitcnt lgkmcnt(0)" ::: "memory");
}

template <int PART> __device__ __forceinline__ void phase0(const Params& p, LAS unsigned char* lds) {
    constexpr int SKIP = PART == 0 ? 0 : PART == 1 ? 48 : 192;
    const int tid = threadIdx.x, lane = tid & 63, wave = tid >> 6;
    const int gw = ((int)blockIdx.x - SKIP) * NWAVES + wave, NGW = ((int)gridDim.x - SKIP) * NWAVES;
    if (gw < 0) return;
    const int gt = blockIdx.x * NTHREADS + tid, NGT = gridDim.x * NTHREADS;
    unsigned char* ws = p.ws;
    LAS float* scr = (LAS float*)(lds + wave * 16640);
    constexpr int I0 = 32 * 192, I1 = 32 * 112, I2 = 32 * 192, I3 = 96 * 32, I4 = 32 * 32, I5 = 32 * 32, I6 = 16 * 32, I7 = 64, I8 = 128, I9 = 128;
    constexpr int NIT = I0 + I1 + I2 + I3 + I4 + I5 + I6 + I7 + I8 + I9;
    constexpr int U0 = I0 + I1, U1 = U0 + I2 / 2, D0 = I0 + I1 + I2, D1 = D0 + I3;
    constexpr int CUT = (U1 - U0) + I3;
    constexpr int LO = PART == 0 ? 0 : PART == 1 ? I0 : PART == 2 ? U0 : D0, HI = PART == 0 ? I0 : PART == 1 ? NIT - CUT : PART == 2 ? U1 : D1;
    for (int it0 = LO + gw; it0 < HI; it0 += NGW) {
        int it = it0;
        if (PART == 1) { if (it >= U0) it += U1 - U0; if (it >= D0) it += I3; }
        int r = it;
        if (r < I0) { const int nb = r % 192, kb = r / 192; cvt_item(p.in[I_WADA], NADA, (bf16_t*)(ws + WS_WADA), DM, 64 * kb, 64 * nb, 64 * nb, scr, lane); continue; } r -= I0;
        if (r < I1) { const int nb = r % 112, kb = r / 112; cvt_item(p.in[I_WIN], INW, (bf16_t*)(ws + WS_WIN), DM, 64 * kb, 64 * nb, 64 * nb, scr, lane); continue; } r -= I1;
        if (r < I2) { const int nb = r % 192, kb = r / 192; const int n0 = 64 * nb; const int j0 = n0 < DFF ? n0 : n0 - DFF;
            const int drow = (j0 >> 7) * 256 + (n0 < DFF ? 0 : 128) + (j0 & 127);
            cvt_item(p.in[I_WUP], 2 * DFF, (bf16_t*)(ws + WS_WUP), DM, 64 * kb, n0, drow, scr, lane); continue; } r -= I2;
        if (r < I3) { const int nb = r % 32, kb = r / 32; cvt_item(p.in[I_WDOWN], DM, (bf16_t*)(ws + WS_WDOWN), DFF, 64 * kb, 64 * nb, 64 * nb, scr, lane); continue; } r -= I3;
        if (r < I4) { const int nb = r % 32, kb = r / 32; cvt_item(p.in[I_WOUT], DM, (bf16_t*)(ws + WS_WOUT), DM, 64 * kb, 64 * nb, 64 * nb, scr, lane); continue; } r -= I4;
        if (r < I5) { const int nb = r % 32, kb = r / 32; cvt_item(p.in[I_WLU], DM, (bf16_t*)(ws + WS_WLU), LW, 64 * kb, 64 * nb, 64 * nb, scr, lane); continue; } r -= I5;
        if (r < I6) { const int nb = r % 32, kb = r / 32; cvt_item(p.in[I_WPU], DM, (bf16_t*)(ws + WS_WPU), PW, 64 * kb, 64 * nb, 64 * nb, scr, lane); continue; } r -= I6;
        if (r < I7) { const int g = r >> 4, q = r & 15, kb = q >> 2, nb = q & 3;
            cvt_item(p.in[I_WGRP] + (size_t)g * 65536, 256, (bf16_t*)(ws + WS_WGRP) + (size_t)g * 65536, 256, 64 * kb, 64 * nb, 64 * nb, scr, lane); continue; } r -= I7;
        { const bool isig = r >= I8; if (isig) r -= I8;
          const int blk = r >> 4, q = r & 15, kb = q >> 2, nb = q & 3, n0 = 64 * nb;
          const int drow = (blk * 2 + (n0 >> 7)) * 256 + (isig ? 128 : 0) + (n0 & 127);
          cvt_item(p.in[isig ? I_WIG : I_WRG] + (size_t)blk * 65536, 256, (bf16_t*)(ws + WS_WGATE), 256, 64 * kb, n0, drow, scr, lane); }
    }
    if (PART != 0) return;
    bf16_t* sada = (bf16_t*)(ws + WS_SADA);
    for (int i = gt; i < 256 * DM; i += NGT) { const int r = i >> 11, k = i & 2047;
        float v = 0.f; if (r < 4) v = p.in[I_CP][r * DM + k]; else if (r < NSEQ) v = p.in[I_CS][(r - 4) * DM + k];
        const float s = v * sigmoidf_(v);
        sada[i] = (bf16_t)(pk2(s, s) & 0xffffu); }
    float* spl = (float*)(ws + WS_CTL);
    for (int i = gt; i < LW; i += NGT) spl[i] = log1pf(expf(-p.in[I_LAM][i]));
}

__device__ __forceinline__ const float* xrow_ptr(const Params& p, int row) { return row < MPROMPT ? p.in[I_XP] + (size_t)row * DM : p.in[I_XS] + (size_t)(row - MPROMPT) * DM; }

__device__ __forceinline__ void norm1_row(const Params& p, const f32x4 (&v)[8], const f32x4 (&sc)[8], const f32x4 (&sh)[8], int row, int lane) {
    bf16_t* H = (bf16_t*)(p.ws + WS_H);
    float ss = 0.f;
#pragma unroll
    for (int j = 0; j < 8; ++j) ss += (v[j].x * v[j].x + v[j].y * v[j].y) + (v[j].z * v[j].z + v[j].w * v[j].w);
    const float rstd = 1.0f / sqrtf(wave_sum(ss) * (1.0f / DM) + EPS);
#pragma unroll
    for (int j = 0; j < 8; ++j) { const int col = 4 * lane + 256 * j;
        const f32x4 h = v[j] * rstd * sc[j] + sh[j];
        u32x2 w; w.x = pk2(h.x, h.y); w.y = pk2(h.z, h.w);
        *(u32x2*)(H + (size_t)row * DM + col) = w; }
}
__device__ __forceinline__ void phase_norm1(const Params& p) {
    const int tid = threadIdx.x, lane = tid & 63, wave = tid >> 6;
    const int gw = blockIdx.x * NWAVES + wave, NGW = gridDim.x * NWAVES;
    const float* ada = (const float*)(p.ws + WS_ADA);
    f32x4 v[8], vn[8];
    if (gw < MPROMPT) { const f32x4* xr = (const f32x4*)(p.in[I_XP] + (size_t)gw * DM) + lane;
#pragma unroll
        for (int j = 0; j < 8; ++j) v[j] = __builtin_nontemporal_load(xr + 64 * j); }
    for (int row = gw; row < MPROMPT; row += NGW) {
        const float* ar = ada + (size_t)(row >> 11) * NADA;
        f32x4 sc[8], sh[8];
#pragma unroll
        for (int j = 0; j < 8; ++j) { const int col = 4 * lane + 256 * j; sc[j] = *(const f32x4*)(ar + DM + col); sh[j] = *(const f32x4*)(ar + col); }
        if (row + NGW < MPROMPT) { const f32x4* xr = (const f32x4*)(p.in[I_XP] + (size_t)(row + NGW) * DM) + lane;
#pragma unroll
            for (int j = 0; j < 8; ++j) vn[j] = __builtin_nontemporal_load(xr + 64 * j); }
        norm1_row(p, v, sc, sh, row, lane);
#pragma unroll
        for (int j = 0; j < 8; ++j) v[j] = vn[j];
    }
    for (int row = MPROMPT + (gw >> 1); (gw & 1) == 0 && row < MTOK; row += (NGW >> 1)) {
        const float* ar = ada + (size_t)seq_of_row(row) * NADA; const f32x4* xr = (const f32x4*)xrow_ptr(p, row) + lane;
        f32x4 x[8], sc[8], sh[8];
#pragma unroll
        for (int j = 0; j < 8; ++j) { const int col = 4 * lane + 256 * j; x[j] = __builtin_nontemporal_load(xr + 64 * j); sc[j] = *(const f32x4*)(ar + DM + col); sh[j] = *(const f32x4*)(ar + col); }
        norm1_row(p, x, sc, sh, row, lane);
    }
}

__device__ __forceinline__ void ld8f(const float* p, float (&x)[8]) { const f32x4 a = *(const f32x4*)p, c = *(const f32x4*)(p + 4); x[0] = a.x; x[1] = a.y; x[2] = a.z; x[3] = a.w; x[4] = c.x; x[5] = c.y; x[6] = c.z; x[7] = c.w; }
template <int W> __device__ __forceinline__ void pool_run(const bf16_t* zp, bf16_t* dp, int t0) {
    u32x2 raw[15 + W];
#pragma unroll
    for (int i = 0; i < 15 + W; ++i) { const int rr = i - (W - 1); raw[i] = (u32x2){0u, 0u}; if (t0 + rr >= 0) raw[i] = *(const u32x2*)(zp + (ptrdiff_t)rr * INW); }
    float s[4] = {0.f, 0.f, 0.f, 0.f};
#pragma unroll
    for (int i = 0; i < W - 1; ++i) { s[0] += bflo(raw[i].x); s[1] += bfhi(raw[i].x); s[2] += bflo(raw[i].y); s[3] += bfhi(raw[i].y); }
#pragma unroll
    for (int i = 0; i < 16; ++i) { const u32x2 cu = raw[i + W - 1]; const float u0 = bflo(cu.x), u1 = bfhi(cu.x), u2 = bflo(cu.y), u3 = bfhi(cu.y);
        s[0] += u0; s[1] += u1; s[2] += u2; s[3] += u3;
        const int t = t0 + i; const float inv = 1.0f / (float)((t + 1) < W ? (t + 1) : W);
        u32x2 o; o.x = pk2(s[0] * inv - u0, s[1] * inv - u1); o.y = pk2(s[2] * inv - u2, s[3] * inv - u3);
        *(u32x2*)(dp + (size_t)i * PW) = o;
        const u32x2 od = raw[i]; s[0] -= bflo(od.x); s[1] -= bfhi(od.x); s[2] -= bflo(od.y); s[3] -= bfhi(od.y); }
}
__device__ __forceinline__ void phase_mixprep(const Params& p) {
    const int gt = blockIdx.x * NTHREADS + threadIdx.x, NGT = gridDim.x * NTHREADS;
    const bf16_t* Z = (const bf16_t*)(p.ws + WS_Z); bf16_t* Dp = (bf16_t*)(p.ws + WS_DP); bf16_t* XC = (bf16_t*)(p.ws + WS_XC);
    for (int it = gt; it < (MPROMPT / 16) * 256; it += NGT) {
        const int c4 = it & 255, run = it >> 8, ch0 = 4 * c4, g = ch0 >> 8, r0 = run * 16, t0 = r0 & (SEQ - 1);
        const bf16_t* zp = Z + (size_t)r0 * INW + ch0;
        switch (g) { case 0: pool_run<2>(zp, Dp + (size_t)r0 * PW + ch0, t0); break; case 1: pool_run<4>(zp, Dp + (size_t)r0 * PW + ch0, t0); break;
                     case 2: pool_run<8>(zp, Dp + (size_t)r0 * PW + ch0, t0); break; default: pool_run<16>(zp, Dp + (size_t)r0 * PW + ch0, t0); break; }
    }
    for (int it = gt; it < 1024 * 128; it += NGT) {
        const int row = MPROMPT + (it >> 7), ch0 = (it & 127) * 8, g = ch0 >> 8, w = 2 << g;
        const int b = (row - MPROMPT) >> 3, t = (row - MPROMPT) & 7;
        u32x4 zr[8]; f32x4 sa[15], sb[15];
#pragma unroll
        for (int j = 0; j < 8; ++j) { zr[j] = (u32x4){0u, 0u, 0u, 0u}; if (j <= t && j < w) zr[j] = *(const u32x4*)(Z + (size_t)(row - j) * INW + ch0); }
#pragma unroll
        for (int k = 0; k < 15; ++k) { const int j = t + 15 - k;
            sa[k] = (f32x4){0.f, 0.f, 0.f, 0.f}; sb[k] = sa[k];
            if (j < w) { const float* sp = p.in[I_SPOOL] + ((size_t)b * 15 + k) * PW + ch0; sa[k] = *(const f32x4*)sp; sb[k] = *(const f32x4*)(sp + 4); } }
        float s[8], u[8]; unpack8(zr[0], u);
#pragma unroll
        for (int e = 0; e < 8; ++e) s[e] = u[e];
#pragma unroll
        for (int j = 1; j < 8; ++j) { float x[8]; unpack8(zr[j], x);
#pragma unroll
            for (int e = 0; e < 8; ++e) s[e] += x[e]; }
#pragma unroll
        for (int k = 0; k < 15; ++k) { s[0] += sa[k].x; s[1] += sa[k].y; s[2] += sa[k].z; s[3] += sa[k].w; s[4] += sb[k].x; s[5] += sb[k].y; s[6] += sb[k].z; s[7] += sb[k].w; }
        const float inv = 1.0f / (float)w; float d[8];
#pragma unroll
        for (int e = 0; e < 8; ++e) d[e] = s[e] * inv - u[e];
        *(u32x4*)(Dp + (size_t)row * PW + ch0) = pack8(d);
    }
    for (int it = gt; it < (MPROMPT / 8) * 256; it += NGT) {
        const int c8 = it & 255, run = it >> 8, ch0 = 8 * c8, r0 = run * 8, t0 = r0 & (SEQ - 1);
        u32x4 raw[11];
#pragma unroll
        for (int i = 0; i < 11; ++i) { const int tt = t0 - 3 + i; raw[i] = (u32x4){0u, 0u, 0u, 0u}; if (tt >= 0) raw[i] = *(const u32x4*)(Z + (size_t)(r0 - 3 + i) * INW + PW + ch0); }
        float wk[4][8], bb[8];
#pragma unroll
        for (int k = 0; k < 4; ++k) ld8f(p.in[I_WLCONV] + (size_t)k * LW + ch0, wk[k]);
        ld8f(p.in[I_BLCONV] + ch0, bb);
        float x0[8], x1[8], x2[8], x3[8];
        unpack8(raw[0], x0); unpack8(raw[1], x1); unpack8(raw[2], x2);
#pragma unroll
        for (int i = 0; i < 8; ++i) { unpack8(raw[3 + i], x3); float o[8];
#pragma unroll
            for (int e = 0; e < 8; ++e) { o[e] = bb[e] + x0[e] * wk[0][e] + x1[e] * wk[1][e] + x2[e] * wk[2][e] + x3[e] * wk[3][e]; x0[e] = x1[e]; x1[e] = x2[e]; x2[e] = x3[e]; }
            *(u32x4*)(XC + (size_t)(r0 + i) * LW + ch0) = pack8(o); }
    }
    for (int it = gt; it < 1024 * 256; it += NGT) {
        const int row = MPROMPT + (it >> 8), ch0 = (it & 255) * 8;
        float acc[8]; ld8f(p.in[I_BLCONV] + ch0, acc);
        const int t = (row - MPROMPT) & 7, b = (row - MPROMPT) >> 3;
#pragma unroll
        for (int k = 0; k < 4; ++k) { const int tt = t - 3 + k; float x[8];
            if (tt >= 0) unpack8(*(const u32x4*)(Z + (size_t)(row - 3 + k) * INW + PW + ch0), x);
            else ld8f(p.in[I_SLCONV] + ((size_t)b * 3 + (3 + tt)) * LW + ch0, x);
            float wv[8]; ld8f(p.in[I_WLCONV] + (size_t)k * LW + ch0, wv);
#pragma unroll
            for (int e = 0; e < 8; ++e) acc[e] += x[e] * wv[e]; }
        *(u32x4*)(XC + (size_t)row * LW + ch0) = pack8(acc);
    }
    float* out = p.out;
    for (int i = gt; i < 4 * 15 * PW / 8; i += NGT) { const int ch = (i & 127) * 8, q = i >> 7, b = q / 15, r = q % 15;
        float x[8]; unpack8(*(const u32x4*)(Z + (size_t)(b * SEQ + SEQ - 15 + r) * INW + ch), x);
        float* o = out + O_POOLP + (size_t)q * PW + ch; *(f32x4*)o = (f32x4){x[0], x[1], x[2], x[3]}; *(f32x4*)(o + 4) = (f32x4){x[4], x[5], x[6], x[7]}; }
    for (int i = gt; i < 128 * 15 * PW / 8; i += NGT) { const int ch = (i & 127) * 8, q = i >> 7, b = q / 15, r = q % 15;
        float x[8];
        if (r < 7) ld8f(p.in[I_SPOOL] + ((size_t)b * 15 + 8 + r) * PW + ch, x); else unpack8(*(const u32x4*)(Z + (size_t)(MPROMPT + b * 8 + r - 7) * INW + ch), x);
        float* o = out + O_POOLS + (size_t)q * PW + ch; *(f32x4*)o = (f32x4){x[0], x[1], x[2], x[3]}; *(f32x4*)(o + 4) = (f32x4){x[4], x[5], x[6], x[7]}; }
    for (int i = gt; i < 4 * 3 * LW / 8; i += NGT) { const int ch = (i & 255) * 8, q = i >> 8, b = q / 3, r = q % 3;
        float x[8]; unpack8(*(const u32x4*)(Z + (size_t)(b * SEQ + SEQ - 3 + r) * INW + PW + ch), x);
        float* o = out + O_LCONVP + (size_t)q * LW + ch; *(f32x4*)o = (f32x4){x[0], x[1], x[2], x[3]}; *(f32x4*)(o + 4) = (f32x4){x[4], x[5], x[6], x[7]}; }
    for (int i = gt; i < 128 * 3 * LW / 8; i += NGT) { const int ch = (i & 255) * 8, q = i >> 8, b = q / 3, r = q % 3;
        float x[8]; unpack8(*(const u32x4*)(Z + (size_t)(MPROMPT + b * 8 + 5 + r) * INW + PW + ch), x);
        float* o = out + O_LCONVS + (size_t)q * LW + ch; *(f32x4*)o = (f32x4){x[0], x[1], x[2], x[3]}; *(f32x4*)(o + 4) = (f32x4){x[4], x[5], x[6], x[7]}; }
}

__device__ __forceinline__ void phase_scan(const Params& p, LAS unsigned char* lds) {
    const int tid = threadIdx.x;
    const unsigned* LU = (const unsigned*)(p.ws + WS_LA); bf16_t* YL = (bf16_t*)(p.ws + WS_YL);
    LAS float* sA = (LAS float*)lds; LAS float* sH = sA + 512;
    for (int item = blockIdx.x; item < 256; item += gridDim.x) {
        const int b = item >> 6, c32 = tid & 31, ch = (item & 63) * 32 + c32, chunk = tid >> 5;
        const size_t base = (size_t)(b * SEQ + chunk * 128) * LW + ch;
        float h = 0.f, sla = 0.f;
#pragma unroll 8
        for (int s = 0; s < 128; ++s) { const unsigned lw = LU[base + (size_t)s * LW]; const float la = bflo(lw), u = bfhi(lw); h = __expf(la) * h + u; sla += la; }
        sA[chunk * 32 + c32] = __expf(sla); sH[chunk * 32 + c32] = h;
        __syncthreads();
        float hin = 0.f;
        for (int j = 0; j < chunk; ++j) hin = sA[j * 32 + c32] * hin + sH[j * 32 + c32];
        h = hin;
#pragma unroll 8
        for (int s = 0; s < 128; ++s) { const unsigned lw = __builtin_nontemporal_load(LU + base + (size_t)s * LW); const float la = bflo(lw), u = bfhi(lw); h = __expf(la) * h + u;
            YL[base + (size_t)s * LW] = (bf16_t)(pk2(h, h) & 0xffffu); }
        if (chunk == 15) p.out[O_LHP + b * LW + ch] = h;
        __syncthreads();
    }
    const int gt = blockIdx.x * NTHREADS + tid, NGT = gridDim.x * NTHREADS;
    for (int i = gt; i < 128 * LW; i += NGT) { const int b = i >> 11, ch = i & 2047;
        float h = p.in[I_SLH][i]; const size_t base = (size_t)(MPROMPT + b * 8) * LW + ch;
#pragma unroll
        for (int s = 0; s < 8; ++s) { const unsigned lw = LU[base + (size_t)s * LW]; const float la = bflo(lw), u = bfhi(lw); h = __expf(la) * h + u;
            YL[base + (size_t)s * LW] = (bf16_t)(pk2(h, h) & 0xffffu); }
        p.out[O_LHS + i] = h; }
}

__device__ __forceinline__ void load_mo_row(f32x4 (&v)[8], const bf16_t* Ob, const float* Os, int row, int lane) {
    if (row < MPROMPT) { const u32x2* mr = (const u32x2*)(Ob + (size_t)row * DM) + lane;
#pragma unroll
        for (int j = 0; j < 8; ++j) { const u32x2 w = __builtin_nontemporal_load(mr + 64 * j); v[j] = (f32x4){bflo(w.x), bfhi(w.x), bflo(w.y), bfhi(w.y)}; } }
    else { const f32x4* mr = (const f32x4*)(Os + (size_t)(row - MPROMPT) * DM) + lane;
#pragma unroll
        for (int j = 0; j < 8; ++j) v[j] = __builtin_nontemporal_load(mr + 64 * j);
#pragma unroll 1
        for (int k0 = 1; k0 < 8; k0 += 4) { f32x4 t[4][8];
#pragma unroll
            for (int q = 0; q < 4; ++q)
#pragma unroll
                for (int j = 0; j < 8; ++j) t[q][j] = (k0 + q < 8) ? mr[(size_t)(k0 + q) * (1024 * DM / 4) + 64 * j] : (f32x4){0.f, 0.f, 0.f, 0.f};
#pragma unroll
            for (int q = 0; q < 4; ++q)
#pragma unroll
                for (int j = 0; j < 8; ++j) v[j] += t[q][j]; } }
}
__device__ __forceinline__ void mid_row(const Params& p, const f32x4 (&x)[8], f32x4 (&v)[8], const f32x4 (&G1)[8], const f32x4 (&S2)[8], const f32x4 (&sh2)[8], int row, int lane) {
    bf16_t* H = (bf16_t*)(p.ws + WS_H2);
    float ss = 0.f;
#pragma unroll
    for (int j = 0; j < 8; ++j) ss += (v[j].x * v[j].x + v[j].y * v[j].y) + (v[j].z * v[j].z + v[j].w * v[j].w);
    const float rstd = 1.0f / sqrtf(wave_sum(ss) * (1.0f / DM) + EPS);
    float ss2 = 0.f;
#pragma unroll
    for (int j = 0; j < 8; ++j) { const int col = 4 * lane + 256 * j;
        v[j] = x[j] + G1[j] * (v[j] * rstd);
        __builtin_nontemporal_store(v[j], (f32x4*)(p.out + (size_t)row * DM + col));
        ss2 += (v[j].x * v[j].x + v[j].y * v[j].y) + (v[j].z * v[j].z + v[j].w * v[j].w); }
    const float rstd2 = 1.0f / sqrtf(wave_sum(ss2) * (1.0f / DM) + EPS);
#pragma unroll
    for (int j = 0; j < 8; ++j) { const int col = 4 * lane + 256 * j;
        const f32x4 h = v[j] * rstd2 * S2[j] + sh2[j];
        u32x2 w; w.x = pk2(h.x, h.y); w.y = pk2(h.z, h.w);
        *(u32x2*)(H + (size_t)row * DM + col) = w; }
}
__device__ __forceinline__ void phase_mid(const Params& p) {
    const int tid = threadIdx.x, lane = tid & 63, wave = tid >> 6;
    const int gw = blockIdx.x * NWAVES + wave, NGW = gridDim.x * NWAVES;
    const float* ada = (const float*)(p.ws + WS_ADA);
    const bf16_t* Ob = (const bf16_t*)(p.ws + WS_MO); const float* Os = (const float*)(p.ws + WS_MOS);
    {
        f32x4 x[8], xn[8]; u32x2 mb[8], mbn[8];
        if (gw < MPROMPT) { const f32x4* xr = (const f32x4*)(p.in[I_XP] + (size_t)gw * DM) + lane; const u32x2* mr = (const u32x2*)(Ob + (size_t)gw * DM) + lane;
#pragma unroll
            for (int j = 0; j < 8; ++j) { x[j] = __builtin_nontemporal_load(xr + 64 * j); mb[j] = __builtin_nontemporal_load(mr + 64 * j); } }
        for (int row = gw; row < MPROMPT; row += NGW) {
            const float* ar = ada + (size_t)(row >> 11) * NADA;
            f32x4 G1[8], S2[8], sh2[8];
#pragma unroll
            for (int j = 0; j < 8; ++j) { const int col = 4 * lane + 256 * j; G1[j] = *(const f32x4*)(ar + 2 * DM + col); }
            if (row + NGW < MPROMPT) { const f32x4* xr = (const f32x4*)(p.in[I_XP] + (size_t)(row + NGW) * DM) + lane; const u32x2* mr = (const u32x2*)(Ob + (size_t)(row + NGW) * DM) + lane;
#pragma unroll
                for (int j = 0; j < 8; ++j) { xn[j] = __builtin_nontemporal_load(xr + 64 * j); mbn[j] = __builtin_nontemporal_load(mr + 64 * j); } }
#pragma unroll
            for (int j = 0; j < 8; ++j) { const int col = 4 * lane + 256 * j; S2[j] = *(const f32x4*)(ar + 4 * DM + col); sh2[j] = *(const f32x4*)(ar + 3 * DM + col); }
            f32x4 v[8];
#pragma unroll
            for (int j = 0; j < 8; ++j) v[j] = (f32x4){bflo(mb[j].x), bfhi(mb[j].x), bflo(mb[j].y), bfhi(mb[j].y)};
            mid_row(p, x, v, G1, S2, sh2, row, lane);
#pragma unroll
            for (int j = 0; j < 8; ++j) { x[j] = xn[j]; mb[j] = mbn[j]; }
        }
    }
    for (int row = MPROMPT + (gw >> 1); (gw & 1) == 0 && row < MTOK; row += (NGW >> 1)) {
        const float* ar = ada + (size_t)seq_of_row(row) * NADA;
        f32x4 v[8]; load_mo_row(v, Ob, Os, row, lane);
        f32x4 x[8], G1[8], S2[8], sh2[8]; const f32x4* xr = (const f32x4*)xrow_ptr(p, row) + lane;
#pragma unroll
        for (int j = 0; j < 8; ++j) { const int col = 4 * lane + 256 * j; x[j] = __builtin_nontemporal_load(xr + 64 * j); G1[j] = *(const f32x4*)(ar + 2 * DM + col); S2[j] = *(const f32x4*)(ar + 4 * DM + col); sh2[j] = *(const f32x4*)(ar + 3 * DM + col); }
        mid_row(p, x, v, G1, S2, sh2, row, lane);
    }
}

__device__ __forceinline__ void phase_ffnconv(const Params& p) {
    const int gt = blockIdx.x * NTHREADS + threadIdx.x, NGT = gridDim.x * NTHREADS;
    const bf16_t* UP = (const bf16_t*)(p.ws + WS_UP); bf16_t* F = (bf16_t*)(p.ws + WS_F2);
    constexpr int NCH = DFF / 8;
    const bf16_t* UPB = (const bf16_t*)(p.ws + WS_UPB);
    for (int it = gt; it < 128 * 2 * NCH; it += NGT) {
        const int c = it % NCH, q = it / NCH, sl = q & 1, blk = q >> 1, j0 = 8 * c, colg = (j0 >> 7) * 256 + (j0 & 127);
        const int row = blk * 64 + sl; const bool first = (blk & 31) == 0;
        float wg[3][8], wv[3][8], ag[8], av[8];
#pragma unroll
        for (int k = 0; k < 3; ++k) { ld8f(p.in[I_WFCONV] + (size_t)k * 2 * DFF + j0, wg[k]); ld8f(p.in[I_WFCONV] + (size_t)k * 2 * DFF + DFF + j0, wv[k]); }
        ld8f(p.in[I_BFCONV] + j0, ag); ld8f(p.in[I_BFCONV] + DFF + j0, av);
#pragma unroll
        for (int k = 0; k < 3; ++k) { const int d = k - 2 + sl;
            if (d < 0 && first) continue;
            const size_t ub = d < 0 ? (size_t)((blk - 1) * 4 + 4 + d) : (size_t)(blk * 4 + d);
            float xg[8], xv[8]; unpack8(*(const u32x4*)(UPB + ub * (2 * DFF) + colg), xg); unpack8(*(const u32x4*)(UPB + ub * (2 * DFF) + colg + 128), xv);
#pragma unroll
            for (int e = 0; e < 8; ++e) { ag[e] += xg[e] * wg[k][e]; av[e] += xv[e] * wv[k][e]; } }
        float f[8];
#pragma unroll
        for (int e = 0; e < 8; ++e) f[e] = gelu_tanh(ag[e]) * av[e];
        *(u32x4*)(F + (size_t)row * DFF + j0) = pack8(f);
    }
    if (gt < 170 * NCH) {
        const int c = gt % NCH, slot = gt / NCH, j0 = 8 * c, colg = (j0 >> 7) * 256 + (j0 & 127);
        float wg[3][8], wv[3][8], bg[8], bv[8];
#pragma unroll
        for (int k = 0; k < 3; ++k) { ld8f(p.in[I_WFCONV] + (size_t)k * 2 * DFF + j0, wg[k]); ld8f(p.in[I_WFCONV] + (size_t)k * 2 * DFF + DFF + j0, wv[k]); }
        ld8f(p.in[I_BFCONV] + j0, bg); ld8f(p.in[I_BFCONV] + DFF + j0, bv);
        for (int rs = slot; rs < 1024; rs += 170) {
            const int row = MPROMPT + rs, t = rs & 7, b = rs >> 3;
            float xg[3][8], xv[3][8];
#pragma unroll
            for (int k = 0; k < 3; ++k) { const int tt = t - 2 + k;
                if (tt >= 0) { unpack8(*(const u32x4*)(UP + (size_t)(row - 2 + k) * 2 * DFF + colg), xg[k]); unpack8(*(const u32x4*)(UP + (size_t)(row - 2 + k) * 2 * DFF + colg + 128), xv[k]); }
                else { const float* sp = p.in[I_SFCONV] + ((size_t)b * 2 + (2 + tt)) * 2 * DFF; ld8f(sp + j0, xg[k]); ld8f(sp + DFF + j0, xv[k]); } }
            float f[8];
#pragma unroll
            for (int e = 0; e < 8; ++e) { const float cg_ = bg[e] + xg[0][e] * wg[0][e] + xg[1][e] * wg[1][e] + xg[2][e] * wg[2][e];
                const float cv_ = bv[e] + xv[0][e] * wv[0][e] + xv[1][e] * wv[1][e] + xv[2][e] * wv[2][e]; f[e] = gelu_tanh(cg_) * cv_; }
            *(u32x4*)(F + (size_t)row * DFF + j0) = pack8(f);
        }
    }
    for (int i = gt; i < NSEQ * 2 * (2 * DFF / 8); i += NGT) { const int c = i % 1536, q = i / 1536, r = q & 1, s = q >> 1, n0 = 8 * c;
        const int j0 = n0 < DFF ? n0 : n0 - DFF, col = (j0 >> 7) * 256 + (n0 < DFF ? 0 : 128) + (j0 & 127);
        const int row = s < 4 ? s * SEQ + SEQ - 2 + r : MPROMPT + (s - 4) * 8 + 6 + r;
        float x[8];
        if (s < 4) unpack8(*(const u32x4*)(UPB + ((size_t)(s * 32 + 31) * 4 + 2 + r) * (2 * DFF) + col), x); else unpack8(*(const u32x4*)(UP + (size_t)row * 2 * DFF + col), x);
        float* o = p.out + (s < 4 ? O_FCONVP + ((size_t)s * 2 + r) * 2 * DFF : O_FCONVS + ((size_t)(s - 4) * 2 + r) * 2 * DFF) + n0;
        *(f32x4*)o = (f32x4){x[0], x[1], x[2], x[3]}; *(f32x4*)(o + 4) = (f32x4){x[4], x[5], x[6], x[7]}; }
}

__device__ __forceinline__ void phase_final(const Params& p) {
    const int tid = threadIdx.x, lane = tid & 63, wave = tid >> 6;
    const int gw = blockIdx.x * NWAVES + wave, NGW = gridDim.x * NWAVES;
    const float* ada = (const float*)(p.ws + WS_ADA);
    const bf16_t* Ob = (const bf16_t*)(p.ws + WS_FO); const float* Os = (const float*)(p.ws + WS_FOS2);
    {
        f32x4 x[8], xn[8]; u32x2 mb[8], mbn[8];
        if (gw < MPROMPT) { const f32x4* xr = (const f32x4*)(p.out + (size_t)gw * DM) + lane; const u32x2* mr = (const u32x2*)(Ob + (size_t)gw * DM) + lane;
#pragma unroll
            for (int j = 0; j < 8; ++j) { x[j] = __builtin_nontemporal_load(xr + 64 * j); mb[j] = __builtin_nontemporal_load(mr + 64 * j); } }
        for (int row = gw; row < MPROMPT; row += NGW) {
            const float* ar = ada + (size_t)(row >> 11) * NADA;
            f32x4 gt2[8];
#pragma unroll
            for (int j = 0; j < 8; ++j) { const int col = 4 * lane + 256 * j; gt2[j] = *(const f32x4*)(ar + 5 * DM + col); }
            if (row + NGW < MPROMPT) { const f32x4* xr = (const f32x4*)(p.out + (size_t)(row + NGW) * DM) + lane; const u32x2* mr = (const u32x2*)(Ob + (size_t)(row + NGW) * DM) + lane;
#pragma unroll
                for (int j = 0; j < 8; ++j) { xn[j] = __builtin_nontemporal_load(xr + 64 * j); mbn[j] = __builtin_nontemporal_load(mr + 64 * j); } }
            f32x4 v[8]; float ss = 0.f;
#pragma unroll
            for (int j = 0; j < 8; ++j) { v[j] = (f32x4){bflo(mb[j].x), bfhi(mb[j].x), bflo(mb[j].y), bfhi(mb[j].y)}; ss += (v[j].x * v[j].x + v[j].y * v[j].y) + (v[j].z * v[j].z + v[j].w * v[j].w); }
            const float rstd = 1.0f / sqrtf(wave_sum(ss) * (1.0f / DM) + EPS);
#pragma unroll
            for (int j = 0; j < 8; ++j) { const int col = 4 * lane + 256 * j;
                __builtin_nontemporal_store(x[j] + gt2[j] * (v[j] * rstd), (f32x4*)(p.out + (size_t)row * DM + col)); }
#pragma unroll
            for (int j = 0; j < 8; ++j) { x[j] = xn[j]; mb[j] = mbn[j]; }
        }
    }
    for (int row = MPROMPT + (gw >> 1); (gw & 1) == 0 && row < MTOK; row += (NGW >> 1)) {
        f32x4 v[8]; float ss = 0.f;
        load_mo_row(v, Ob, Os, row, lane);
#pragma unroll
        for (int j = 0; j < 8; ++j) ss += (v[j].x * v[j].x + v[j].y * v[j].y) + (v[j].z * v[j].z + v[j].w * v[j].w);
        const float rstd = 1.0f / sqrtf(wave_sum(ss) * (1.0f / DM) + EPS);
        const float* ar = ada + (size_t)seq_of_row(row) * NADA;
#pragma unroll
        for (int j = 0; j < 8; ++j) { const int col = 4 * lane + 256 * j;
            const f32x4 gt2 = *(const f32x4*)(ar + 5 * DM + col);
            float* o = p.out + (size_t)row * DM + col; const f32x4 x1 = *(const f32x4*)o;
            *(f32x4*)o = x1 + gt2 * (v[j] * rstd); }
    }
}

__global__ void __launch_bounds__(NTHREADS, 2) fwd_megakernel(Params p) {
    extern __shared__ __attribute__((aligned(16))) unsigned char lds_raw[];
    LAS unsigned char* lds = (LAS unsigned char*)lds_raw;
    cg::grid_group grid = cg::this_grid();
    unsigned char* ws = p.ws;
    if (ws == nullptr) grid.sync();
    volatile LAS unsigned* xst = (volatile LAS unsigned*)(lds + LDS_MAIN);
    if (threadIdx.x < 4) xst[threadIdx.x] = 0u;
    __syncthreads();
    const XcdBarrier xbar = xcd_barrier_post((unsigned*)(ws + WS_BAR), xst);
    const int G = gridDim.x, c = blockIdx.x;
    using namespace pg8;
    const size_t TA = 256ull * 2;

    if (PHASE_MASK & 1u) phase0<0>(p, lds);
    xcd_barrier(xbar);
    if (c < 48) {
        Sched S{(const char*)(ws + WS_SADA), (const char*)(ws + WS_WADA), TA * DM, TA * DM, 1, NADA / 256, DM / 64, G, c, 0, 0};
        EpiAda E{(float*)(ws + WS_ADA), p.in[I_BADA], p.in[I_GPRE1], p.in[I_GPOST1], p.in[I_GPRE2], p.in[I_GPOST2]};
        gemm_phase(lds, DM, DM, S, E);
        if (threadIdx.x == 0) { __builtin_amdgcn_fence(__ATOMIC_RELEASE, "agent"); asm volatile("s_waitcnt vmcnt(0)" ::: "memory");
            __hip_atomic_fetch_add((unsigned*)(ws + WS_BAR) + ADA_FLAG, 1u, __ATOMIC_RELAXED, __HIP_MEMORY_SCOPE_AGENT); }
    } else phase0<1>(p, lds);
    if (threadIdx.x == 0) { unsigned* f = (unsigned*)(ws + WS_BAR) + ADA_FLAG; unsigned sp = 0;
        while (__hip_atomic_load(f, __ATOMIC_RELAXED, __HIP_MEMORY_SCOPE_AGENT) < 48u) { __builtin_amdgcn_s_sleep(2); if (++sp > (1u << 20)) break; }
        __builtin_amdgcn_fence(__ATOMIC_ACQUIRE, "agent"); asm volatile("s_waitcnt vmcnt(0)" ::: "memory"); }
    __syncthreads();
    if (PHASE_MASK & 4u) phase_norm1(p);
    xcd_barrier(xbar);
    if (PHASE_MASK & 8u) {
        Sched S{(const char*)(ws + WS_H), (const char*)(ws + WS_WIN), TA * DM, TA * DM, MTOK / 256, INW / 256, DM / 64, G, c, 0, 0};
        EpiBf16 E{(bf16_t*)(ws + WS_Z), INW, 12};
        gemm_phase(lds, DM, DM, S, E);
    }
    xcd_barrier(xbar);
    if (PHASE_MASK & 16u) phase_mixprep(p);
    xcd_barrier(xbar);
    if (PHASE_MASK & 32u) {
        { Sched S{(const char*)(ws + WS_DP), (const char*)(ws + WS_WGRP), TA * PW, TA * 256, MTOK / 256, 4, 4, G, c, 0, 512};
          EpiPool E{(bf16_t*)(ws + WS_YP), p.in[I_PSCALE]};
          gemm_phase(lds, PW, 256, S, E); }
        { Sched S{(const char*)(ws + WS_XC), (const char*)(ws + WS_WGATE), TA * LW, TA * 256, MTOK / 256, 16, 4, G, (c + 80) & 255, 1, 512};
          EpiGates E{(const bf16_t*)(ws + WS_XC), (unsigned*)(ws + WS_LA), p.in[I_BRG], p.in[I_BIG], (const float*)(ws + WS_CTL)};
          gemm_phase(lds, LW, 256, S, E); }
    }
    xcd_barrier(xbar);
    if (PHASE_MASK & 64u) phase_scan(p, lds);
    xcd_barrier(xbar);
    if (PHASE_MASK & 128u) {
        { SchedP7 S{Sched{(const char*)(ws + WS_YP), (const char*)(ws + WS_WPU), TA * PW, TA * PW, 32, DM / 256, PW / 64, G, c, 0, 0}, 0, 1000};
          EpiMerge<false> E{(bf16_t*)(ws + WS_MG), (const bf16_t*)(ws + WS_Z), PW + LW, (unsigned*)(ws + WS_BAR)};
          gemm_phase(lds, PW, PW, S, E); }
        { SchedP7 S{Sched{(const char*)(ws + WS_YL), (const char*)(ws + WS_WLU), TA * LW, TA * LW, 32, DM / 256, LW / 64, G, c, 0, 0}, 32, 2000};
          EpiMerge<true> E{(bf16_t*)(ws + WS_MG), (const bf16_t*)(ws + WS_Z), PW + LW + DM, (unsigned*)(ws + WS_BAR)};
          gemm_phase(lds, LW, LW, S, E); }
        phase0<2>(p, lds);
    }
    xcd_barrier(xbar);
    if (PHASE_MASK & 256u) {
        SchedSplit S{Sched{(const char*)(ws + WS_MG), (const char*)(ws + WS_WOUT), TA * DM, TA * DM, 32, DM / 256, DM / 64, G, c, 0, 0}, 4, 0, 8, 0};
        EpiOut E{(bf16_t*)(ws + WS_MO), (float*)(ws + WS_MOS)};
        gemm_phase(lds, DM, DM, S, E);
    }
    xcd_barrier(xbar);
    if (PHASE_MASK & 512u) phase_mid(p);
    xcd_barrier(xbar);
    if (PHASE_MASK & 1024u) {
        Sched S{(const char*)(ws + WS_H2), (const char*)(ws + WS_WUP), TA * DM, TA * DM, MTOK / 256, 2 * DFF / 256, DM / 64, G, c, 0, 0};
        EpiUpFused E{(bf16_t*)(ws + WS_UP), (bf16_t*)(ws + WS_F2), (bf16_t*)(ws + WS_UPB), p.in[I_WFCONV], p.in[I_BFCONV]};
        gemm_phase(lds, DM, DM, S, E);
        phase0<3>(p, lds);
    }
    xcd_barrier(xbar);
    if (PHASE_MASK & 2048u) phase_ffnconv(p);
    xcd_barrier(xbar);
    if (PHASE_MASK & 4096u) {
        SchedSplit S{Sched{(const char*)(ws + WS_F2), (const char*)(ws + WS_WDOWN), TA * DFF, TA * DFF, 32, DM / 256, DFF / 64, G, c, 0, 0}, 12, 0, 8, 0};
        EpiOut E{(bf16_t*)(ws + WS_FO), (float*)(ws + WS_FOS2)};
        gemm_phase(lds, DFF, DFF, S, E);
    }
    xcd_barrier(xbar);
    if (PHASE_MASK & 8192u) phase_final(p);
}

extern "C" void kernel_launch(void* const* d_in, const int* in_sizes, int n_in, void* d_out, int out_size, void* d_ws, size_t ws_size, hipStream_t stream) {
    constexpr size_t kDynLds = LDS_MAIN + 64;
    static int grid_blocks = 0;
    if (!grid_blocks) {
        int dev = 0, cus = 0, per_cu = 0;
        (void)hipGetDevice(&dev);
        (void)hipDeviceGetAttribute(&cus, hipDeviceAttributeMultiprocessorCount, dev);
        (void)hipFuncSetAttribute((const void*)fwd_megakernel, hipFuncAttributeMaxDynamicSharedMemorySize, (int)kDynLds);
        (void)hipOccupancyMaxActiveBlocksPerMultiprocessor(&per_cu, (const void*)fwd_megakernel, NTHREADS, kDynLds);
        if (per_cu < 1) per_cu = 1;
        grid_blocks = cus;
        if (n_in != N_IN) fprintf(stderr, "kernel_launch: expected %d inputs, got %d\n", (int)N_IN, n_in);
    }
    Params p{};
    for (int i = 0; i < N_IN; ++i) p.in[i] = (const float*)d_in[i];
    p.out = (float*)d_out; p.ws = (unsigned char*)d_ws;
    (void)hipMemsetAsync((unsigned char*)d_ws + WS_BAR, 0, BAR_ZERO_WORDS * 4, stream);
    void* args[] = {&p};
    hipError_t e = hipLaunchCooperativeKernel((const void*)fwd_megakernel, dim3(grid_blocks), dim3(NTHREADS), args, kDynLds, stream);
    if (e != hipSuccess) fprintf(stderr, "cooperative launch failed: %s (grid %d)\n", hipGetErrorString(e), grid_blocks);
}
```

```cpp
#include <hip/hip_runtime.h>
#include <hip/hip_cooperative_groups.h>
#include <cstdio>
namespace cg = cooperative_groups;

#define LAS __attribute__((address_space(3)))
typedef unsigned short bf16_t;
typedef short bf16x8 __attribute__((ext_vector_type(8)));
typedef float f32x4 __attribute__((ext_vector_type(4)));
typedef float f32x2 __attribute__((ext_vector_type(2)));
typedef unsigned u32x4 __attribute__((ext_vector_type(4)));
typedef unsigned u32x2 __attribute__((ext_vector_type(2)));

#ifndef PHASE_MASK
#define PHASE_MASK 0xFFFFFFFFu
#endif

constexpr int DM = 2048, MTOK = 9216, MPROMPT = 8192, SEQ = 2048, NSEQ = 132;
constexpr int PW = 1024, LW = 2048, INW = 7168, DFF = 6144, NADA = 12288;
constexpr float EPS = 1e-6f;
constexpr int NTHREADS = 512, NWAVES = 8;

enum { I_XP = 0, I_XS, I_CP, I_CS, I_SPOOL, I_SLCONV, I_SLH, I_SFCONV, I_WADA, I_BADA, I_GPRE1, I_GPOST1, I_GPRE2, I_GPOST2,
       I_WIN, I_WGRP, I_PSCALE, I_WLCONV, I_BLCONV, I_WRG, I_BRG, I_WIG, I_BIG, I_LAM, I_WPU, I_WLU, I_WOUT, I_WUP, I_WFCONV, I_BFCONV, I_WDOWN, N_IN };

constexpr size_t O_YP = 0, O_YS = 16777216, O_POOLP = 18874368, O_LCONVP = O_POOLP + 61440, O_LHP = O_LCONVP + 24576, O_FCONVP = O_LHP + 8192,
                 O_POOLS = O_FCONVP + 98304, O_LCONVS = O_POOLS + 1966080, O_LHS = O_LCONVS + 786432, O_FCONVS = O_LHS + 262144;

constexpr size_t MiB = 1ull << 20;
constexpr size_t WS_ADA = 0, WS_CTL = 12 * MiB, WS_SADA = 13 * MiB, WS_WDOWN = 14 * MiB, WS_WUP = 38 * MiB,
                 WS_WGRP = 86 * MiB, WS_WGATE = 86 * MiB + 512 * 1024, WS_WPU = 89 * MiB, WS_WLU = 93 * MiB, WS_WOUT = 101 * MiB,
                 WS_WADA = 109 * MiB, WS_WIN = 157 * MiB, WS_H = 185 * MiB, WS_Z = 221 * MiB, WS_DP = 347 * MiB, WS_XC = 365 * MiB, WS_YP = 401 * MiB,
                 WS_LA = 109 * MiB, WS_UU = 181 * MiB, WS_YL = 347 * MiB, WS_MG = 109 * MiB, WS_MO = 221 * MiB, WS_UP = 221 * MiB, WS_F = 109 * MiB;

constexpr size_t WS_BAR = WS_CTL + 64 * 1024;
constexpr size_t WS_MOS = 253 * MiB;
constexpr size_t WS_MGS = 145 * MiB;
constexpr size_t WS_H2 = 109 * MiB;
constexpr size_t WS_UPB = 145 * MiB;
constexpr size_t WS_F2 = 221 * MiB;
constexpr size_t WS_FO = 109 * MiB;
constexpr size_t WS_FOS2 = 329 * MiB;
constexpr size_t WS_FOS = 253 * MiB;
constexpr int LDS_MAIN = 8 * 16640;
struct Params { const float* in[N_IN]; float* out; unsigned char* ws; };

__device__ __forceinline__ unsigned pk2(float lo, float hi) { unsigned r; asm("v_cvt_pk_bf16_f32 %0, %1, %2" : "=v"(r) : "v"(lo), "v"(hi)); return r; }
__device__ __forceinline__ float bflo(unsigned w) { return __uint_as_float(w << 16); }
__device__ __forceinline__ float bfhi(unsigned w) { return __uint_as_float(w & 0xffff0000u); }
__device__ __forceinline__ float bf1(bf16_t b) { return __uint_as_float(((unsigned)b) << 16); }
__device__ __forceinline__ float sigmoidf_(float x) { return __builtin_amdgcn_rcpf(1.0f + __expf(-x)); }
__device__ __forceinline__ float wave_sum(float v) {
#pragma unroll
    for (int o = 1; o < 64; o <<= 1) v += __shfl_xor(v, o);
    return v;
}
__device__ __forceinline__ int seq_of_row(int r) { return r < MPROMPT ? (r >> 11) : 4 + ((r - MPROMPT) >> 3); }
__device__ __forceinline__ void unpack8(const u32x4 w, float (&f)[8]) {
    f[0] = bflo(w.x); f[1] = bfhi(w.x); f[2] = bflo(w.y); f[3] = bfhi(w.y); f[4] = bflo(w.z); f[5] = bfhi(w.z); f[6] = bflo(w.w); f[7] = bfhi(w.w);
}
__device__ __forceinline__ u32x4 pack8(const float (&f)[8]) { u32x4 w; w.x = pk2(f[0], f[1]); w.y = pk2(f[2], f[3]); w.z = pk2(f[4], f[5]); w.w = pk2(f[6], f[7]); return w; }


#define XB_TMO      128
#define XB_XCNT(j)  (256  + 64 * (j))
#define XB_XSUB(j)  (1280 + 64 * (j))
#define XB_XGEN(j)  (2304 + 64 * (j))
#define XB_TOP      3328
#define XB_TOPGEN   3392
#define XCD_BAR_WORDS 3456
#define P7_FLAG(t) (XCD_BAR_WORDS + 64 * (t))
#define ADA_FLAG (XCD_BAR_WORDS + 64 * 32)
#define BAR_ZERO_WORDS (XCD_BAR_WORDS + 64 * 33)
#define XB_SPIN_CAP (1u << 18)
__device__ __forceinline__ unsigned xb_ld(unsigned* p)              { return __hip_atomic_load(p, __ATOMIC_RELAXED, __HIP_MEMORY_SCOPE_AGENT); }
__device__ __forceinline__ unsigned xb_add(unsigned* p, unsigned v) { return __hip_atomic_fetch_add(p, v, __ATOMIC_RELAXED, __HIP_MEMORY_SCOPE_AGENT); }
__device__ __forceinline__ unsigned xb_xcc_id() { return (unsigned)__builtin_amdgcn_s_getreg((3 << 11) | 20) & 0xFu; }
#define XB_SPIN(cond, bar) do { unsigned _sp = 0; while (cond) { __builtin_amdgcn_s_sleep(1); \
    if ((++_sp & 255u) == 0u) { if (xb_ld(&(bar)[XB_TMO])) break; if (_sp > XB_SPIN_CAP) { atomicAdd(&(bar)[XB_TMO], 1u); break; } } } } while (0)
struct XcdBarrier { unsigned* bar; unsigned x; volatile LAS unsigned* st; };
__device__ __forceinline__ XcdBarrier xcd_barrier_post(unsigned* bar, volatile LAS unsigned* st) {
    XcdBarrier b; b.bar = bar; b.x = xb_xcc_id(); b.st = st;
    if (threadIdx.x == 0) (void)xb_add(&bar[XB_XCNT(b.x)], 1u);
    return b;
}
__device__ __forceinline__ void xcd_barrier_complete(unsigned* bar, unsigned x, unsigned& nloc, unsigned& nx) {
    const unsigned G = gridDim.x * gridDim.y * gridDim.z;
    unsigned sum, cnt, mine, sp = 0u;
    for (;;) {
        sum = 0u; cnt = 0u; mine = 0u;
#pragma unroll
        for (unsigned j = 0; j < 16; ++j) { const unsigned c = xb_ld(&bar[XB_XCNT(j)]); sum += c; cnt += (c > 0u) ? 1u : 0u; mine = (j == x) ? c : mine; }
        if (sum == G) break;
        __builtin_amdgcn_s_sleep(1);
        if ((++sp & 255u) == 0u) { if (xb_ld(&bar[XB_TMO])) break; if (sp > XB_SPIN_CAP) { atomicAdd(&bar[XB_TMO], 1u); break; } }
    }
    nloc = mine > 0u ? mine : 1u; nx = cnt > 0u ? cnt : 1u;
}
__device__ __forceinline__ void xcd_barrier(const XcdBarrier& b) {
    asm volatile("s_waitcnt vmcnt(0)" ::: "memory");
    __syncthreads();
    if (threadIdx.x == 0) {
        unsigned* bar = b.bar;
        __builtin_amdgcn_s_waitcnt(0);
        unsigned nloc = b.st[0], nx = b.st[1];
        if (nloc == 0u) { xcd_barrier_complete(bar, b.x, nloc, nx); b.st[0] = nloc; b.st[1] = nx; }
        const unsigned old = xb_add(&bar[XB_XSUB(b.x)], 1u);
        const unsigned gen = old / nloc;
        if (old + 1u == (gen + 1u) * nloc) {
            __builtin_amdgcn_fence(__ATOMIC_RELEASE, "agent");
            asm volatile("s_waitcnt vmcnt(0)" ::: "memory");
            const unsigned og = xb_add(&bar[XB_TOP], 1u);
            const unsigned tg = og / nx;
            if (og + 1u == (tg + 1u) * nx) xb_add(&bar[XB_TOPGEN], 1u);
            else XB_SPIN(xb_ld(&bar[XB_TOPGEN]) == tg, bar);
            __builtin_amdgcn_fence(__ATOMIC_ACQUIRE, "agent");
            xb_add(&bar[XB_XGEN(b.x)], 1u);
            asm volatile("s_waitcnt vmcnt(0)" ::: "memory");
        } else {
            XB_SPIN(xb_ld(&bar[XB_XGEN(b.x)]) == gen, bar);
            __builtin_amdgcn_fence(__ATOMIC_ACQUIRE, "agent");
            asm volatile("s_waitcnt vmcnt(0)" ::: "memory");
        }
    }
    __syncthreads();
}

__device__ __forceinline__ void ld8f(const float* p, float (&x)[8]);
__device__ __forceinline__ float gelu_tanh(float x) { const float y = 1.5957691216f * (x + 0.044715f * x * x * x); return x * __builtin_amdgcn_rcpf(1.0f + __expf(-y)); }
namespace pg8 {
constexpr int BM = 256, BK = 64, HALF = 128, HTB = HALF * BK * 2, STAGE_BYTES = 8 * HTB;
__device__ __forceinline__ int lds_byte(int r, int c) { const int st = (r >> 4) * 2 + (c >> 5), rr = r & 15, cc = c & 31, ob = rr * 64 + cc * 2; return st * 1024 + (ob ^ (((ob >> 9) & 1) << 5)); }
__device__ __forceinline__ void stage_rc(int b, int& R, int& C) { const int st = b / 1024, sb = b % 1024, swz = sb ^ (((sb >> 9) & 1) << 5); R = (st >> 1) * 16 + swz / 64; C = (st & 1) * 32 + (swz % 64) / 2; }
__device__ __forceinline__ int perm32(int rho) { const int n = rho >> 4, i = rho & 15; return 8 * (i >> 2) + 4 * n + (i & 3); }

struct Unit { const char* A; const char* B; int nt, pm, pn, tag; };

struct Sched {
    const char* A; const char* B; size_t a_tile, b_tile; int nM, nN, nt, G, c, a_sh, a_mul;
    __device__ __forceinline__ bool next(int i, Unit& u) const {
        const long L = (long)i * G + c; const int nwg = nM * nN; if (L >= nwg) return false;
        int wgid = (int)L; { const int q = nwg / 8, r = nwg % 8, xcd = wgid % 8, off = wgid / 8; wgid = (xcd < r ? xcd * (q + 1) : r * (q + 1) + (xcd - r) * q) + off; }
        const int nig = 8 * nN, gid = wgid / nig, fm = gid * 8, gsz = (nM - fm) < 8 ? (nM - fm) : 8;
        u.pm = fm + ((wgid % nig) % gsz); u.pn = (wgid % nig) / gsz; u.tag = 0;
        u.A = A + (size_t)u.pm * a_tile + (size_t)((u.pn >> a_sh) * a_mul); u.B = B + (size_t)u.pn * b_tile; u.nt = nt; return true;
    }
};

template <class Epi, class S_t>
__device__ __forceinline__ void gemm_phase(LAS unsigned char* lds, int lda, int ldb, const S_t& S, const Epi& E) {
    int tid = threadIdx.x; asm volatile("" : "+v"(tid));
    const int wid = __builtin_amdgcn_readfirstlane(tid >> 6), lane = tid & 63, wr = wid >> 2, wc = wid & 3, fr = lane & 15, fq = lane >> 4;
    unsigned voffA[2], voffB[2];
#pragma unroll
    for (int i = 0; i < 2; ++i) { int R, C; stage_rc(tid * 16 + i * 8192, R, C); const int Rb = Epi::PERM ? ((R & ~31) + perm32(R & 31)) : R;
        voffA[i] = (unsigned)(R * lda + C) * 2u; voffB[i] = (unsigned)(Rb * ldb + C) * 2u; }
    const size_t kstep = (size_t)(BK * 2);
    const size_t hstepA = (size_t)HALF * lda * 2, hstepB = (size_t)HALF * ldb * 2;
    const unsigned ldsw = (unsigned)wid * 1024u;
    const int aoff = lds_byte(wr * 64 + fr, fq * 8), boff = lds_byte(wc * 32 + fr, fq * 8);
#define PG8_SA(b, h) (((b) * 2 + (h)) * HTB)
#define PG8_SB(b, h) ((4 + (b) * 2 + (h)) * HTB)
#define PG8_STAGE(bufoff, gbase, voff) do { _Pragma("unroll") for (int _i = 0; _i < 2; ++_i) \
        __builtin_amdgcn_global_load_lds((const unsigned*)((const char*)(gbase) + (voff)[_i]), (LAS unsigned*)(lds + (bufoff) + ldsw + _i * 8192), 16, 0, 0); } while (0)
#define PG8_LDA(dst, b, h) do { _Pragma("unroll") for (int m = 0; m < 4; ++m) _Pragma("unroll") for (int k = 0; k < 2; ++k) dst[m][k] = *(const LAS bf16x8*)(lds + PG8_SA(b, h) + aoff + m * 2048 + k * 1024); } while (0)
#define PG8_LDB(dst, b, h) do { _Pragma("unroll") for (int n = 0; n < 2; ++n) _Pragma("unroll") for (int k = 0; k < 2; ++k) dst[n][k] = *(const LAS bf16x8*)(lds + PG8_SB(b, h) + boff + n * 2048 + k * 1024); } while (0)
#define PG8_MMA(ai, bj, At, Bt) do { __builtin_amdgcn_s_setprio(1); _Pragma("unroll") for (int m = 0; m < 4; ++m) _Pragma("unroll") for (int n = 0; n < 2; ++n) _Pragma("unroll") for (int k = 0; k < 2; ++k) \
        acc[ai][bj][m][n] = __builtin_amdgcn_mfma_f32_16x16x32_bf16(Bt[n][k], At[m][k], acc[ai][bj][m][n], 0, 0, 0); __builtin_amdgcn_s_setprio(0); } while (0)
#define PG8_WAIT_V(n) asm volatile("s_waitcnt vmcnt(" #n ")" ::: "memory")
#define PG8_WAIT_L(n) asm volatile("s_waitcnt lgkmcnt(" #n ")" ::: "memory")
#define PG8_BAR __builtin_amdgcn_s_barrier()
#define PG8_SCHED __builtin_amdgcn_sched_barrier(0)
    Unit cur, nxt; int ui = 0;
    if (!S.next(0, cur)) return;
    f32x4 acc[2][2][4][2];
#pragma unroll
    for (int a = 0; a < 2; ++a)
#pragma unroll
        for (int b = 0; b < 2; ++b)
#pragma unroll
            for (int m = 0; m < 4; ++m)
#pragma unroll
                for (int n = 0; n < 2; ++n) acc[a][b][m][n] = (f32x4){0.f, 0.f, 0.f, 0.f};
    bf16x8 At[4][2], B0[2][2], B1[2][2];
    const char* cA = cur.A; const char* cB = cur.B;
    PG8_STAGE(PG8_SB(0, 0), cB, voffB); PG8_STAGE(PG8_SA(0, 0), cA, voffA); PG8_STAGE(PG8_SB(0, 1), cB + hstepB, voffB); PG8_STAGE(PG8_SA(0, 1), cA + hstepA, voffA);
    if (wr == 1) PG8_BAR;
    PG8_WAIT_V(4); PG8_BAR;
    PG8_STAGE(PG8_SB(1, 0), cB + kstep, voffB); PG8_STAGE(PG8_SA(1, 0), cA + kstep, voffA); PG8_STAGE(PG8_SB(1, 1), cB + hstepB + kstep, voffB);
    PG8_WAIT_V(6); PG8_BAR;
    for (;;) {
        const bool has_next = S.next(ui + 1, nxt);
        const char* nA = has_next ? nxt.A : cA; const char* nB = has_next ? nxt.B : cB;
        const int nt = cur.nt;
        for (int t = 0; t < nt; t += 2) {
            const bool last = (t == nt - 2);
            const char* a1 = cA + (size_t)(t + 1) * kstep;
            const char* a2 = last ? nA : cA + (size_t)(t + 2) * kstep; const char* b2 = last ? nB : cB + (size_t)(t + 2) * kstep;
            const char* a3 = a2 + kstep; const char* b3 = b2 + kstep;
            PG8_LDB(B0, 0, 0); PG8_SCHED; PG8_LDA(At, 0, 0); PG8_STAGE(PG8_SA(1, 1), a1 + hstepA, voffA);
            PG8_WAIT_L(8); PG8_BAR; PG8_WAIT_L(0); PG8_MMA(0, 0, At, B0); PG8_BAR; PG8_SCHED;
            PG8_LDB(B1, 0, 1); PG8_STAGE(PG8_SB(0, 0), b2, voffB);
            PG8_BAR; PG8_WAIT_L(0); PG8_MMA(0, 1, At, B1); PG8_BAR;
            PG8_LDA(At, 0, 1); PG8_STAGE(PG8_SA(0, 0), a2, voffA);
            PG8_BAR; PG8_WAIT_L(0); PG8_MMA(1, 0, At, B0); PG8_BAR; PG8_SCHED;
            PG8_STAGE(PG8_SB(0, 1), b2 + hstepB, voffB);
            PG8_WAIT_V(6); PG8_BAR; PG8_MMA(1, 1, At, B1); PG8_BAR;
            PG8_LDB(B0, 1, 0); PG8_SCHED; PG8_LDA(At, 1, 0); PG8_STAGE(PG8_SA(0, 1), a2 + hstepA, voffA);
            PG8_WAIT_L(8); PG8_BAR; PG8_WAIT_L(0); PG8_MMA(0, 0, At, B0); PG8_BAR; PG8_SCHED;
            PG8_LDB(B1, 1, 1); PG8_STAGE(PG8_SB(1, 0), b3, voffB);
            PG8_BAR; PG8_WAIT_L(0); PG8_MMA(0, 1, At, B1); PG8_BAR;
            PG8_LDA(At, 1, 1); PG8_STAGE(PG8_SA(1, 0), a3, voffA);
            PG8_BAR; PG8_WAIT_L(0); PG8_MMA(1, 0, At, B0); PG8_BAR; PG8_SCHED;
            PG8_STAGE(PG8_SB(1, 1), b3 + hstepB, voffB);
            PG8_WAIT_V(6); PG8_BAR; PG8_MMA(1, 1, At, B1); PG8_BAR;
        }
        E(acc, cur, wr, wc, fr, fq);
        if (!has_next) break;
#pragma unroll
        for (int a = 0; a < 2; ++a)
#pragma unroll
            for (int b = 0; b < 2; ++b)
#pragma unroll
                for (int m = 0; m < 4; ++m)
#pragma unroll
                    for (int n = 0; n < 2; ++n) acc[a][b][m][n] = (f32x4){0.f, 0.f, 0.f, 0.f};
        cur = nxt; cA = nA; cB = nB; ++ui;
    }
    PG8_WAIT_V(0);
    if (wr == 0) PG8_BAR;
    PG8_BAR;
#undef PG8_SA
#undef PG8_SB
#undef PG8_STAGE
#undef PG8_LDA
#undef PG8_LDB
#undef PG8_MMA
#undef PG8_WAIT_V
#undef PG8_WAIT_L
#undef PG8_BAR
#undef PG8_SCHED
}

struct EpiF32 {
    static constexpr bool PERM = false;
    float* C; int ldc; const float* bias;
    __device__ __forceinline__ void operator()(const f32x4 (&acc)[2][2][4][2], const Unit& u, int wr, int wc, int fr, int fq) const {
        const int row0 = u.pm * BM + wr * 64 + fr, col0 = u.pn * BM + wc * 32 + 4 * fq;
        f32x4 bv[2][2];
#pragma unroll
        for (int bj = 0; bj < 2; ++bj)
#pragma unroll
            for (int n = 0; n < 2; ++n) bv[bj][n] = bias ? *(const f32x4*)(bias + col0 + bj * HALF + n * 16) : (f32x4){0.f, 0.f, 0.f, 0.f};
#pragma unroll
        for (int ai = 0; ai < 2; ++ai)
#pragma unroll
            for (int m = 0; m < 4; ++m) { float* rowp = C + (size_t)(row0 + ai * HALF + m * 16) * ldc + col0;
#pragma unroll
                for (int bj = 0; bj < 2; ++bj)
#pragma unroll
                    for (int n = 0; n < 2; ++n) *(f32x4*)(rowp + bj * HALF + n * 16) = acc[ai][bj][m][n] + bv[bj][n]; }
    }
};
struct EpiAda {
    static constexpr bool PERM = false;
    float* C; const float* bias; const float* g1; const float* g2; const float* g4; const float* g5;
    __device__ __forceinline__ void operator()(const f32x4 (&acc)[2][2][4][2], const Unit& u, int wr, int wc, int fr, int fq) const {
        const int row0 = wr * 64 + fr, col0 = u.pn * BM + wc * 32 + 4 * fq, kind = u.pn >> 3;
        const float* gm = kind == 2 ? g2 : kind == 4 ? g4 : kind == 5 ? g5 : g1;
        const float one = (kind == 1 || kind == 4) ? 1.0f : 0.0f, gs = (kind == 0 || kind == 3) ? 0.0f : 1.0f;
#pragma unroll
        for (int bj = 0; bj < 2; ++bj)
#pragma unroll
            for (int n = 0; n < 2; ++n) { const int col = col0 + bj * HALF + n * 16;
                const f32x4 bv = *(const f32x4*)(bias + col) + one, gv = *(const f32x4*)(gm + (col & (DM - 1))) * gs + (1.0f - gs);
#pragma unroll
                for (int ai = 0; ai < 2; ++ai)
#pragma unroll
                    for (int m = 0; m < 4; ++m) *(f32x4*)(C + (size_t)(row0 + ai * HALF + m * 16) * NADA + col) = (acc[ai][bj][m][n] + bv) * gv; }
    }
};
struct EpiBf16 {
    static constexpr bool PERM = true;
    bf16_t* O; int ldc; int sig_pn;
    __device__ __forceinline__ void operator()(const f32x4 (&acc)[2][2][4][2], const Unit& u, int wr, int wc, int fr, int fq) const {
        const int row0 = u.pm * BM + wr * 64 + fr, col0 = u.pn * BM + wc * 32 + 8 * fq;
        const bool sg = u.pn >= sig_pn;
#pragma unroll
        for (int ai = 0; ai < 2; ++ai)
#pragma unroll
            for (int m = 0; m < 4; ++m) { bf16_t* rowp = O + (size_t)(row0 + ai * HALF + m * 16) * ldc + col0;
#pragma unroll
                for (int bj = 0; bj < 2; ++bj) { f32x4 v0 = acc[ai][bj][m][0], v1 = acc[ai][bj][m][1];
                    if (sg) {
#pragma unroll
                        for (int j = 0; j < 4; ++j) { v0[j] = sigmoidf_(v0[j]); v1[j] = sigmoidf_(v1[j]); } }
                    u32x4 w; w.x = pk2(v0[0], v0[1]); w.y = pk2(v0[2], v0[3]); w.z = pk2(v1[0], v1[1]); w.w = pk2(v1[2], v1[3]);
                    *(u32x4*)(rowp + bj * HALF) = w; } }
    }
};
struct EpiPool {
    static constexpr bool PERM = true;
    bf16_t* O; const float* scale;
    __device__ __forceinline__ void operator()(const f32x4 (&acc)[2][2][4][2], const Unit& u, int wr, int wc, int fr, int fq) const {
        const int row0 = u.pm * BM + wr * 64 + fr, col0 = u.pn * BM + wc * 32 + 8 * fq;
        f32x4 sv[2][2];
#pragma unroll
        for (int bj = 0; bj < 2; ++bj)
#pragma unroll
            for (int n = 0; n < 2; ++n) sv[bj][n] = *(const f32x4*)(scale + col0 + bj * HALF + 4 * n);
#pragma unroll
        for (int ai = 0; ai < 2; ++ai)
#pragma unroll
            for (int m = 0; m < 4; ++m) { bf16_t* rowp = O + (size_t)(row0 + ai * HALF + m * 16) * PW + col0;
#pragma unroll
                for (int bj = 0; bj < 2; ++bj) { const f32x4 v0 = acc[ai][bj][m][0] * sv[bj][0], v1 = acc[ai][bj][m][1] * sv[bj][1];
                    u32x4 w; w.x = pk2(v0[0], v0[1]); w.y = pk2(v0[2], v0[3]); w.z = pk2(v1[0], v1[1]); w.w = pk2(v1[2], v1[3]);
                    *(u32x4*)(rowp + bj * HALF) = w; } }
    }
};
struct EpiGates {
    static constexpr bool PERM = true;
    const bf16_t* XC; unsigned* LU; const float* brg; const float* big; const float* spl;
    __device__ __forceinline__ void operator()(const f32x4 (&acc)[2][2][4][2], const Unit& u, int wr, int wc, int fr, int fq) const {
        const int row0 = u.pm * BM + wr * 64 + fr, ch0 = u.pn * HALF + wc * 32 + 8 * fq;
        float br[8], bi[8], sp[8];
#pragma unroll
        for (int q = 0; q < 2; ++q) { const f32x4 a = *(const f32x4*)(brg + ch0 + 4 * q), b = *(const f32x4*)(big + ch0 + 4 * q), c = *(const f32x4*)(spl + ch0 + 4 * q);
#pragma unroll
            for (int j = 0; j < 4; ++j) { br[4 * q + j] = a[j]; bi[4 * q + j] = b[j]; sp[4 * q + j] = c[j]; } }
        u32x4 xraw[2][4];
#pragma unroll
        for (int ai = 0; ai < 2; ++ai)
#pragma unroll
            for (int m = 0; m < 4; ++m) xraw[ai][m] = *(const u32x4*)(XC + (size_t)(row0 + ai * HALF + m * 16) * LW + ch0);
        asm volatile("" ::: "memory");
#pragma unroll
        for (int ai = 0; ai < 2; ++ai)
#pragma unroll
            for (int m = 0; m < 4; ++m) { const size_t off = (size_t)(row0 + ai * HALF + m * 16) * LW + ch0;
                float xc[8]; unpack8(xraw[ai][m], xc);
                float la[8], uu[8];
#pragma unroll
                for (int n = 0; n < 2; ++n)
#pragma unroll
                    for (int j = 0; j < 4; ++j) { const int e = 4 * n + j;
                        const float r = sigmoidf_(acc[ai][0][m][n][j] + br[e]), ig = sigmoidf_(acc[ai][1][m][n][j] + bi[e]);
                        const float l = -8.0f * r * sp[e]; la[e] = l;
                        const float x2 = 2.0f * l;
                        const float om = x2 > -0.03125f ? -x2 * (1.0f + x2 * (0.5f + x2 * (0.16666667f + x2 * 0.041666668f))) : 1.0f - __expf(x2);
                        uu[e] = __builtin_amdgcn_sqrtf(om) * (ig * xc[e]); }
                u32x4 w0, w1; w0.x = pk2(la[0], uu[0]); w0.y = pk2(la[1], uu[1]); w0.z = pk2(la[2], uu[2]); w0.w = pk2(la[3], uu[3]);
                w1.x = pk2(la[4], uu[4]); w1.y = pk2(la[5], uu[5]); w1.z = pk2(la[6], uu[6]); w1.w = pk2(la[7], uu[7]);
                *(u32x4*)(LU + off) = w0; *(u32x4*)(LU + off + 4) = w1; }
    }
};
template <bool ADD> struct EpiMerge {
    static constexpr bool PERM = true;
    bf16_t* MG; const bf16_t* Z; int gcol0; unsigned* flags;
    __device__ __forceinline__ void operator()(const f32x4 (&acc)[2][2][4][2], const Unit& u, int wr, int wc, int fr, int fq) const {
        const int row0 = u.pm * BM + wr * 64 + fr, col0 = u.pn * BM + wc * 32 + 8 * fq;
        if (ADD && u.tag >= 2000) {
            unsigned* f = flags + P7_FLAG(u.tag - 2000); unsigned sp = 0;
            while ((unsigned)__builtin_amdgcn_readfirstlane(__hip_atomic_load(f, __ATOMIC_RELAXED, __HIP_MEMORY_SCOPE_AGENT)) < 8u) { __builtin_amdgcn_s_sleep(2); if (++sp > (1u << 20)) break; }
            __builtin_amdgcn_fence(__ATOMIC_ACQUIRE, "agent");
            asm volatile("s_waitcnt vmcnt(0)" ::: "memory");
        }
#pragma unroll
        for (int ai = 0; ai < 2; ++ai) {
            u32x4 gr[4][2], orw[4][2];
            asm volatile("" ::: "memory");
#pragma unroll
            for (int m = 0; m < 4; ++m)
#pragma unroll
                for (int bj = 0; bj < 2; ++bj) { const int row = row0 + ai * HALF + m * 16, col = col0 + bj * HALF;
                    gr[m][bj] = *(const u32x4*)(Z + (size_t)row * INW + gcol0 + col);
                    if (ADD) orw[m][bj] = *(const u32x4*)(MG + (size_t)row * DM + col); }
            asm volatile("" ::: "memory");
#pragma unroll
            for (int m = 0; m < 4; ++m)
#pragma unroll
                for (int bj = 0; bj < 2; ++bj) { const int row = row0 + ai * HALF + m * 16, col = col0 + bj * HALF;
                    float g[8], o[8]; unpack8(gr[m][bj], g);
                    if (ADD) unpack8(orw[m][bj], o);
#pragma unroll
                    for (int n = 0; n < 2; ++n)
#pragma unroll
                        for (int j = 0; j < 4; ++j) { const int e = 4 * n + j; o[e] = ADD ? o[e] + g[e] * acc[ai][bj][m][n][j] : g[e] * acc[ai][bj][m][n][j]; }
                    *(u32x4*)(MG + (size_t)row * DM + col) = pack8(o); }
        }
        if (!ADD && u.tag >= 1000) {
            asm volatile("s_waitcnt vmcnt(0)" ::: "memory");
            __builtin_amdgcn_fence(__ATOMIC_RELEASE, "agent");
            asm volatile("s_waitcnt vmcnt(0)" ::: "memory");
            if ((threadIdx.x & 63) == 0) __hip_atomic_fetch_add(flags + P7_FLAG(u.tag - 1000), 1u, __ATOMIC_RELAXED, __HIP_MEMORY_SCOPE_AGENT);
        }
    }
};
struct SchedSplit {
    Sched base; int ntp, kz_lo, kz_hi, mode;
    __device__ __forceinline__ bool next(int i, Unit& u) const {
        if (i == 0) return base.next(0, u);
        if (i > 1) return false;
        const int tile = base.c >> 3, kz = base.c & 7;
        if (kz < kz_lo || kz >= kz_hi) return false;
        const int k = kz - kz_lo; int koff, nt;
        if (mode == 0) { koff = k * ntp; nt = ntp; } else { koff = k < 4 ? 6 * k : 24 + 4 * (k - 4); nt = k < 4 ? 6 : 4; }
        u.pm = 32 + (tile >> 3); u.pn = tile & 7; u.tag = 1 + kz; u.nt = nt;
        u.A = base.A + (size_t)u.pm * base.a_tile + (size_t)koff * 128; u.B = base.B + (size_t)u.pn * base.b_tile + (size_t)koff * 128; return true;
    }
};
struct SchedP7 {
    Sched base; int lo, tg;
    __device__ __forceinline__ bool next(int i, Unit& u) const {
        if (i == 0) return base.next(0, u);
        const int t = base.c - lo;
        if (i > 1 || t < 0 || t >= 32) return false;
        u.pm = 32 + (t >> 3); u.pn = t & 7; u.tag = tg + t; u.nt = base.nt;
        u.A = base.A + (size_t)u.pm * base.a_tile; u.B = base.B + (size_t)u.pn * base.b_tile; return true;
    }
};
struct EpiOut {
    static constexpr bool PERM = true;
    bf16_t* Ob; float* Os;
    __device__ __forceinline__ void operator()(const f32x4 (&acc)[2][2][4][2], const Unit& u, int wr, int wc, int fr, int fq) const {
        const int col0 = u.pn * BM + wc * 32 + 8 * fq;
        if (u.tag == 0) {
            const int row0 = u.pm * BM + wr * 64 + fr;
#pragma unroll
            for (int ai = 0; ai < 2; ++ai)
#pragma unroll
                for (int m = 0; m < 4; ++m) { bf16_t* rowp = Ob + (size_t)(row0 + ai * HALF + m * 16) * DM + col0;
#pragma unroll
                    for (int bj = 0; bj < 2; ++bj) { const f32x4 v0 = acc[ai][bj][m][0], v1 = acc[ai][bj][m][1];
                        u32x4 w; w.x = pk2(v0[0], v0[1]); w.y = pk2(v0[2], v0[3]); w.z = pk2(v1[0], v1[1]); w.w = pk2(v1[2], v1[3]);
                        *(u32x4*)(rowp + bj * HALF) = w; } }
        } else {
            const int row0 = (u.pm - 32) * BM + wr * 64 + fr;
            float* Op = Os + (size_t)(u.tag - 1) * (1024ull * DM);
#pragma unroll
            for (int ai = 0; ai < 2; ++ai)
#pragma unroll
                for (int m = 0; m < 4; ++m) { float* rowp = Op + (size_t)(row0 + ai * HALF + m * 16) * DM + col0;
#pragma unroll
                    for (int bj = 0; bj < 2; ++bj)
#pragma unroll
                        for (int n = 0; n < 2; ++n) *(f32x4*)(rowp + bj * HALF + 4 * n) = acc[ai][bj][m][n]; }
        }
    }
};
__device__ __forceinline__ float dpp_shr1(float old, float src) { return __int_as_float(__builtin_amdgcn_update_dpp(__float_as_int(old), __float_as_int(src), 0x111, 0xf, 0xf, false)); }
__device__ __forceinline__ float dpp_shr2(float old, float src) { return __int_as_float(__builtin_amdgcn_update_dpp(__float_as_int(old), __float_as_int(src), 0x112, 0xf, 0xf, false)); }
__device__ __forceinline__ float dpp_ror1(float src) { return __int_as_float(__builtin_amdgcn_update_dpp(0, __float_as_int(src), 0x121, 0xf, 0xf, false)); }
__device__ __forceinline__ float dpp_ror2(float src) { return __int_as_float(__builtin_amdgcn_update_dpp(0, __float_as_int(src), 0x122, 0xf, 0xf, false)); }
struct EpiUpFused {
    static constexpr bool PERM = true;
    bf16_t* UP; bf16_t* F; bf16_t* UPB; const float* wconv; const float* bconv;
    __device__ __forceinline__ void operator()(const f32x4 (&acc)[2][2][4][2], const Unit& u, int wr, int wc, int fr, int fq) const {
        const int row0 = u.pm * BM + wr * 64 + fr, col0 = u.pn * BM + wc * 32 + 8 * fq;
        if (u.pm >= 32) {
#pragma unroll
            for (int ai = 0; ai < 2; ++ai)
#pragma unroll
                for (int m = 0; m < 4; ++m) { bf16_t* rowp = UP + (size_t)(row0 + ai * HALF + m * 16) * (2 * DFF) + col0;
#pragma unroll
                    for (int bj = 0; bj < 2; ++bj) { const f32x4 v0 = acc[ai][bj][m][0], v1 = acc[ai][bj][m][1];
                        u32x4 w; w.x = pk2(v0[0], v0[1]); w.y = pk2(v0[2], v0[3]); w.z = pk2(v1[0], v1[1]); w.w = pk2(v1[2], v1[3]);
                        *(u32x4*)(rowp + bj * HALF) = w; } }
            return;
        }
        const int j0 = u.pn * HALF + wc * 32 + 8 * fq;
        u32x2 res0[8];
#pragma unroll
        for (int n = 0; n < 2; ++n) {
            asm volatile("" ::: "memory");
            const int jc = j0 + 4 * n;
            const f32x4 wg0 = *(const f32x4*)(wconv + jc), wg1 = *(const f32x4*)(wconv + 2 * DFF + jc), wg2 = *(const f32x4*)(wconv + 4 * DFF + jc), bg = *(const f32x4*)(bconv + jc);
            const f32x4 wv0 = *(const f32x4*)(wconv + DFF + jc), wv1 = *(const f32x4*)(wconv + 3 * DFF + jc), wv2 = *(const f32x4*)(wconv + 5 * DFF + jc), bv = *(const f32x4*)(bconv + DFF + jc);
#pragma unroll
            for (int ai = 0; ai < 2; ++ai)
#pragma unroll
                for (int m = 0; m < 4; ++m) { const int row = row0 + ai * HALF + m * 16;
                    const f32x4 g0 = acc[ai][0][m][n], v0 = acc[ai][1][m][n];
                    f32x4 gp = (f32x4){0.f, 0.f, 0.f, 0.f}, vp = gp;
                    if (m > 0) { gp = acc[ai][0][m > 0 ? m - 1 : 0][n]; vp = acc[ai][1][m > 0 ? m - 1 : 0][n]; }
                    f32x4 f;
#pragma unroll
                    for (int j = 0; j < 4; ++j) {
                        const float g1 = dpp_shr1(dpp_ror1(gp[j]), g0[j]), g2 = dpp_shr2(dpp_ror2(gp[j]), g0[j]);
                        const float v1 = dpp_shr1(dpp_ror1(vp[j]), v0[j]), v2 = dpp_shr2(dpp_ror2(vp[j]), v0[j]);
                        const float cg_ = bg[j] + g2 * wg0[j] + g1 * wg1[j] + g0[j] * wg2[j];
                        const float cv_ = bv[j] + v2 * wv0[j] + v1 * wv1[j] + v0[j] * wv2[j];
                        f[j] = gelu_tanh(cg_) * cv_; }
                    u32x2 w; w.x = pk2(f[0], f[1]); w.y = pk2(f[2], f[3]);
                    if (n == 0) res0[ai * 4 + m] = w;
                    else if (m > 0 || fr >= 2) { u32x4 w4; w4.x = res0[ai * 4 + m].x; w4.y = res0[ai * 4 + m].y; w4.z = w.x; w4.w = w.y; *(u32x4*)(F + (size_t)row * DFF + j0) = w4; }
                    if (n == 1 && ((m == 0 && fr < 2) || (m == 3 && fr >= 14))) { const int slot = m == 0 ? fr : fr - 12;
                        const f32x4 ga = acc[ai][0][m][0], va = acc[ai][1][m][0];
                        bf16_t* bp = UPB + ((size_t)(row >> 6) * 4 + slot) * (2 * DFF) + col0;
                        u32x4 wg_, wv_; wg_.x = pk2(ga[0], ga[1]); wg_.y = pk2(ga[2], ga[3]); wg_.z = pk2(g0[0], g0[1]); wg_.w = pk2(g0[2], g0[3]);
                        wv_.x = pk2(va[0], va[1]); wv_.y = pk2(va[2], va[3]); wv_.z = pk2(v0[0], v0[1]); wv_.w = pk2(v0[2], v0[3]);
                        *(u32x4*)bp = wg_; *(u32x4*)(bp + HALF) = wv_; } }
        }
    }
};
}

__device__ __forceinline__ void cvt_item(const float* __restrict__ W, int N, bf16_t* WT, int K, int k0, int n0, int drow0, LAS float* scr, int lane) {
    float v[64];
#pragma unroll
    for (int kk = 0; kk < 64; ++kk) v[kk] = __builtin_nontemporal_load(W + (size_t)(k0 + kk) * N + n0 + lane);
#pragma unroll
    for (int kk = 0; kk < 64; ++kk) scr[kk * 65 + lane] = v[kk];
    asm volatile("s_waitcnt lgkmcnt(0)" ::: "memory");
    const int c = lane & 7;
#pragma unroll
    for (int j = 0; j < 8; ++j) { const int n = (lane >> 3) + 8 * j; const LAS float* s = scr + (8 * c) * 65 + n;
        u32x4 o; o.x = pk2(s[0 * 65], s[1 * 65]); o.y = pk2(s[2 * 65], s[3 * 65]); o.z = pk2(s[4 * 65], s[5 * 65]); o.w = pk2(s[6 * 65], s[7 * 65]);
        *(u32x4*)(WT + (size_t)(drow0 + n) * K + k0 + 8 * c) = o; }
    asm volatile("s_waitcnt lgkmcnt(0)" ::: "memory");
}

template <int PART> __device__ __forceinline__ void phase0(const Params& p, LAS unsigned char* lds) {
    constexpr int SKIP = PART == 0 ? 0 : PART == 1 ? 48 : 192;
    const int tid = threadIdx.x, lane = tid & 63, wave = tid >> 6;
    const int gw = ((int)blockIdx.x - SKIP) * NWAVES + wave, NGW = ((int)gridDim.x - SKIP) * NWAVES;
    if (gw < 0) return;
    const int gt = blockIdx.x * NTHREADS + tid, NGT = gridDim.x * NTHREADS;
    unsigned char* ws = p.ws;
    LAS float* scr = (LAS float*)(lds + wave * 16640);
    constexpr int I0 = 32 * 192, I1 = 32 * 112, I2 = 32 * 192, I3 = 96 * 32, I4 = 32 * 32, I5 = 32 * 32, I6 = 16 * 32, I7 = 64, I8 = 128, I9 = 128;
    constexpr int NIT = I0 + I1 + I2 + I3 + I4 + I5 + I6 + I7 + I8 + I9;
    constexpr int U0 = I0 + I1, U1 = U0 + I2 / 2, D0 = I0 + I1 + I2, D1 = D0 + I3;
    constexpr int CUT = (U1 - U0) + I3;
    constexpr int LO = PART == 0 ? 0 : PART == 1 ? I0 : PART == 2 ? U0 : D0, HI = PART == 0 ? I0 : PART == 1 ? NIT - CUT : PART == 2 ? U1 : D1;
    for (int it0 = LO + gw; it0 < HI; it0 += NGW) {
        int it = it0;
        if (PART == 1) { if (it >= U0) it += U1 - U0; if (it >= D0) it += I3; }
        int r = it;
        if (r < I0) { const int nb = r % 192, kb = r / 192; cvt_item(p.in[I_WADA], NADA, (bf16_t*)(ws + WS_WADA), DM, 64 * kb, 64 * nb, 64 * nb, scr, lane); continue; } r -= I0;
        if (r < I1) { const int nb = r % 112, kb = r / 112; cvt_item(p.in[I_WIN], INW, (bf16_t*)(ws + WS_WIN), DM, 64 * kb, 64 * nb, 64 * nb, scr, lane); continue; } r -= I1;
        if (r < I2) { const int nb = r % 192, kb = r / 192; const int n0 = 64 * nb; const int j0 = n0 < DFF ? n0 : n0 - DFF;
            const int drow = (j0 >> 7) * 256 + (n0 < DFF ? 0 : 128) + (j0 & 127);
            cvt_item(p.in[I_WUP], 2 * DFF, (bf16_t*)(ws + WS_WUP), DM, 64 * kb, n0, drow, scr, lane); continue; } r -= I2;
        if (r < I3) { const int nb = r % 32, kb = r / 32; cvt_item(p.in[I_WDOWN], DM, (bf16_t*)(ws + WS_WDOWN), DFF, 64 * kb, 64 * nb, 64 * nb, scr, lane); continue; } r -= I3;
        if (r < I4) { const int nb = r % 32, kb = r / 32; cvt_item(p.in[I_WOUT], DM, (bf16_t*)(ws + WS_WOUT), DM, 64 * kb, 64 * nb, 64 * nb, scr, lane); continue; } r -= I4;
        if (r < I5) { const int nb = r % 32, kb = r / 32; cvt_item(p.in[I_WLU], DM, (bf16_t*)(ws + WS_WLU), LW, 64 * kb, 64 * nb, 64 * nb, scr, lane); continue; } r -= I5;
        if (r < I6) { const int nb = r % 32, kb = r / 32; cvt_item(p.in[I_WPU], DM, (bf16_t*)(ws + WS_WPU), PW, 64 * kb, 64 * nb, 64 * nb, scr, lane); continue; } r -= I6;
        if (r < I7) { const int g = r >> 4, q = r & 15, kb = q >> 2, nb = q & 3;
            cvt_item(p.in[I_WGRP] + (size_t)g * 65536, 256, (bf16_t*)(ws + WS_WGRP) + (size_t)g * 65536, 256, 64 * kb, 64 * nb, 64 * nb, scr, lane); continue; } r -= I7;
        { const bool isig = r >= I8; if (isig) r -= I8;
          const int blk = r >> 4, q = r & 15, kb = q >> 2, nb = q & 3, n0 = 64 * nb;
          const int drow = (blk * 2 + (n0 >> 7)) * 256 + (isig ? 128 : 0) + (n0 & 127);
          cvt_item(p.in[isig ? I_WIG : I_WRG] + (size_t)blk * 65536, 256, (bf16_t*)(ws + WS_WGATE), 256, 64 * kb, n0, drow, scr, lane); }
    }
    if (PART != 0) return;
    bf16_t* sada = (bf16_t*)(ws + WS_SADA);
    for (int i = gt; i < 256 * DM; i += NGT) { const int r = i >> 11, k = i & 2047;
        float v = 0.f; if (r < 4) v = p.in[I_CP][r * DM + k]; else if (r < NSEQ) v = p.in[I_CS][(r - 4) * DM + k];
        const float s = v * sigmoidf_(v);
        sada[i] = (bf16_t)(pk2(s, s) & 0xffffu); }
    float* spl = (float*)(ws + WS_CTL);
    for (int i = gt; i < LW; i += NGT) spl[i] = log1pf(expf(-p.in[I_LAM][i]));
}

__device__ __forceinline__ const float* xrow_ptr(const Params& p, int row) { return row < MPROMPT ? p.in[I_XP] + (size_t)row * DM : p.in[I_XS] + (size_t)(row - MPROMPT) * DM; }

__device__ __forceinline__ void norm1_row(const Params& p, const f32x4 (&v)[8], const f32x4 (&sc)[8], const f32x4 (&sh)[8], int row, int lane) {
    bf16_t* H = (bf16_t*)(p.ws + WS_H);
    float ss = 0.f;
#pragma unroll
    for (int j = 0; j < 8; ++j) ss += (v[j].x * v[j].x + v[j].y * v[j].y) + (v[j].z * v[j].z + v[j].w * v[j].w);
    const float rstd = 1.0f / sqrtf(wave_sum(ss) * (1.0f / DM) + EPS);
#pragma unroll
    for (int j = 0; j < 8; ++j) { const int col = 4 * lane + 256 * j;
        const f32x4 h = v[j] * rstd * sc[j] + sh[j];
        u32x2 w; w.x = pk2(h.x, h.y); w.y = pk2(h.z, h.w);
        *(u32x2*)(H + (size_t)row * DM + col) = w; }
}
__device__ __forceinline__ void phase_norm1(const Params& p) {
    const int tid = threadIdx.x, lane = tid & 63, wave = tid >> 6;
    const int gw = blockIdx.x * NWAVES + wave, NGW = gridDim.x * NWAVES;
    const float* ada = (const float*)(p.ws + WS_ADA);
    f32x4 v[8], vn[8];
    if (gw < MPROMPT) { const f32x4* xr = (const f32x4*)(p.in[I_XP] + (size_t)gw * DM) + lane;
#pragma unroll
        for (int j = 0; j < 8; ++j) v[j] = __builtin_nontemporal_load(xr + 64 * j); }
    for (int row = gw; row < MPROMPT; row += NGW) {
        const float* ar = ada + (size_t)(row >> 11) * NADA;
        f32x4 sc[8], sh[8];
#pragma unroll
        for (int j = 0; j < 8; ++j) { const int col = 4 * lane + 256 * j; sc[j] = *(const f32x4*)(ar + DM + col); sh[j] = *(const f32x4*)(ar + col); }
        if (row + NGW < MPROMPT) { const f32x4* xr = (const f32x4*)(p.in[I_XP] + (size_t)(row + NGW) * DM) + lane;
#pragma unroll
            for (int j = 0; j < 8; ++j) vn[j] = __builtin_nontemporal_load(xr + 64 * j); }
        norm1_row(p, v, sc, sh, row, lane);
#pragma unroll
        for (int j = 0; j < 8; ++j) v[j] = vn[j];
    }
    for (int row = MPROMPT + (gw >> 1); (gw & 1) == 0 && row < MTOK; row += (NGW >> 1)) {
        const float* ar = ada + (size_t)seq_of_row(row) * NADA; const f32x4* xr = (const f32x4*)xrow_ptr(p, row) + lane;
        f32x4 x[8], sc[8], sh[8];
#pragma unroll
        for (int j = 0; j < 8; ++j) { const int col = 4 * lane + 256 * j; x[j] = __builtin_nontemporal_load(xr + 64 * j); sc[j] = *(const f32x4*)(ar + DM + col); sh[j] = *(const f32x4*)(ar + col); }
        norm1_row(p, x, sc, sh, row, lane);
    }
}

__device__ __forceinline__ void ld8f(const float* p, float (&x)[8]) { const f32x4 a = *(const f32x4*)p, c = *(const f32x4*)(p + 4); x[0] = a.x; x[1] = a.y; x[2] = a.z; x[3] = a.w; x[4] = c.x; x[5] = c.y; x[6] = c.z; x[7] = c.w; }
template <int W> __device__ __forceinline__ void pool_run(const bf16_t* zp, bf16_t* dp, int t0) {
    u32x2 raw[15 + W];
#pragma unroll
    for (int i = 0; i < 15 + W; ++i) { const int rr = i - (W - 1); raw[i] = (u32x2){0u, 0u}; if (t0 + rr >= 0) raw[i] = __builtin_nontemporal_load((const u32x2*)(zp + (ptrdiff_t)rr * INW)); }
    float s[4] = {0.f, 0.f, 0.f, 0.f};
#pragma unroll
    for (int i = 0; i < W - 1; ++i) { s[0] += bflo(raw[i].x); s[1] += bfhi(raw[i].x); s[2] += bflo(raw[i].y); s[3] += bfhi(raw[i].y); }
#pragma unroll
    for (int i = 0; i < 16; ++i) { const u32x2 cu = raw[i + W - 1]; const float u0 = bflo(cu.x), u1 = bfhi(cu.x), u2 = bflo(cu.y), u3 = bfhi(cu.y);
        s[0] += u0; s[1] += u1; s[2] += u2; s[3] += u3;
        const int t = t0 + i; const float inv = 1.0f / (float)((t + 1) < W ? (t + 1) : W);
        u32x2 o; o.x = pk2(s[0] * inv - u0, s[1] * inv - u1); o.y = pk2(s[2] * inv - u2, s[3] * inv - u3);
        *(u32x2*)(dp + (size_t)i * PW) = o;
        const u32x2 od = raw[i]; s[0] -= bflo(od.x); s[1] -= bfhi(od.x); s[2] -= bflo(od.y); s[3] -= bfhi(od.y); }
}
__device__ __forceinline__ void phase_mixprep(const Params& p) {
    const int gt = blockIdx.x * NTHREADS + threadIdx.x, NGT = gridDim.x * NTHREADS;
    const bf16_t* Z = (const bf16_t*)(p.ws + WS_Z); bf16_t* Dp = (bf16_t*)(p.ws + WS_DP); bf16_t* XC = (bf16_t*)(p.ws + WS_XC);
    for (int it = gt; it < (MPROMPT / 16) * 256; it += NGT) {
        const int c4 = it & 255, run = it >> 8, ch0 = 4 * c4, g = ch0 >> 8, r0 = run * 16, t0 = r0 & (SEQ - 1);
        const bf16_t* zp = Z + (size_t)r0 * INW + ch0;
        switch (g) { case 0: pool_run<2>(zp, Dp + (size_t)r0 * PW + ch0, t0); break; case 1: pool_run<4>(zp, Dp + (size_t)r0 * PW + ch0, t0); break;
                     case 2: pool_run<8>(zp, Dp + (size_t)r0 * PW + ch0, t0); break; default: pool_run<16>(zp, Dp + (size_t)r0 * PW + ch0, t0); break; }
    }
    for (int it = gt; it < 1024 * 128; it += NGT) {
        const int row = MPROMPT + (it >> 7), ch0 = (it & 127) * 8, g = ch0 >> 8, w = 2 << g;
        const int b = (row - MPROMPT) >> 3, t = (row - MPROMPT) & 7;
        u32x4 zr[8]; f32x4 sa[15], sb[15];
#pragma unroll
        for (int j = 0; j < 8; ++j) { zr[j] = (u32x4){0u, 0u, 0u, 0u}; if (j <= t && j < w) zr[j] = *(const u32x4*)(Z + (size_t)(row - j) * INW + ch0); }
#pragma unroll
        for (int k = 0; k < 15; ++k) { const int j = t + 15 - k;
            sa[k] = (f32x4){0.f, 0.f, 0.f, 0.f}; sb[k] = sa[k];
            if (j < w) { const float* sp = p.in[I_SPOOL] + ((size_t)b * 15 + k) * PW + ch0; sa[k] = *(const f32x4*)sp; sb[k] = *(const f32x4*)(sp + 4); } }
        float s[8], u[8]; unpack8(zr[0], u);
#pragma unroll
        for (int e = 0; e < 8; ++e) s[e] = u[e];
#pragma unroll
        for (int j = 1; j < 8; ++j) { float x[8]; unpack8(zr[j], x);
#pragma unroll
            for (int e = 0; e < 8; ++e) s[e] += x[e]; }
#pragma unroll
        for (int k = 0; k < 15; ++k) { s[0] += sa[k].x; s[1] += sa[k].y; s[2] += sa[k].z; s[3] += sa[k].w; s[4] += sb[k].x; s[5] += sb[k].y; s[6] += sb[k].z; s[7] += sb[k].w; }
        const float inv = 1.0f / (float)w; float d[8];
#pragma unroll
        for (int e = 0; e < 8; ++e) d[e] = s[e] * inv - u[e];
        *(u32x4*)(Dp + (size_t)row * PW + ch0) = pack8(d);
    }
    for (int it = gt; it < (MPROMPT / 8) * 256; it += NGT) {
        const int c8 = it & 255, run = it >> 8, ch0 = 8 * c8, r0 = run * 8, t0 = r0 & (SEQ - 1);
        u32x4 raw[11];
#pragma unroll
        for (int i = 0; i < 11; ++i) { const int tt = t0 - 3 + i; raw[i] = (u32x4){0u, 0u, 0u, 0u}; if (tt >= 0) raw[i] = __builtin_nontemporal_load((const u32x4*)(Z + (size_t)(r0 - 3 + i) * INW + PW + ch0)); }
        float wk[4][8], bb[8];
#pragma unroll
        for (int k = 0; k < 4; ++k) ld8f(p.in[I_WLCONV] + (size_t)k * LW + ch0, wk[k]);
        ld8f(p.in[I_BLCONV] + ch0, bb);
        float x0[8], x1[8], x2[8], x3[8];
        unpack8(raw[0], x0); unpack8(raw[1], x1); unpack8(raw[2], x2);
#pragma unroll
        for (int i = 0; i < 8; ++i) { unpack8(raw[3 + i], x3); float o[8];
#pragma unroll
            for (int e = 0; e < 8; ++e) { o[e] = bb[e] + x0[e] * wk[0][e] + x1[e] * wk[1][e] + x2[e] * wk[2][e] + x3[e] * wk[3][e]; x0[e] = x1[e]; x1[e] = x2[e]; x2[e] = x3[e]; }
            *(u32x4*)(XC + (size_t)(r0 + i) * LW + ch0) = pack8(o); }
    }
    for (int it = gt; it < 1024 * 256; it += NGT) {
        const int row = MPROMPT + (it >> 8), ch0 = (it & 255) * 8;
        float acc[8]; ld8f(p.in[I_BLCONV] + ch0, acc);
        const int t = (row - MPROMPT) & 7, b = (row - MPROMPT) >> 3;
#pragma unroll
        for (int k = 0; k < 4; ++k) { const int tt = t - 3 + k; float x[8];
            if (tt >= 0) unpack8(*(const u32x4*)(Z + (size_t)(row - 3 + k) * INW + PW + ch0), x);
            else ld8f(p.in[I_SLCONV] + ((size_t)b * 3 + (3 + tt)) * LW + ch0, x);
            float wv[8]; ld8f(p.in[I_WLCONV] + (size_t)k * LW + ch0, wv);
#pragma unroll
            for (int e = 0; e < 8; ++e) acc[e] += x[e] * wv[e]; }
        *(u32x4*)(XC + (size_t)row * LW + ch0) = pack8(acc);
    }
    float* out = p.out;
    for (int i = gt; i < 4 * 15 * PW / 8; i += NGT) { const int ch = (i & 127) * 8, q = i >> 7, b = q / 15, r = q % 15;
        float x[8]; unpack8(*(const u32x4*)(Z + (size_t)(b * SEQ + SEQ - 15 + r) * INW + ch), x);
        float* o = out + O_POOLP + (size_t)q * PW + ch; *(f32x4*)o = (f32x4){x[0], x[1], x[2], x[3]}; *(f32x4*)(o + 4) = (f32x4){x[4], x[5], x[6], x[7]}; }
    for (int i = gt; i < 128 * 15 * PW / 8; i += NGT) { const int ch = (i & 127) * 8, q = i >> 7, b = q / 15, r = q % 15;
        float x[8];
        if (r < 7) ld8f(p.in[I_SPOOL] + ((size_t)b * 15 + 8 + r) * PW + ch, x); else unpack8(*(const u32x4*)(Z + (size_t)(MPROMPT + b * 8 + r - 7) * INW + ch), x);
        float* o = out + O_POOLS + (size_t)q * PW + ch; *(f32x4*)o = (f32x4){x[0], x[1], x[2], x[3]}; *(f32x4*)(o + 4) = (f32x4){x[4], x[5], x[6], x[7]}; }
    for (int i = gt; i < 4 * 3 * LW / 8; i += NGT) { const int ch = (i & 255) * 8, q = i >> 8, b = q / 3, r = q % 3;
        float x[8]; unpack8(*(const u32x4*)(Z + (size_t)(b * SEQ + SEQ - 3 + r) * INW + PW + ch), x);
        float* o = out + O_LCONVP + (size_t)q * LW + ch; *(f32x4*)o = (f32x4){x[0], x[1], x[2], x[3]}; *(f32x4*)(o + 4) = (f32x4){x[4], x[5], x[6], x[7]}; }
    for (int i = gt; i < 128 * 3 * LW / 8; i += NGT) { const int ch = (i & 255) * 8, q = i >> 8, b = q / 3, r = q % 3;
        float x[8]; unpack8(*(const u32x4*)(Z + (size_t)(MPROMPT + b * 8 + 5 + r) * INW + PW + ch), x);
        float* o = out + O_LCONVS + (size_t)q * LW + ch; *(f32x4*)o = (f32x4){x[0], x[1], x[2], x[3]}; *(f32x4*)(o + 4) = (f32x4){x[4], x[5], x[6], x[7]}; }
}

__device__ __forceinline__ void phase_scan(const Params& p, LAS unsigned char* lds) {
    const int tid = threadIdx.x;
    const unsigned* LU = (const unsigned*)(p.ws + WS_LA); bf16_t* YL = (bf16_t*)(p.ws + WS_YL);
    LAS float* sA = (LAS float*)lds; LAS float* sH = sA + 512;
    for (int item = blockIdx.x; item < 256; item += gridDim.x) {
        const int b = item >> 6, c32 = tid & 31, ch = (item & 63) * 32 + c32, chunk = tid >> 5;
        const size_t base = (size_t)(b * SEQ + chunk * 128) * LW + ch;
        float h = 0.f, sla = 0.f;
#pragma unroll 8
        for (int s = 0; s < 128; ++s) { const unsigned lw = LU[base + (size_t)s * LW]; const float la = bflo(lw), u = bfhi(lw); h = __expf(la) * h + u; sla += la; }
        sA[chunk * 32 + c32] = __expf(sla); sH[chunk * 32 + c32] = h;
        __syncthreads();
        float hin = 0.f;
        for (int j = 0; j < chunk; ++j) hin = sA[j * 32 + c32] * hin + sH[j * 32 + c32];
        h = hin;
#pragma unroll 8
        for (int s = 0; s < 128; ++s) { const unsigned lw = __builtin_nontemporal_load(LU + base + (size_t)s * LW); const float la = bflo(lw), u = bfhi(lw); h = __expf(la) * h + u;
            YL[base + (size_t)s * LW] = (bf16_t)(pk2(h, h) & 0xffffu); }
        if (chunk == 15) p.out[O_LHP + b * LW + ch] = h;
        __syncthreads();
    }
    const int gt = blockIdx.x * NTHREADS + tid, NGT = gridDim.x * NTHREADS;
    for (int i = gt; i < 128 * LW; i += NGT) { const int b = i >> 11, ch = i & 2047;
        float h = p.in[I_SLH][i]; const size_t base = (size_t)(MPROMPT + b * 8) * LW + ch;
#pragma unroll
        for (int s = 0; s < 8; ++s) { const unsigned lw = LU[base + (size_t)s * LW]; const float la = bflo(lw), u = bfhi(lw); h = __expf(la) * h + u;
            YL[base + (size_t)s * LW] = (bf16_t)(pk2(h, h) & 0xffffu); }
        p.out[O_LHS + i] = h; }
}

__device__ __forceinline__ void load_mo_row(f32x4 (&v)[8], const bf16_t* Ob, const float* Os, int row, int lane) {
    if (row < MPROMPT) { const u32x2* mr = (const u32x2*)(Ob + (size_t)row * DM) + lane;
#pragma unroll
        for (int j = 0; j < 8; ++j) { const u32x2 w = __builtin_nontemporal_load(mr + 64 * j); v[j] = (f32x4){bflo(w.x), bfhi(w.x), bflo(w.y), bfhi(w.y)}; } }
    else { const f32x4* mr = (const f32x4*)(Os + (size_t)(row - MPROMPT) * DM) + lane;
#pragma unroll
        for (int j = 0; j < 8; ++j) v[j] = __builtin_nontemporal_load(mr + 64 * j);
#pragma unroll 1
        for (int k0 = 1; k0 < 8; k0 += 4) { f32x4 t[4][8];
#pragma unroll
            for (int q = 0; q < 4; ++q)
#pragma unroll
                for (int j = 0; j < 8; ++j) t[q][j] = (k0 + q < 8) ? mr[(size_t)(k0 + q) * (1024 * DM / 4) + 64 * j] : (f32x4){0.f, 0.f, 0.f, 0.f};
#pragma unroll
            for (int q = 0; q < 4; ++q)
#pragma unroll
                for (int j = 0; j < 8; ++j) v[j] += t[q][j]; } }
}
__device__ __forceinline__ void mid_row(const Params& p, const f32x4 (&x)[8], f32x4 (&v)[8], const f32x4 (&G1)[8], const f32x4 (&S2)[8], const f32x4 (&sh2)[8], int row, int lane) {
    bf16_t* H = (bf16_t*)(p.ws + WS_H2);
    float ss = 0.f;
#pragma unroll
    for (int j = 0; j < 8; ++j) ss += (v[j].x * v[j].x + v[j].y * v[j].y) + (v[j].z * v[j].z + v[j].w * v[j].w);
    const float rstd = 1.0f / sqrtf(wave_sum(ss) * (1.0f / DM) + EPS);
    float ss2 = 0.f;
#pragma unroll
    for (int j = 0; j < 8; ++j) { const int col = 4 * lane + 256 * j;
        v[j] = x[j] + G1[j] * (v[j] * rstd);
        __builtin_nontemporal_store(v[j], (f32x4*)(p.out + (size_t)row * DM + col));
        ss2 += (v[j].x * v[j].x + v[j].y * v[j].y) + (v[j].z * v[j].z + v[j].w * v[j].w); }
    const float rstd2 = 1.0f / sqrtf(wave_sum(ss2) * (1.0f / DM) + EPS);
#pragma unroll
    for (int j = 0; j < 8; ++j) { const int col = 4 * lane + 256 * j;
        const f32x4 h = v[j] * rstd2 * S2[j] + sh2[j];
        u32x2 w; w.x = pk2(h.x, h.y); w.y = pk2(h.z, h.w);
        *(u32x2*)(H + (size_t)row * DM + col) = w; }
}
__device__ __forceinline__ void phase_mid(const Params& p) {
    const int tid = threadIdx.x, lane = tid & 63, wave = tid >> 6;
    const int gw = blockIdx.x * NWAVES + wave, NGW = gridDim.x * NWAVES;
    const float* ada = (const float*)(p.ws + WS_ADA);
    const bf16_t* Ob = (const bf16_t*)(p.ws + WS_MO); const float* Os = (const float*)(p.ws + WS_MOS);
    {
        f32x4 x[8], xn[8]; u32x2 mb[8], mbn[8];
        if (gw < MPROMPT) { const f32x4* xr = (const f32x4*)(p.in[I_XP] + (size_t)gw * DM) + lane; const u32x2* mr = (const u32x2*)(Ob + (size_t)gw * DM) + lane;
#pragma unroll
            for (int j = 0; j < 8; ++j) { x[j] = __builtin_nontemporal_load(xr + 64 * j); mb[j] = __builtin_nontemporal_load(mr + 64 * j); } }
        for (int row = gw; row < MPROMPT; row += NGW) {
            const float* ar = ada + (size_t)(row >> 11) * NADA;
            f32x4 G1[8], S2[8], sh2[8];
#pragma unroll
            for (int j = 0; j < 8; ++j) { const int col = 4 * lane + 256 * j; G1[j] = *(const f32x4*)(ar + 2 * DM + col); }
            if (row + NGW < MPROMPT) { const f32x4* xr = (const f32x4*)(p.in[I_XP] + (size_t)(row + NGW) * DM) + lane; const u32x2* mr = (const u32x2*)(Ob + (size_t)(row + NGW) * DM) + lane;
#pragma unroll
                for (int j = 0; j < 8; ++j) { xn[j] = __builtin_nontemporal_load(xr + 64 * j); mbn[j] = __builtin_nontemporal_load(mr + 64 * j); } }
#pragma unroll
            for (int j = 0; j < 8; ++j) { const int col = 4 * lane + 256 * j; S2[j] = *(const f32x4*)(ar + 4 * DM + col); sh2[j] = *(const f32x4*)(ar + 3 * DM + col); }
            f32x4 v[8];
#pragma unroll
            for (int j = 0; j < 8; ++j) v[j] = (f32x4){bflo(mb[j].x), bfhi(mb[j].x), bflo(mb[j].y), bfhi(mb[j].y)};
            mid_row(p, x, v, G1, S2, sh2, row, lane);
#pragma unroll
            for (int j = 0; j < 8; ++j) { x[j] = xn[j]; mb[j] = mbn[j]; }
        }
    }
    for (int row = MPROMPT + (gw >> 1); (gw & 1) == 0 && row < MTOK; row += (NGW >> 1)) {
        const float* ar = ada + (size_t)seq_of_row(row) * NADA;
        f32x4 v[8]; load_mo_row(v, Ob, Os, row, lane);
        f32x4 x[8], G1[8], S2[8], sh2[8]; const f32x4* xr = (const f32x4*)xrow_ptr(p, row) + lane;
#pragma unroll
        for (int j = 0; j < 8; ++j) { const int col = 4 * lane + 256 * j; x[j] = __builtin_nontemporal_load(xr + 64 * j); G1[j] = *(const f32x4*)(ar + 2 * DM + col); S2[j] = *(const f32x4*)(ar + 4 * DM + col); sh2[j] = *(const f32x4*)(ar + 3 * DM + col); }
        mid_row(p, x, v, G1, S2, sh2, row, lane);
    }
}

__device__ __forceinline__ void phase_ffnconv(const Params& p) {
    const int gt = blockIdx.x * NTHREADS + threadIdx.x, NGT = gridDim.x * NTHREADS;
    const bf16_t* UP = (const bf16_t*)(p.ws + WS_UP); bf16_t* F = (bf16_t*)(p.ws + WS_F2);
    constexpr int NCH = DFF / 8;
    const bf16_t* UPB = (const bf16_t*)(p.ws + WS_UPB);
    for (int it = gt; it < 128 * 2 * NCH; it += NGT) {
        const int c = it % NCH, q = it / NCH, sl = q & 1, blk = q >> 1, j0 = 8 * c, colg = (j0 >> 7) * 256 + (j0 & 127);
        const int row = blk * 64 + sl; const bool first = (blk & 31) == 0;
        float wg[3][8], wv[3][8], ag[8], av[8];
#pragma unroll
        for (int k = 0; k < 3; ++k) { ld8f(p.in[I_WFCONV] + (size_t)k * 2 * DFF + j0, wg[k]); ld8f(p.in[I_WFCONV] + (size_t)k * 2 * DFF + DFF + j0, wv[k]); }
        ld8f(p.in[I_BFCONV] + j0, ag); ld8f(p.in[I_BFCONV] + DFF + j0, av);
#pragma unroll
        for (int k = 0; k < 3; ++k) { const int d = k - 2 + sl;
            if (d < 0 && first) continue;
            const size_t ub = d < 0 ? (size_t)((blk - 1) * 4 + 4 + d) : (size_t)(blk * 4 + d);
            float xg[8], xv[8]; unpack8(*(const u32x4*)(UPB + ub * (2 * DFF) + colg), xg); unpack8(*(const u32x4*)(UPB + ub * (2 * DFF) + colg + 128), xv);
#pragma unroll
            for (int e = 0; e < 8; ++e) { ag[e] += xg[e] * wg[k][e]; av[e] += xv[e] * wv[k][e]; } }
        float f[8];
#pragma unroll
        for (int e = 0; e < 8; ++e) f[e] = gelu_tanh(ag[e]) * av[e];
        *(u32x4*)(F + (size_t)row * DFF + j0) = pack8(f);
    }
    if (gt < 170 * NCH) {
        const int c = gt % NCH, slot = gt / NCH, j0 = 8 * c, colg = (j0 >> 7) * 256 + (j0 & 127);
        float wg[3][8], wv[3][8], bg[8], bv[8];
#pragma unroll
        for (int k = 0; k < 3; ++k) { ld8f(p.in[I_WFCONV] + (size_t)k * 2 * DFF + j0, wg[k]); ld8f(p.in[I_WFCONV] + (size_t)k * 2 * DFF + DFF + j0, wv[k]); }
        ld8f(p.in[I_BFCONV] + j0, bg); ld8f(p.in[I_BFCONV] + DFF + j0, bv);
        for (int rs = slot; rs < 1024; rs += 170) {
            const int row = MPROMPT + rs, t = rs & 7, b = rs >> 3;
            float xg[3][8], xv[3][8];
#pragma unroll
            for (int k = 0; k < 3; ++k) { const int tt = t - 2 + k;
                if (tt >= 0) { unpack8(*(const u32x4*)(UP + (size_t)(row - 2 + k) * 2 * DFF + colg), xg[k]); unpack8(*(const u32x4*)(UP + (size_t)(row - 2 + k) * 2 * DFF + colg + 128), xv[k]); }
                else { const float* sp = p.in[I_SFCONV] + ((size_t)b * 2 + (2 + tt)) * 2 * DFF; ld8f(sp + j0, xg[k]); ld8f(sp + DFF + j0, xv[k]); } }
            float f[8];
#pragma unroll
            for (int e = 0; e < 8; ++e) { const float cg_ = bg[e] + xg[0][e] * wg[0][e] + xg[1][e] * wg[1][e] + xg[2][e] * wg[2][e];
                const float cv_ = bv[e] + xv[0][e] * wv[0][e] + xv[1][e] * wv[1][e] + xv[2][e] * wv[2][e]; f[e] = gelu_tanh(cg_) * cv_; }
            *(u32x4*)(F + (size_t)row * DFF + j0) = pack8(f);
        }
    }
    for (int i = gt; i < NSEQ * 2 * (2 * DFF / 8); i += NGT) { const int c = i % 1536, q = i / 1536, r = q & 1, s = q >> 1, n0 = 8 * c;
        const int j0 = n0 < DFF ? n0 : n0 - DFF, col = (j0 >> 7) * 256 + (n0 < DFF ? 0 : 128) + (j0 & 127);
        const int row = s < 4 ? s * SEQ + SEQ - 2 + r : MPROMPT + (s - 4) * 8 + 6 + r;
        float x[8];
        if (s < 4) unpack8(*(const u32x4*)(UPB + ((size_t)(s * 32 + 31) * 4 + 2 + r) * (2 * DFF) + col), x); else unpack8(*(const u32x4*)(UP + (size_t)row * 2 * DFF + col), x);
        float* o = p.out + (s < 4 ? O_FCONVP + ((size_t)s * 2 + r) * 2 * DFF : O_FCONVS + ((size_t)(s - 4) * 2 + r) * 2 * DFF) + n0;
        *(f32x4*)o = (f32x4){x[0], x[1], x[2], x[3]}; *(f32x4*)(o + 4) = (f32x4){x[4], x[5], x[6], x[7]}; }
}

__device__ __forceinline__ void phase_final(const Params& p) {
    const int tid = threadIdx.x, lane = tid & 63, wave = tid >> 6;
    const int gw = blockIdx.x * NWAVES + wave, NGW = gridDim.x * NWAVES;
    const float* ada = (const float*)(p.ws + WS_ADA);
    const bf16_t* Ob = (const bf16_t*)(p.ws + WS_FO); const float* Os = (const float*)(p.ws + WS_FOS2);
    {
        f32x4 x[8], xn[8]; u32x2 mb[8], mbn[8];
        if (gw < MPROMPT) { const f32x4* xr = (const f32x4*)(p.out + (size_t)gw * DM) + lane; const u32x2* mr = (const u32x2*)(Ob + (size_t)gw * DM) + lane;
#pragma unroll
            for (int j = 0; j < 8; ++j) { x[j] = __builtin_nontemporal_load(xr + 64 * j); mb[j] = __builtin_nontemporal_load(mr + 64 * j); } }
        for (int row = gw; row < MPROMPT; row += NGW) {
            const float* ar = ada + (size_t)(row >> 11) * NADA;
            f32x4 gt2[8];
#pragma unroll
            for (int j = 0; j < 8; ++j) { const int col = 4 * lane + 256 * j; gt2[j] = *(const f32x4*)(ar + 5 * DM + col); }
            if (row + NGW < MPROMPT) { const f32x4* xr = (const f32x4*)(p.out + (size_t)(row + NGW) * DM) + lane; const u32x2* mr = (const u32x2*)(Ob + (size_t)(row + NGW) * DM) + lane;
#pragma unroll
                for (int j = 0; j < 8; ++j) { xn[j] = __builtin_nontemporal_load(xr + 64 * j); mbn[j] = __builtin_nontemporal_load(mr + 64 * j); } }
            f32x4 v[8]; float ss = 0.f;
#pragma unroll
            for (int j = 0; j < 8; ++j) { v[j] = (f32x4){bflo(mb[j].x), bfhi(mb[j].x), bflo(mb[j].y), bfhi(mb[j].y)}; ss += (v[j].x * v[j].x + v[j].y * v[j].y) + (v[j].z * v[j].z + v[j].w * v[j].w); }
            const float rstd = 1.0f / sqrtf(wave_sum(ss) * (1.0f / DM) + EPS);
#pragma unroll
            for (int j = 0; j < 8; ++j) { const int col = 4 * lane + 256 * j;
                __builtin_nontemporal_store(x[j] + gt2[j] * (v[j] * rstd), (f32x4*)(p.out + (size_t)row * DM + col)); }
#pragma unroll
            for (int j = 0; j < 8; ++j) { x[j] = xn[j]; mb[j] = mbn[j]; }
        }
    }
    for (int row = MPROMPT + (gw >> 1); (gw & 1) == 0 && row < MTOK; row += (NGW >> 1)) {
        f32x4 v[8]; float ss = 0.f;
        load_mo_row(v, Ob, Os, row, lane);
#pragma unroll
        for (int j = 0; j < 8; ++j) ss += (v[j].x * v[j].x + v[j].y * v[j].y) + (v[j].z * v[j].z + v[j].w * v[j].w);
        const float rstd = 1.0f / sqrtf(wave_sum(ss) * (1.0f / DM) + EPS);
        const float* ar = ada + (size_t)seq_of_row(row) * NADA;
#pragma unroll
        for (int j = 0; j < 8; ++j) { const int col = 4 * lane + 256 * j;
            const f32x4 gt2 = *(const f32x4*)(ar + 5 * DM + col);
            float* o = p.out + (size_t)row * DM + col; const f32x4 x1 = *(const f32x4*)o;
            *(f32x4*)o = x1 + gt2 * (v[j] * rstd); }
    }
}

__global__ void __launch_bounds__(NTHREADS, 2) fwd_megakernel(Params p) {
    extern __shared__ __attribute__((aligned(16))) unsigned char lds_raw[];
    LAS unsigned char* lds = (LAS unsigned char*)lds_raw;
    cg::grid_group grid = cg::this_grid();
    unsigned char* ws = p.ws;
    if (ws == nullptr) grid.sync();
    volatile LAS unsigned* xst = (volatile LAS unsigned*)(lds + LDS_MAIN);
    if (threadIdx.x < 4) xst[threadIdx.x] = 0u;
    __syncthreads();
    const XcdBarrier xbar = xcd_barrier_post((unsigned*)(ws + WS_BAR), xst);
    const int G = gridDim.x, c = blockIdx.x;
    using namespace pg8;
    const size_t TA = 256ull * 2;

    if (PHASE_MASK & 1u) phase0<0>(p, lds);
    xcd_barrier(xbar);
    if (c < 48) {
        Sched S{(const char*)(ws + WS_SADA), (const char*)(ws + WS_WADA), TA * DM, TA * DM, 1, NADA / 256, DM / 64, G, c, 0, 0};
        EpiAda E{(float*)(ws + WS_ADA), p.in[I_BADA], p.in[I_GPRE1], p.in[I_GPOST1], p.in[I_GPRE2], p.in[I_GPOST2]};
        gemm_phase(lds, DM, DM, S, E);
        if (threadIdx.x == 0) { __builtin_amdgcn_fence(__ATOMIC_RELEASE, "agent"); asm volatile("s_waitcnt vmcnt(0)" ::: "memory");
            __hip_atomic_fetch_add((unsigned*)(ws + WS_BAR) + ADA_FLAG, 1u, __ATOMIC_RELAXED, __HIP_MEMORY_SCOPE_AGENT); }
    } else phase0<1>(p, lds);
    if (threadIdx.x == 0) { unsigned* f = (unsigned*)(ws + WS_BAR) + ADA_FLAG; unsigned sp = 0;
        while (__hip_atomic_load(f, __ATOMIC_RELAXED, __HIP_MEMORY_SCOPE_AGENT) < 48u) { __builtin_amdgcn_s_sleep(2); if (++sp > (1u << 20)) break; }
        __builtin_amdgcn_fence(__ATOMIC_ACQUIRE, "agent"); asm volatile("s_waitcnt vmcnt(0)" ::: "memory"); }
    __syncthreads();
    if (PHASE_MASK & 4u) phase_norm1(p);
    xcd_barrier(xbar);
    if (PHASE_MASK & 8u) {
        Sched S{(const char*)(ws + WS_H), (const char*)(ws + WS_WIN), TA * DM, TA * DM, MTOK / 256, INW / 256, DM / 64, G, c, 0, 0};
        EpiBf16 E{(bf16_t*)(ws + WS_Z), INW, 12};
        gemm_phase(lds, DM, DM, S, E);
    }
    xcd_barrier(xbar);
    if (PHASE_MASK & 16u) phase_mixprep(p);
    xcd_barrier(xbar);
    if (PHASE_MASK & 32u) {
        { Sched S{(const char*)(ws + WS_DP), (const char*)(ws + WS_WGRP), TA * PW, TA * 256, MTOK / 256, 4, 4, G, c, 0, 512};
          EpiPool E{(bf16_t*)(ws + WS_YP), p.in[I_PSCALE]};
          gemm_phase(lds, PW, 256, S, E); }
        { Sched S{(const char*)(ws + WS_XC), (const char*)(ws + WS_WGATE), TA * LW, TA * 256, MTOK / 256, 16, 4, G, (c + 80) & 255, 1, 512};
          EpiGates E{(const bf16_t*)(ws + WS_XC), (unsigned*)(ws + WS_LA), p.in[I_BRG], p.in[I_BIG], (const float*)(ws + WS_CTL)};
          gemm_phase(lds, LW, 256, S, E); }
    }
    xcd_barrier(xbar);
    if (PHASE_MASK & 64u) phase_scan(p, lds);
    xcd_barrier(xbar);
    if (PHASE_MASK & 128u) {
        { SchedP7 S{Sched{(const char*)(ws + WS_YP), (const char*)(ws + WS_WPU), TA * PW, TA * PW, 32, DM / 256, PW / 64, G, c, 0, 0}, 0, 1000};
          EpiMerge<false> E{(bf16_t*)(ws + WS_MG), (const bf16_t*)(ws + WS_Z), PW + LW, (unsigned*)(ws + WS_BAR)};
          gemm_phase(lds, PW, PW, S, E); }
        { SchedP7 S{Sched{(const char*)(ws + WS_YL), (const char*)(ws + WS_WLU), TA * LW, TA * LW, 32, DM / 256, LW / 64, G, c, 0, 0}, 32, 2000};
          EpiMerge<true> E{(bf16_t*)(ws + WS_MG), (const bf16_t*)(ws + WS_Z), PW + LW + DM, (unsigned*)(ws + WS_BAR)};
          gemm_phase(lds, LW, LW, S, E); }
        phase0<2>(p, lds);
    }
    xcd_barrier(xbar);
    if (PHASE_MASK & 256u) {
        SchedSplit S{Sched{(const char*)(ws + WS_MG), (const char*)(ws + WS_WOUT), TA * DM, TA * DM, 32, DM / 256, DM / 64, G, c, 0, 0}, 4, 0, 8, 0};
        EpiOut E{(bf16_t*)(ws + WS_MO), (float*)(ws + WS_MOS)};
        gemm_phase(lds, DM, DM, S, E);
    }
    xcd_barrier(xbar);
    if (PHASE_MASK & 512u) phase_mid(p);
    xcd_barrier(xbar);
    if (PHASE_MASK & 1024u) {
        Sched S{(const char*)(ws + WS_H2), (const char*)(ws + WS_WUP), TA * DM, TA * DM, MTOK / 256, 2 * DFF / 256, DM / 64, G, c, 0, 0};
        EpiUpFused E{(bf16_t*)(ws + WS_UP), (bf16_t*)(ws + WS_F2), (bf16_t*)(ws + WS_UPB), p.in[I_WFCONV], p.in[I_BFCONV]};
        gemm_phase(lds, DM, DM, S, E);
        phase0<3>(p, lds);
    }
    xcd_barrier(xbar);
    if (PHASE_MASK & 2048u) phase_ffnconv(p);
    xcd_barrier(xbar);
    if (PHASE_MASK & 4096u) {
        SchedSplit S{Sched{(const char*)(ws + WS_F2), (const char*)(ws + WS_WDOWN), TA * DFF, TA * DFF, 32, DM / 256, DFF / 64, G, c, 0, 0}, 12, 0, 8, 0};
        EpiOut E{(bf16_t*)(ws + WS_FO), (float*)(ws + WS_FOS2)};
        gemm_phase(lds, DFF, DFF, S, E);
    }
    xcd_barrier(xbar);
    if (PHASE_MASK & 8192u) phase_final(p);
}

extern "C" void kernel_launch(void* const* d_in, const int* in_sizes, int n_in, void* d_out, int out_size, void* d_ws, size_t ws_size, hipStream_t stream) {
    constexpr size_t kDynLds = LDS_MAIN + 64;
    static int grid_blocks = 0;
    if (!grid_blocks) {
        int dev = 0, cus = 0, per_cu = 0;
        (void)hipGetDevice(&dev);
        (void)hipDeviceGetAttribute(&cus, hipDeviceAttributeMultiprocessorCount, dev);
        (void)hipFuncSetAttribute((const void*)fwd_megakernel, hipFuncAttributeMaxDynamicSharedMemorySize, (int)kDynLds);
        (void)hipOccupancyMaxActiveBlocksPerMultiprocessor(&per_cu, (const void*)fwd_megakernel, NTHREADS, kDynLds);
        if (per_cu < 1) per_cu = 1;
        grid_blocks = cus;
        if (n_in != N_IN) fprintf(stderr, "kernel_launch: expected %d inputs, got %d\n", (int)N_IN, n_in);
    }
    Params p{};
    for (int i = 0; i < N_IN; ++i) p.in[i] = (const float*)d_in[i];
    p.out = (float*)d_out; p.ws = (unsigned char*)d_ws;
    (void)hipMemsetAsync((unsigned char*)d_ws + WS_BAR, 0, BAR_ZERO_WORDS * 4, stream);
    void* args[] = {&p};
    hipError_t e = hipLaunchCooperativeKernel((const void*)fwd_megakernel, dim3(grid_blocks), dim3(NTHREADS), args, kDynLds, stream);
    if (e != hipSuccess) fprintf(stderr, "cooperative launch failed: %s (grid %d)\n", hipGetErrorString(e), grid_blocks);
}
```

```cpp
#include <hip/hip_runtime.h>
#include <hip/hip_cooperative_groups.h>
#include <cstdio>
namespace cg = cooperative_groups;

#define LAS __attribute__((address_space(3)))
typedef unsigned short bf16_t;
typedef short bf16x8 __attribute__((ext_vector_type(8)));
typedef float f32x4 __attribute__((ext_vector_type(4)));
typedef float f32x2 __attribute__((ext_vector_type(2)));
typedef unsigned u32x4 __attribute__((ext_vector_type(4)));
typedef unsigned u32x2 __attribute__((ext_vector_type(2)));

#ifndef PHASE_MASK
#define PHASE_MASK 0xFFFFFFFFu
#endif

constexpr int DM = 2048, MTOK = 9216, MPROMPT = 8192, SEQ = 2048, NSEQ = 132;
constexpr int PW = 1024, LW = 2048, INW = 7168, DFF = 6144, NADA = 12288;
constexpr float EPS = 1e-6f;
constexpr int NTHREADS = 512, NWAVES = 8;

enum { I_XP = 0, I_XS, I_CP, I_CS, I_SPOOL, I_SLCONV, I_SLH, I_SFCONV, I_WADA, I_BADA, I_GPRE1, I_GPOST1, I_GPRE2, I_GPOST2,
       I_WIN, I_WGRP, I_PSCALE, I_WLCONV, I_BLCONV, I_WRG, I_BRG, I_WIG, I_BIG, I_LAM, I_WPU, I_WLU, I_WOUT, I_WUP, I_WFCONV, I_BFCONV, I_WDOWN, N_IN };

constexpr size_t O_YP = 0, O_YS = 16777216, O_POOLP = 18874368, O_LCONVP = O_POOLP + 61440, O_LHP = O_LCONVP + 24576, O_FCONVP = O_LHP + 8192,
                 O_POOLS = O_FCONVP + 98304, O_LCONVS = O_POOLS + 1966080, O_LHS = O_LCONVS + 786432, O_FCONVS = O_LHS + 262144;

constexpr size_t MiB = 1ull << 20;
constexpr size_t WS_ADA = 0, WS_CTL = 12 * MiB, WS_SADA = 13 * MiB, WS_WDOWN = 14 * MiB, WS_WUP = 38 * MiB,
                 WS_WGRP = 86 * MiB, WS_WGATE = 86 * MiB + 512 * 1024, WS_WPU = 89 * MiB, WS_WLU = 93 * MiB, WS_WOUT = 101 * MiB,
                 WS_WADA = 109 * MiB, WS_WIN = 157 * MiB, WS_H = 185 * MiB, WS_Z = 221 * MiB, WS_DP = 347 * MiB, WS_XC = 365 * MiB, WS_YP = 401 * MiB,
                 WS_LA = 109 * MiB, WS_UU = 181 * MiB, WS_YL = 347 * MiB, WS_MG = 109 * MiB, WS_MO = 221 * MiB, WS_UP = 221 * MiB, WS_F = 109 * MiB;

constexpr size_t WS_BAR = WS_CTL + 64 * 1024;
constexpr size_t WS_MOS = 253 * MiB;
constexpr size_t WS_MGS = 145 * MiB;
constexpr size_t WS_H2 = 109 * MiB;
constexpr size_t WS_UPB = 145 * MiB;
constexpr size_t WS_F2 = 221 * MiB;
constexpr size_t WS_FO = 109 * MiB;
constexpr size_t WS_FOS2 = 329 * MiB;
constexpr size_t WS_FOS = 253 * MiB;
constexpr int LDS_MAIN = 8 * 16640;
struct Params { const float* in[N_IN]; float* out; unsigned char* ws; };

__device__ __forceinline__ unsigned pk2(float lo, float hi) { unsigned r; asm("v_cvt_pk_bf16_f32 %0, %1, %2" : "=v"(r) : "v"(lo), "v"(hi)); return r; }
__device__ __forceinline__ float bflo(unsigned w) { return __uint_as_float(w << 16); }
__device__ __forceinline__ float bfhi(unsigned w) { return __uint_as_float(w & 0xffff0000u); }
__device__ __forceinline__ float bf1(bf16_t b) { return __uint_as_float(((unsigned)b) << 16); }
__device__ __forceinline__ float sigmoidf_(float x) { return __builtin_amdgcn_rcpf(1.0f + __expf(-x)); }
__device__ __forceinline__ float wave_sum(float v) {
#pragma unroll
    for (int o = 1; o < 64; o <<= 1) v += __shfl_xor(v, o);
    return v;
}
__device__ __forceinline__ int seq_of_row(int r) { return r < MPROMPT ? (r >> 11) : 4 + ((r - MPROMPT) >> 3); }
__device__ __forceinline__ void unpack8(const u32x4 w, float (&f)[8]) {
    f[0] = bflo(w.x); f[1] = bfhi(w.x); f[2] = bflo(w.y); f[3] = bfhi(w.y); f[4] = bflo(w.z); f[5] = bfhi(w.z); f[6] = bflo(w.w); f[7] = bfhi(w.w);
}
__device__ __forceinline__ u32x4 pack8(const float (&f)[8]) { u32x4 w; w.x = pk2(f[0], f[1]); w.y = pk2(f[2], f[3]); w.z = pk2(f[4], f[5]); w.w = pk2(f[6], f[7]); return w; }


#define XB_TMO      128
#define XB_XCNT(j)  (256  + 64 * (j))
#define XB_XSUB(j)  (1280 + 64 * (j))
#define XB_XGEN(j)  (2304 + 64 * (j))
#define XB_TOP      3328
#define XB_TOPGEN   3392
#define XCD_BAR_WORDS 3456
#define P7_FLAG(t) (XCD_BAR_WORDS + 64 * (t))
#define ADA_FLAG (XCD_BAR_WORDS + 64 * 32)
#define BAR_ZERO_WORDS (XCD_BAR_WORDS + 64 * 33)
#define XB_SPIN_CAP (1u << 18)
__device__ __forceinline__ unsigned xb_ld(unsigned* p)              { return __hip_atomic_load(p, __ATOMIC_RELAXED, __HIP_MEMORY_SCOPE_AGENT); }
__device__ __forceinline__ unsigned xb_add(unsigned* p, unsigned v) { return __hip_atomic_fetch_add(p, v, __ATOMIC_RELAXED, __HIP_MEMORY_SCOPE_AGENT); }
__device__ __forceinline__ unsigned xb_xcc_id() { return (unsigned)__builtin_amdgcn_s_getreg((3 << 11) | 20) & 0xFu; }
#define XB_SPIN(cond, bar) do { unsigned _sp = 0; while (cond) { __builtin_amdgcn_s_sleep(1); \
    if ((++_sp & 255u) == 0u) { if (xb_ld(&(bar)[XB_TMO])) break; if (_sp > XB_SPIN_CAP) { atomicAdd(&(bar)[XB_TMO], 1u); break; } } } } while (0)
struct XcdBarrier { unsigned* bar; unsigned x; volatile LAS unsigned* st; };
__device__ __forceinline__ XcdBarrier xcd_barrier_post(unsigned* bar, volatile LAS unsigned* st) {
    XcdBarrier b; b.bar = bar; b.x = xb_xcc_id(); b.st = st;
    if (threadIdx.x == 0) (void)xb_add(&bar[XB_XCNT(b.x)], 1u);
    return b;
}
__device__ __forceinline__ void xcd_barrier_complete(unsigned* bar, unsigned x, unsigned& nloc, unsigned& nx) {
    const unsigned G = gridDim.x * gridDim.y * gridDim.z;
    unsigned sum, cnt, mine, sp = 0u;
    for (;;) {
        sum = 0u; cnt = 0u; mine = 0u;
#pragma unroll
        for (unsigned j = 0; j < 16; ++j) { const unsigned c = xb_ld(&bar[XB_XCNT(j)]); sum += c; cnt += (c > 0u) ? 1u : 0u; mine = (j == x) ? c : mine; }
        if (sum == G) break;
        __builtin_amdgcn_s_sleep(1);
        if ((++sp & 255u) == 0u) { if (xb_ld(&bar[XB_TMO])) break; if (sp > XB_SPIN_CAP) { atomicAdd(&bar[XB_TMO], 1u); break; } }
    }
    nloc = mine > 0u ? mine : 1u; nx = cnt > 0u ? cnt : 1u;
}
__device__ __forceinline__ void xcd_barrier(const XcdBarrier& b) {
    asm volatile("s_waitcnt vmcnt(0)" ::: "memory");
    __syncthreads();
    if (threadIdx.x == 0) {
        unsigned* bar = b.bar;
        __builtin_amdgcn_s_waitcnt(0);
        unsigned nloc = b.st[0], nx = b.st[1];
        if (nloc == 0u) { xcd_barrier_complete(bar, b.x, nloc, nx); b.st[0] = nloc; b.st[1] = nx; }
        const unsigned old = xb_add(&bar[XB_XSUB(b.x)], 1u);
        const unsigned gen = old / nloc;
        if (old + 1u == (gen + 1u) * nloc) {
            __builtin_amdgcn_fence(__ATOMIC_RELEASE, "agent");
            asm volatile("s_waitcnt vmcnt(0)" ::: "memory");
            const unsigned og = xb_add(&bar[XB_TOP], 1u);
            const unsigned tg = og / nx;
            if (og + 1u == (tg + 1u) * nx) xb_add(&bar[XB_TOPGEN], 1u);
            else XB_SPIN(xb_ld(&bar[XB_TOPGEN]) == tg, bar);
            __builtin_amdgcn_fence(__ATOMIC_ACQUIRE, "agent");
            xb_add(&bar[XB_XGEN(b.x)], 1u);
            asm volatile("s_waitcnt vmcnt(0)" ::: "memory");
        } else {
            XB_SPIN(xb_ld(&bar[XB_XGEN(b.x)]) == gen, bar);
            __builtin_amdgcn_fence(__ATOMIC_ACQUIRE, "agent");
            asm volatile("s_waitcnt vmcnt(0)" ::: "memory");
        }
    }
    __syncthreads();
}

__device__ __forceinline__ void ld8f(const float* p, float (&x)[8]);
__device__ __forceinline__ float gelu_tanh(float x) { const float y = 1.5957691216f * (x + 0.044715f * x * x * x); return x * __builtin_amdgcn_rcpf(1.0f + __expf(-y)); }
namespace pg8 {
constexpr int BM = 256, BK = 64, HALF = 128, HTB = HALF * BK * 2, STAGE_BYTES = 8 * HTB;
__device__ __forceinline__ int lds_byte(int r, int c) { const int st = (r >> 4) * 2 + (c >> 5), rr = r & 15, cc = c & 31, ob = rr * 64 + cc * 2; return st * 1024 + (ob ^ (((ob >> 9) & 1) << 5)); }
__device__ __forceinline__ void stage_rc(int b, int& R, int& C) { const int st = b / 1024, sb = b % 1024, swz = sb ^ (((sb >> 9) & 1) << 5); R = (st >> 1) * 16 + swz / 64; C = (st & 1) * 32 + (swz % 64) / 2; }
__device__ __forceinline__ int perm32(int rho) { const int n = rho >> 4, i = rho & 15; return 8 * (i >> 2) + 4 * n + (i & 3); }

struct Unit { const char* A; const char* B; int nt, pm, pn, tag; };

struct Sched {
    const char* A; const char* B; size_t a_tile, b_tile; int nM, nN, nt, G, c, a_sh, a_mul;
    __device__ __forceinline__ bool next(int i, Unit& u) const {
        const long L = (long)i * G + c; const int nwg = nM * nN; if (L >= nwg) return false;
        int wgid = (int)L; { const int q = nwg / 8, r = nwg % 8, xcd = wgid % 8, off = wgid / 8; wgid = (xcd < r ? xcd * (q + 1) : r * (q + 1) + (xcd - r) * q) + off; }
        const int nig = 8 * nN, gid = wgid / nig, fm = gid * 8, gsz = (nM - fm) < 8 ? (nM - fm) : 8;
        u.pm = fm + ((wgid % nig) % gsz); u.pn = (wgid % nig) / gsz; u.tag = 0;
        u.A = A + (size_t)u.pm * a_tile + (size_t)((u.pn >> a_sh) * a_mul); u.B = B + (size_t)u.pn * b_tile; u.nt = nt; return true;
    }
};

template <class Epi, class S_t>
__device__ __forceinline__ void gemm_phase(LAS unsigned char* lds, int lda, int ldb, const S_t& S, const Epi& E) {
    int tid = threadIdx.x; asm volatile("" : "+v"(tid));
    const int wid = __builtin_amdgcn_readfirstlane(tid >> 6), lane = tid & 63, wr = wid >> 2, wc = wid & 3, fr = lane & 15, fq = lane >> 4;
    unsigned voffA[2], voffB[2];
#pragma unroll
    for (int i = 0; i < 2; ++i) { int R, C; stage_rc(tid * 16 + i * 8192, R, C); const int Rb = Epi::PERM ? ((R & ~31) + perm32(R & 31)) : R;
        voffA[i] = (unsigned)(R * lda + C) * 2u; voffB[i] = (unsigned)(Rb * ldb + C) * 2u; }
    const size_t kstep = (size_t)(BK * 2);
    const size_t hstepA = (size_t)HALF * lda * 2, hstepB = (size_t)HALF * ldb * 2;
    const unsigned ldsw = (unsigned)wid * 1024u;
    const int aoff = lds_byte(wr * 64 + fr, fq * 8), boff = lds_byte(wc * 32 + fr, fq * 8);
#define PG8_SA(b, h) (((b) * 2 + (h)) * HTB)
#define PG8_SB(b, h) ((4 + (b) * 2 + (h)) * HTB)
#define PG8_STAGE(bufoff, gbase, voff) do { _Pragma("unroll") for (int _i = 0; _i < 2; ++_i) \
        __builtin_amdgcn_global_load_lds((const unsigned*)((const char*)(gbase) + (voff)[_i]), (LAS unsigned*)(lds + (bufoff) + ldsw + _i * 8192), 16, 0, 0); } while (0)
#define PG8_LDA(dst, b, h) do { _Pragma("unroll") for (int m = 0; m < 4; ++m) _Pragma("unroll") for (int k = 0; k < 2; ++k) dst[m][k] = *(const LAS bf16x8*)(lds + PG8_SA(b, h) + aoff + m * 2048 + k * 1024); } while (0)
#define PG8_LDB(dst, b, h) do { _Pragma("unroll") for (int n = 0; n < 2; ++n) _Pragma("unroll") for (int k = 0; k < 2; ++k) dst[n][k] = *(const LAS bf16x8*)(lds + PG8_SB(b, h) + boff + n * 2048 + k * 1024); } while (0)
#define PG8_MMA(ai, bj, At, Bt) do { __builtin_amdgcn_s_setprio(1); _Pragma("unroll") for (int m = 0; m < 4; ++m) _Pragma("unroll") for (int n = 0; n < 2; ++n) _Pragma("unroll") for (int k = 0; k < 2; ++k) \
        acc[ai][bj][m][n] = __builtin_amdgcn_mfma_f32_16x16x32_bf16(Bt[n][k], At[m][k], acc[ai][bj][m][n], 0, 0, 0); __builtin_amdgcn_s_setprio(0); } while (0)
#define PG8_WAIT_V(n) asm volatile("s_waitcnt vmcnt(" #n ")" ::: "memory")
#define PG8_WAIT_L(n) asm volatile("s_waitcnt lgkmcnt(" #n ")" ::: "memory")
#define PG8_BAR __builtin_amdgcn_s_barrier()
#define PG8_SCHED __builtin_amdgcn_sched_barrier(0)
    Unit cur, nxt; int ui = 0;
    if (!S.next(0, cur)) return;
    f32x4 acc[2][2][4][2];
#pragma unroll
    for (int a = 0; a < 2; ++a)
#pragma unroll
        for (int b = 0; b < 2; ++b)
#pragma unroll
            for (int m = 0; m < 4; ++m)
#pragma unroll
                for (int n = 0; n < 2; ++n) acc[a][b][m][n] = (f32x4){0.f, 0.f, 0.f, 0.f};
    bf16x8 At[4][2], B0[2][2], B1[2][2];
    const char* cA = cur.A; const char* cB = cur.B;
    PG8_STAGE(PG8_SB(0, 0), cB, voffB); PG8_STAGE(PG8_SA(0, 0), cA, voffA); PG8_STAGE(PG8_SB(0, 1), cB + hstepB, voffB); PG8_STAGE(PG8_SA(0, 1), cA + hstepA, voffA);
    if (wr == 1) PG8_BAR;
    PG8_WAIT_V(4); PG8_BAR;
    PG8_STAGE(PG8_SB(1, 0), cB + kstep, voffB); PG8_STAGE(PG8_SA(1, 0), cA + kstep, voffA); PG8_STAGE(PG8_SB(1, 1), cB + hstepB + kstep, voffB);
    PG8_WAIT_V(6); PG8_BAR;
    for (;;) {
        const bool has_next = S.next(ui + 1, nxt);
        const char* nA = has_next ? nxt.A : cA; const char* nB = has_next ? nxt.B : cB;
        const int nt = cur.nt;
        for (int t = 0; t < nt; t += 2) {
            const bool last = (t == nt - 2);
            const char* a1 = cA + (size_t)(t + 1) * kstep;
            const char* a2 = last ? nA : cA + (size_t)(t + 2) * kstep; const char* b2 = last ? nB : cB + (size_t)(t + 2) * kstep;
            const char* a3 = a2 + kstep; const char* b3 = b2 + kstep;
            PG8_LDB(B0, 0, 0); PG8_SCHED; PG8_LDA(At, 0, 0); PG8_STAGE(PG8_SA(1, 1), a1 + hstepA, voffA);
            PG8_WAIT_L(8); PG8_BAR; PG8_WAIT_L(0); PG8_MMA(0, 0, At, B0); PG8_BAR; PG8_SCHED;
            PG8_LDB(B1, 0, 1); PG8_STAGE(PG8_SB(0, 0), b2, voffB);
            PG8_BAR; PG8_WAIT_L(0); PG8_MMA(0, 1, At, B1); PG8_BAR;
            PG8_LDA(At, 0, 1); PG8_STAGE(PG8_SA(0, 0), a2, voffA);
            PG8_BAR; PG8_WAIT_L(0); PG8_MMA(1, 0, At, B0); PG8_BAR; PG8_SCHED;
            PG8_STAGE(PG8_SB(0, 1), b2 + hstepB, voffB);
            PG8_WAIT_V(6); PG8_BAR; PG8_MMA(1, 1, At, B1); PG8_BAR;
            PG8_LDB(B0, 1, 0); PG8_SCHED; PG8_LDA(At, 1, 0); PG8_STAGE(PG8_SA(0, 1), a2 + hstepA, voffA);
            PG8_WAIT_L(8); PG8_BAR; PG8_WAIT_L(0); PG8_MMA(0, 0, At, B0); PG8_BAR; PG8_SCHED;
            PG8_LDB(B1, 1, 1); PG8_STAGE(PG8_SB(1, 0), b3, voffB);
            PG8_BAR; PG8_WAIT_L(0); PG8_MMA(0, 1, At, B1); PG8_BAR;
            PG8_LDA(At, 1, 1); PG8_STAGE(PG8_SA(1, 0), a3, voffA);
            PG8_BAR; PG8_WAIT_L(0); PG8_MMA(1, 0, At, B0); PG8_BAR; PG8_SCHED;
            PG8_STAGE(PG8_SB(1, 1), b3 + hstepB, voffB);
            PG8_WAIT_V(6); PG8_BAR; PG8_MMA(1, 1, At, B1); PG8_BAR;
        }
        E(acc, cur, wr, wc, fr, fq);
        if (!has_next) break;
#pragma unroll
        for (int a = 0; a < 2; ++a)
#pragma unroll
            for (int b = 0; b < 2; ++b)
#pragma unroll
                for (int m = 0; m < 4; ++m)
#pragma unroll
                    for (int n = 0; n < 2; ++n) acc[a][b][m][n] = (f32x4){0.f, 0.f, 0.f, 0.f};
        cur = nxt; cA = nA; cB = nB; ++ui;
    }
    PG8_WAIT_V(0);
    if (wr == 0) PG8_BAR;
    PG8_BAR;
#undef PG8_SA
#undef PG8_SB
#undef PG8_STAGE
#undef PG8_LDA
#undef PG8_LDB
#undef PG8_MMA
#undef PG8_WAIT_V
#undef PG8_WAIT_L
#undef PG8_BAR
#undef PG8_SCHED
}

struct EpiF32 {
    static constexpr bool PERM = false;
    float* C; int ldc; const float* bias;
    __device__ __forceinline__ void operator()(const f32x4 (&acc)[2][2][4][2], const Unit& u, int wr, int wc, int fr, int fq) const {
        const int row0 = u.pm * BM + wr * 64 + fr, col0 = u.pn * BM + wc * 32 + 4 * fq;
        f32x4 bv[2][2];
#pragma unroll
        for (int bj = 0; bj < 2; ++bj)
#pragma unroll
            for (int n = 0; n < 2; ++n) bv[bj][n] = bias ? *(const f32x4*)(bias + col0 + bj * HALF + n * 16) : (f32x4){0.f, 0.f, 0.f, 0.f};
#pragma unroll
        for (int ai = 0; ai < 2; ++ai)
#pragma unroll
            for (int m = 0; m < 4; ++m) { float* rowp = C + (size_t)(row0 + ai * HALF + m * 16) * ldc + col0;
#pragma unroll
                for (int bj = 0; bj < 2; ++bj)
#pragma unroll
                    for (int n = 0; n < 2; ++n) *(f32x4*)(rowp + bj * HALF + n * 16) = acc[ai][bj][m][n] + bv[bj][n]; }
    }
};
struct EpiAda {
    static constexpr bool PERM = false;
    float* C; const float* bias; const float* g1; const float* g2; const float* g4; const float* g5;
    __device__ __forceinline__ void operator()(const f32x4 (&acc)[2][2][4][2], const Unit& u, int wr, int wc, int fr, int fq) const {
        const int row0 = wr * 64 + fr, col0 = u.pn * BM + wc * 32 + 4 * fq, kind = u.pn >> 3;
        const float* gm = kind == 2 ? g2 : kind == 4 ? g4 : kind == 5 ? g5 : g1;
        const float one = (kind == 1 || kind == 4) ? 1.0f : 0.0f, gs = (kind == 0 || kind == 3) ? 0.0f : 1.0f;
#pragma unroll
        for (int bj = 0; bj < 2; ++bj)
#pragma unroll
            for (int n = 0; n < 2; ++n) { const int col = col0 + bj * HALF + n * 16;
                const f32x4 bv = *(const f32x4*)(bias + col) + one, gv = *(const f32x4*)(gm + (col & (DM - 1))) * gs + (1.0f - gs);
#pragma unroll
                for (int ai = 0; ai < 2; ++ai)
#pragma unroll
                    for (int m = 0; m < 4; ++m) *(f32x4*)(C + (size_t)(row0 + ai * HALF + m * 16) * NADA + col) = (acc[ai][bj][m][n] + bv) * gv; }
    }
};
struct EpiBf16 {
    static constexpr bool PERM = true;
    bf16_t* O; int ldc; int sig_pn;
    __device__ __forceinline__ void operator()(const f32x4 (&acc)[2][2][4][2], const Unit& u, int wr, int wc, int fr, int fq) const {
        const int row0 = u.pm * BM + wr * 64 + fr, col0 = u.pn * BM + wc * 32 + 8 * fq;
        const bool sg = u.pn >= sig_pn;
#pragma unroll
        for (int ai = 0; ai < 2; ++ai)
#pragma unroll
            for (int m = 0; m < 4; ++m) { bf16_t* rowp = O + (size_t)(row0 + ai * HALF + m * 16) * ldc + col0;
#pragma unroll
                for (int bj = 0; bj < 2; ++bj) { f32x4 v0 = acc[ai][bj][m][0], v1 = acc[ai][bj][m][1];
                    if (sg) {
#pragma unroll
                        for (int j = 0; j < 4; ++j) { v0[j] = sigmoidf_(v0[j]); v1[j] = sigmoidf_(v1[j]); } }
                    u32x4 w; w.x = pk2(v0[0], v0[1]); w.y = pk2(v0[2], v0[3]); w.z = pk2(v1[0], v1[1]); w.w = pk2(v1[2], v1[3]);
                    *(u32x4*)(rowp + bj * HALF) = w; } }
    }
};
struct EpiPool {
    static constexpr bool PERM = true;
    bf16_t* O; const float* scale;
    __device__ __forceinline__ void operator()(const f32x4 (&acc)[2][2][4][2], const Unit& u, int wr, int wc, int fr, int fq) const {
        const int row0 = u.pm * BM + wr * 64 + fr, col0 = u.pn * BM + wc * 32 + 8 * fq;
        f32x4 sv[2][2];
#pragma unroll
        for (int bj = 0; bj < 2; ++bj)
#pragma unroll
            for (int n = 0; n < 2; ++n) sv[bj][n] = *(const f32x4*)(scale + col0 + bj * HALF + 4 * n);
#pragma unroll
        for (int ai = 0; ai < 2; ++ai)
#pragma unroll
            for (int m = 0; m < 4; ++m) { bf16_t* rowp = O + (size_t)(row0 + ai * HALF + m * 16) * PW + col0;
#pragma unroll
                for (int bj = 0; bj < 2; ++bj) { const f32x4 v0 = acc[ai][bj][m][0] * sv[bj][0], v1 = acc[ai][bj][m][1] * sv[bj][1];
                    u32x4 w; w.x = pk2(v0[0], v0[1]); w.y = pk2(v0[2], v0[3]); w.z = pk2(v1[0], v1[1]); w.w = pk2(v1[2], v1[3]);
                    *(u32x4*)(rowp + bj * HALF) = w; } }
    }
};
struct EpiGates {
    static constexpr bool PERM = true;
    const bf16_t* XC; unsigned* LU; const float* brg; const float* big; const float* spl;
    __device__ __forceinline__ void operator()(const f32x4 (&acc)[2][2][4][2], const Unit& u, int wr, int wc, int fr, int fq) const {
        const int row0 = u.pm * BM + wr * 64 + fr, ch0 = u.pn * HALF + wc * 32 + 8 * fq;
        float br[8], bi[8], sp[8];
#pragma unroll
        for (int q = 0; q < 2; ++q) { const f32x4 a = *(const f32x4*)(brg + ch0 + 4 * q), b = *(const f32x4*)(big + ch0 + 4 * q), c = *(const f32x4*)(spl + ch0 + 4 * q);
#pragma unroll
            for (int j = 0; j < 4; ++j) { br[4 * q + j] = a[j]; bi[4 * q + j] = b[j]; sp[4 * q + j] = c[j]; } }
        u32x4 xraw[2][4];
#pragma unroll
        for (int ai = 0; ai < 2; ++ai)
#pragma unroll
            for (int m = 0; m < 4; ++m) xraw[ai][m] = *(const u32x4*)(XC + (size_t)(row0 + ai * HALF + m * 16) * LW + ch0);
        asm volatile("" ::: "memory");
#pragma unroll
        for (int ai = 0; ai < 2; ++ai)
#pragma unroll
            for (int m = 0; m < 4; ++m) { const size_t off = (size_t)(row0 + ai * HALF + m * 16) * LW + ch0;
                float xc[8]; unpack8(xraw[ai][m], xc);
                float la[8], uu[8];
#pragma unroll
                for (int n = 0; n < 2; ++n)
#pragma unroll
                    for (int j = 0; j < 4; ++j) { const int e = 4 * n + j;
                        const float r = sigmoidf_(acc[ai][0][m][n][j] + br[e]), ig = sigmoidf_(acc[ai][1][m][n][j] + bi[e]);
                        const float l = -8.0f * r * sp[e]; la[e] = l;
                        const float x2 = 2.0f * l;
                        const float om = x2 > -0.03125f ? -x2 * (1.0f + x2 * (0.5f + x2 * (0.16666667f + x2 * 0.041666668f))) : 1.0f - __expf(x2);
                        uu[e] = __builtin_amdgcn_sqrtf(om) * (ig * xc[e]); }
                u32x4 w0, w1; w0.x = pk2(la[0], uu[0]); w0.y = pk2(la[1], uu[1]); w0.z = pk2(la[2], uu[2]); w0.w = pk2(la[3], uu[3]);
                w1.x = pk2(la[4], uu[4]); w1.y = pk2(la[5], uu[5]); w1.z = pk2(la[6], uu[6]); w1.w = pk2(la[7], uu[7]);
                *(u32x4*)(LU + off) = w0; *(u32x4*)(LU + off + 4) = w1; }
    }
};
template <bool ADD> struct EpiMerge {
    static constexpr bool PERM = true;
    bf16_t* MG; const bf16_t* Z; int gcol0; unsigned* flags;
    __device__ __forceinline__ void operator()(const f32x4 (&acc)[2][2][4][2], const Unit& u, int wr, int wc, int fr, int fq) const {
        const int row0 = u.pm * BM + wr * 64 + fr, col0 = u.pn * BM + wc * 32 + 8 * fq;
        if (ADD && u.tag >= 2000) {
            unsigned* f = flags + P7_FLAG(u.tag - 2000); unsigned sp = 0;
            while ((unsigned)__builtin_amdgcn_readfirstlane(__hip_atomic_load(f, __ATOMIC_RELAXED, __HIP_MEMORY_SCOPE_AGENT)) < 8u) { __builtin_amdgcn_s_sleep(2); if (++sp > (1u << 20)) break; }
            __builtin_amdgcn_fence(__ATOMIC_ACQUIRE, "agent");
            asm volatile("s_waitcnt vmcnt(0)" ::: "memory");
        }
#pragma unroll
        for (int ai = 0; ai < 2; ++ai) {
            u32x4 gr[4][2], orw[4][2];
            asm volatile("" ::: "memory");
#pragma unroll
            for (int m = 0; m < 4; ++m)
#pragma unroll
                for (int bj = 0; bj < 2; ++bj) { const int row = row0 + ai * HALF + m * 16, col = col0 + bj * HALF;
                    gr[m][bj] = *(const u32x4*)(Z + (size_t)row * INW + gcol0 + col);
                    if (ADD) orw[m][bj] = *(const u32x4*)(MG + (size_t)row * DM + col); }
            asm volatile("" ::: "memory");
#pragma unroll
            for (int m = 0; m < 4; ++m)
#pragma unroll
                for (int bj = 0; bj < 2; ++bj) { const int row = row0 + ai * HALF + m * 16, col = col0 + bj * HALF;
                    float g[8], o[8]; unpack8(gr[m][bj], g);
                    if (ADD) unpack8(orw[m][bj], o);
#pragma unroll
                    for (int n = 0; n < 2; ++n)
#pragma unroll
                        for (int j = 0; j < 4; ++j) { const int e = 4 * n + j; o[e] = ADD ? o[e] + g[e] * acc[ai][bj][m][n][j] : g[e] * acc[ai][bj][m][n][j]; }
                    *(u32x4*)(MG + (size_t)row * DM + col) = pack8(o); }
        }
        if (!ADD && u.tag >= 1000) {
            asm volatile("s_waitcnt vmcnt(0)" ::: "memory");
            __builtin_amdgcn_fence(__ATOMIC_RELEASE, "agent");
            asm volatile("s_waitcnt vmcnt(0)" ::: "memory");
            if ((threadIdx.x & 63) == 0) __hip_atomic_fetch_add(flags + P7_FLAG(u.tag - 1000), 1u, __ATOMIC_RELAXED, __HIP_MEMORY_SCOPE_AGENT);
        }
    }
};
struct SchedSplit {
    Sched base; int ntp, kz_lo, kz_hi, mode;
    __device__ __forceinline__ bool next(int i, Unit& u) const {
        if (i == 0) return base.next(0, u);
        if (i > 1) return false;
        const int tile = base.c >> 3, kz = base.c & 7;
        if (kz < kz_lo || kz >= kz_hi) return false;
        const int k = kz - kz_lo; int koff, nt;
        if (mode == 0) { koff = k * ntp; nt = ntp; } else { koff = k < 4 ? 6 * k : 24 + 4 * (k - 4); nt = k < 4 ? 6 : 4; }
        u.pm = 32 + (tile >> 3); u.pn = tile & 7; u.tag = 1 + kz; u.nt = nt;
        u.A = base.A + (size_t)u.pm * base.a_tile + (size_t)koff * 128; u.B = base.B + (size_t)u.pn * base.b_tile + (size_t)koff * 128; return true;
    }
};
struct SchedP7 {
    Sched base; int lo, tg;
    __device__ __forceinline__ bool next(int i, Unit& u) const {
        if (i == 0) return base.next(0, u);
        const int t = base.c - lo;
        if (i > 1 || t < 0 || t >= 32) return false;
        u.pm = 32 + (t >> 3); u.pn = t & 7; u.tag = tg + t; u.nt = base.nt;
        u.A = base.A + (size_t)u.pm * base.a_tile; u.B = base.B + (size_t)u.pn * base.b_tile; return true;
    }
};
struct EpiOut {
    static constexpr bool PERM = true;
    bf16_t* Ob; float* Os;
    __device__ __forceinline__ void operator()(const f32x4 (&acc)[2][2][4][2], const Unit& u, int wr, int wc, int fr, int fq) const {
        const int col0 = u.pn * BM + wc * 32 + 8 * fq;
        if (u.tag == 0) {
            const int row0 = u.pm * BM + wr * 64 + fr;
#pragma unroll
            for (int ai = 0; ai < 2; ++ai)
#pragma unroll
                for (int m = 0; m < 4; ++m) { bf16_t* rowp = Ob + (size_t)(row0 + ai * HALF + m * 16) * DM + col0;
#pragma unroll
                    for (int bj = 0; bj < 2; ++bj) { const f32x4 v0 = acc[ai][bj][m][0], v1 = acc[ai][bj][m][1];
                        u32x4 w; w.x = pk2(v0[0], v0[1]); w.y = pk2(v0[2], v0[3]); w.z = pk2(v1[0], v1[1]); w.w = pk2(v1[2], v1[3]);
                        *(u32x4*)(rowp + bj * HALF) = w; } }
        } else {
            const int row0 = (u.pm - 32) * BM + wr * 64 + fr;
            float* Op = Os + (size_t)(u.tag - 1) * (1024ull * DM);
#pragma unroll
            for (int ai = 0; ai < 2; ++ai)
#pragma unroll
                for (int m = 0; m < 4; ++m) { float* rowp = Op + (size_t)(row0 + ai * HALF + m * 16) * DM + col0;
#pragma unroll
                    for (int bj = 0; bj < 2; ++bj)
#pragma unroll
                        for (int n = 0; n < 2; ++n) *(f32x4*)(rowp + bj * HALF + 4 * n) = acc[ai][bj][m][n]; }
        }
    }
};
__device__ __forceinline__ float dpp_shr1(float old, float src) { return __int_as_float(__builtin_amdgcn_update_dpp(__float_as_int(old), __float_as_int(src), 0x111, 0xf, 0xf, false)); }
__device__ __forceinline__ float dpp_shr2(float old, float src) { return __int_as_float(__builtin_amdgcn_update_dpp(__float_as_int(old), __float_as_int(src), 0x112, 0xf, 0xf, false)); }
__device__ __forceinline__ float dpp_ror1(float src) { return __int_as_float(__builtin_amdgcn_update_dpp(0, __float_as_int(src), 0x121, 0xf, 0xf, false)); }
__device__ __forceinline__ float dpp_ror2(float src) { return __int_as_float(__builtin_amdgcn_update_dpp(0, __float_as_int(src), 0x122, 0xf, 0xf, false)); }
struct EpiUpFused {
    static constexpr bool PERM = true;
    bf16_t* UP; bf16_t* F; bf16_t* UPB; const float* wconv; const float* bconv;
    __device__ __forceinline__ void operator()(const f32x4 (&acc)[2][2][4][2], const Unit& u, int wr, int wc, int fr, int fq) const {
        const int row0 = u.pm * BM + wr * 64 + fr, col0 = u.pn * BM + wc * 32 + 8 * fq;
        if (u.pm >= 32) {
#pragma unroll
            for (int ai = 0; ai < 2; ++ai)
#pragma unroll
                for (int m = 0; m < 4; ++m) { bf16_t* rowp = UP + (size_t)(row0 + ai * HALF + m * 16) * (2 * DFF) + col0;
#pragma unroll
                    for (int bj = 0; bj < 2; ++bj) { const f32x4 v0 = acc[ai][bj][m][0], v1 = acc[ai][bj][m][1];
                        u32x4 w; w.x = pk2(v0[0], v0[1]); w.y = pk2(v0[2], v0[3]); w.z = pk2(v1[0], v1[1]); w.w = pk2(v1[2], v1[3]);
                        *(u32x4*)(rowp + bj * HALF) = w; } }
            return;
        }
        const int j0 = u.pn * HALF + wc * 32 + 8 * fq;
        u32x2 res0[8];
#pragma unroll
        for (int n = 0; n < 2; ++n) {
            asm volatile("" ::: "memory");
            const int jc = j0 + 4 * n;
            const f32x4 wg0 = *(const f32x4*)(wconv + jc), wg1 = *(const f32x4*)(wconv + 2 * DFF + jc), wg2 = *(const f32x4*)(wconv + 4 * DFF + jc), bg = *(const f32x4*)(bconv + jc);
            const f32x4 wv0 = *(const f32x4*)(wconv + DFF + jc), wv1 = *(const f32x4*)(wconv + 3 * DFF + jc), wv2 = *(const f32x4*)(wconv + 5 * DFF + jc), bv = *(const f32x4*)(bconv + DFF + jc);
#pragma unroll
            for (int ai = 0; ai < 2; ++ai)
#pragma unroll
                for (int m = 0; m < 4; ++m) { const int row = row0 + ai * HALF + m * 16;
                    const f32x4 g0 = acc[ai][0][m][n], v0 = acc[ai][1][m][n];
                    f32x4 gp = (f32x4){0.f, 0.f, 0.f, 0.f}, vp = gp;
                    if (m > 0) { gp = acc[ai][0][m > 0 ? m - 1 : 0][n]; vp = acc[ai][1][m > 0 ? m - 1 : 0][n]; }
                    f32x4 f;
#pragma unroll
                    for (int j = 0; j < 4; ++j) {
                        const float g1 = dpp_shr1(dpp_ror1(gp[j]), g0[j]), g2 = dpp_shr2(dpp_ror2(gp[j]), g0[j]);
                        const float v1 = dpp_shr1(dpp_ror1(vp[j]), v0[j]), v2 = dpp_shr2(dpp_ror2(vp[j]), v0[j]);
                        const float cg_ = bg[j] + g2 * wg0[j] + g1 * wg1[j] + g0[j] * wg2[j];
                        const float cv_ = bv[j] + v2 * wv0[j] + v1 * wv1[j] + v0[j] * wv2[j];
                        f[j] = gelu_tanh(cg_) * cv_; }
                    u32x2 w; w.x = pk2(f[0], f[1]); w.y = pk2(f[2], f[3]);
                    if (n == 0) res0[ai * 4 + m] = w;
                    else if (m > 0 || fr >= 2) { u32x4 w4; w4.x = res0[ai * 4 + m].x; w4.y = res0[ai * 4 + m].y; w4.z = w.x; w4.w = w.y; *(u32x4*)(F + (size_t)row * DFF + j0) = w4; }
                    if (n == 1 && ((m == 0 && fr < 2) || (m == 3 && fr >= 14))) { const int slot = m == 0 ? fr : fr - 12;
                        const f32x4 ga = acc[ai][0][m][0], va = acc[ai][1][m][0];
                        bf16_t* bp = UPB + ((size_t)(row >> 6) * 4 + slot) * (2 * DFF) + col0;
                        u32x4 wg_, wv_; wg_.x = pk2(ga[0], ga[1]); wg_.y = pk2(ga[2], ga[3]); wg_.z = pk2(g0[0], g0[1]); wg_.w = pk2(g0[2], g0[3]);
                        wv_.x = pk2(va[0], va[1]); wv_.y = pk2(va[2], va[3]); wv_.z = pk2(v0[0], v0[1]); wv_.w = pk2(v0[2], v0[3]);
                        *(u32x4*)bp = wg_; *(u32x4*)(bp + HALF) = wv_; } }
        }
    }
};
}

__device__ __forceinline__ void cvt_item(const float* __restrict__ W, int N, bf16_t* WT, int K, int k0, int n0, int drow0, LAS float* scr, int lane) {
    float v[64];
#pragma unroll
    for (int kk = 0; kk < 64; ++kk) v[kk] = __builtin_nontemporal_load(W + (size_t)(k0 + kk) * N + n0 + lane);
#pragma unroll
    for (int kk = 0; kk < 64; ++kk) scr[kk * 65 + lane] = v[kk];
    asm volatile("s_waitcnt lgkmcnt(0)" ::: "memory");
    const int c = lane & 7;
#pragma unroll
    for (int j = 0; j < 8; ++j) { const int n = (lane >> 3) + 8 * j; const LAS float* s = scr + (8 * c) * 65 + n;
        u32x4 o; o.x = pk2(s[0 * 65], s[1 * 65]); o.y = pk2(s[2 * 65], s[3 * 65]); o.z = pk2(s[4 * 65], s[5 * 65]); o.w = pk2(s[6 * 65], s[7 * 65]);
        *(u32x4*)(WT + (size_t)(drow0 + n) * K + k0 + 8 * c) = o; }
    asm volatile("s_waitcnt lgkmcnt(0)" ::: "memory");
}

template <int PART> __device__ __forceinline__ void phase0(const Params& p, LAS unsigned char* lds) {
    constexpr int SKIP = PART == 0 ? 0 : PART == 1 ? 48 : 192;
    const int tid = threadIdx.x, lane = tid & 63, wave = tid >> 6;
    const int gw = ((int)blockIdx.x - SKIP) * NWAVES + wave, NGW = ((int)gridDim.x - SKIP) * NWAVES;
    if (gw < 0) return;
    const int gt = blockIdx.x * NTHREADS + tid, NGT = gridDim.x * NTHREADS;
    unsigned char* ws = p.ws;
    LAS float* scr = (LAS float*)(lds + wave * 16640);
    constexpr int I0 = 32 * 192, I1 = 32 * 112, I2 = 32 * 192, I3 = 96 * 32, I4 = 32 * 32, I5 = 32 * 32, I6 = 16 * 32, I7 = 64, I8 = 128, I9 = 128;
    constexpr int NIT = I0 + I1 + I2 + I3 + I4 + I5 + I6 + I7 + I8 + I9;
    constexpr int U0 = I0 + I1, U1 = U0 + I2 / 2, D0 = I0 + I1 + I2, D1 = D0 + I3;
    constexpr int CUT = (U1 - U0) + I3;
    constexpr int LO = PART == 0 ? 0 : PART == 1 ? I0 : PART == 2 ? U0 : D0, HI = PART == 0 ? I0 : PART == 1 ? NIT - CUT : PART == 2 ? U1 : D1;
    for (int it0 = LO + gw; it0 < HI; it0 += NGW) {
        int it = it0;
        if (PART == 1) { if (it >= U0) it += U1 - U0; if (it >= D0) it += I3; }
        int r = it;
        if (r < I0) { const int nb = r % 192, kb = r / 192; cvt_item(p.in[I_WADA], NADA, (bf16_t*)(ws + WS_WADA), DM, 64 * kb, 64 * nb, 64 * nb, scr, lane); continue; } r -= I0;
        if (r < I1) { const int nb = r % 112, kb = r / 112; cvt_item(p.in[I_WIN], INW, (bf16_t*)(ws + WS_WIN), DM, 64 * kb, 64 * nb, 64 * nb, scr, lane); continue; } r -= I1;
        if (r < I2) { const int nb = r % 192, kb = r / 192; const int n0 = 64 * nb; const int j0 = n0 < DFF ? n0 : n0 - DFF;
            const int drow = (j0 >> 7) * 256 + (n0 < DFF ? 0 : 128) + (j0 & 127);
            cvt_item(p.in[I_WUP], 2 * DFF, (bf16_t*)(ws + WS_WUP), DM, 64 * kb, n0, drow, scr, lane); continue; } r -= I2;
        if (r < I3) { const int nb = r % 32, kb = r / 32; cvt_item(p.in[I_WDOWN], DM, (bf16_t*)(ws + WS_WDOWN), DFF, 64 * kb, 64 * nb, 64 * nb, scr, lane); continue; } r -= I3;
        if (r < I4) { const int nb = r % 32, kb = r / 32; cvt_item(p.in[I_WOUT], DM, (bf16_t*)(ws + WS_WOUT), DM, 64 * kb, 64 * nb, 64 * nb, scr, lane); continue; } r -= I4;
        if (r < I5) { const int nb = r % 32, kb = r / 32; cvt_item(p.in[I_WLU], DM, (bf16_t*)(ws + WS_WLU), LW, 64 * kb, 64 * nb, 64 * nb, scr, lane); continue; } r -= I5;
        if (r < I6) { const int nb = r % 32, kb = r / 32; cvt_item(p.in[I_WPU], DM, (bf16_t*)(ws + WS_WPU), PW, 64 * kb, 64 * nb, 64 * nb, scr, lane); continue; } r -= I6;
        if (r < I7) { const int g = r >> 4, q = r & 15, kb = q >> 2, nb = q & 3;
            cvt_item(p.in[I_WGRP] + (size_t)g * 65536, 256, (bf16_t*)(ws + WS_WGRP) + (size_t)g * 65536, 256, 64 * kb, 64 * nb, 64 * nb, scr, lane); continue; } r -= I7;
        { const bool isig = r >= I8; if (isig) r -= I8;
          const int blk = r >> 4, q = r & 15, kb = q >> 2, nb = q & 3, n0 = 64 * nb;
          const int drow = (blk * 2 + (n0 >> 7)) * 256 + (isig ? 128 : 0) + (n0 & 127);
          cvt_item(p.in[isig ? I_WIG : I_WRG] + (size_t)blk * 65536, 256, (bf16_t*)(ws + WS_WGATE), 256, 64 * kb, n0, drow, scr, lane); }
    }
    if (PART != 0) return;
    bf16_t* sada = (bf16_t*)(ws + WS_SADA);
    for (int i = gt; i < 256 * DM; i += NGT) { const int r = i >> 11, k = i & 2047;
        float v = 0.f; if (r < 4) v = p.in[I_CP][r * DM + k]; else if (r < NSEQ) v = p.in[I_CS][(r - 4) * DM + k];
        const float s = v * sigmoidf_(v);
        sada[i] = (bf16_t)(pk2(s, s) & 0xffffu); }
    float* spl = (float*)(ws + WS_CTL);
    for (int i = gt; i < LW; i += NGT) spl[i] = log1pf(expf(-p.in[I_LAM][i]));
}

__device__ __forceinline__ const float* xrow_ptr(const Params& p, int row) { return row < MPROMPT ? p.in[I_XP] + (size_t)row * DM : p.in[I_XS] + (size_t)(row - MPROMPT) * DM; }

__device__ __forceinline__ void norm1_row(const Params& p, const f32x4 (&v)[8], const f32x4 (&sc)[8], const f32x4 (&sh)[8], int row, int lane) {
    bf16_t* H = (bf16_t*)(p.ws + WS_H);
    float ss = 0.f;
#pragma unroll
    for (int j = 0; j < 8; ++j) ss += (v[j].x * v[j].x + v[j].y * v[j].y) + (v[j].z * v[j].z + v[j].w * v[j].w);
    const float rstd = 1.0f / sqrtf(wave_sum(ss) * (1.0f / DM) + EPS);
#pragma unroll
    for (int j = 0; j < 8; ++j) { const int col = 4 * lane + 256 * j;
        const f32x4 h = v[j] * rstd * sc[j] + sh[j];
        u32x2 w; w.x = pk2(h.x, h.y); w.y = pk2(h.z, h.w);
        *(u32x2*)(H + (size_t)row * DM + col) = w; }
}
__device__ __forceinline__ void phase_norm1(const Params& p) {
    const int tid = threadIdx.x, lane = tid & 63, wave = tid >> 6;
    const int gw = blockIdx.x * NWAVES + wave, NGW = gridDim.x * NWAVES;
    const float* ada = (const float*)(p.ws + WS_ADA);
    f32x4 v[8], vn[8];
    if (gw < MPROMPT) { const f32x4* xr = (const f32x4*)(p.in[I_XP] + (size_t)gw * DM) + lane;
#pragma unroll
        for (int j = 0; j < 8; ++j) v[j] = __builtin_nontemporal_load(xr + 64 * j); }
    for (int row = gw; row < MPROMPT; row += NGW) {
        const float* ar = ada + (size_t)(row >> 11) * NADA;
        f32x4 sc[8], sh[8];
#pragma unroll
        for (int j = 0; j < 8; ++j) { const int col = 4 * lane + 256 * j; sc[j] = *(const f32x4*)(ar + DM + col); sh[j] = *(const f32x4*)(ar + col); }
        if (row + NGW < MPROMPT) { const f32x4* xr = (const f32x4*)(p.in[I_XP] + (size_t)(row + NGW) * DM) + lane;
#pragma unroll
            for (int j = 0; j < 8; ++j) vn[j] = __builtin_nontemporal_load(xr + 64 * j); }
        norm1_row(p, v, sc, sh, row, lane);
#pragma unroll
        for (int j = 0; j < 8; ++j) v[j] = vn[j];
    }
    for (int row = MPROMPT + (gw >> 1); (gw & 1) == 0 && row < MTOK; row += (NGW >> 1)) {
        const float* ar = ada + (size_t)seq_of_row(row) * NADA; const f32x4* xr = (const f32x4*)xrow_ptr(p, row) + lane;
        f32x4 x[8], sc[8], sh[8];
#pragma unroll
        for (int j = 0; j < 8; ++j) { const int col = 4 * lane + 256 * j; x[j] = __builtin_nontemporal_load(xr + 64 * j); sc[j] = *(const f32x4*)(ar + DM + col); sh[j] = *(const f32x4*)(ar + col); }
        norm1_row(p, x, sc, sh, row, lane);
    }
}

__device__ __forceinline__ void ld8f(const float* p, float (&x)[8]) { const f32x4 a = *(const f32x4*)p, c = *(const f32x4*)(p + 4); x[0] = a.x; x[1] = a.y; x[2] = a.z; x[3] = a.w; x[4] = c.x; x[5] = c.y; x[6] = c.z; x[7] = c.w; }
template <int W> __device__ __forceinline__ void pool_run(const bf16_t* zp, bf16_t* dp, int t0) {
    u32x2 raw[15 + W];
#pragma unroll
    for (int i = 0; i < 15 + W; ++i) { const int rr = i - (W - 1); raw[i] = (u32x2){0u, 0u}; if (t0 + rr >= 0) raw[i] = __builtin_nontemporal_load((const u32x2*)(zp + (ptrdiff_t)rr * INW)); }
    float s[4] = {0.f, 0.f, 0.f, 0.f};
#pragma unroll
    for (int i = 0; i < W - 1; ++i) { s[0] += bflo(raw[i].x); s[1] += bfhi(raw[i].x); s[2] += bflo(raw[i].y); s[3] += bfhi(raw[i].y); }
#pragma unroll
    for (int i = 0; i < 16; ++i) { const u32x2 cu = raw[i + W - 1]; const float u0 = bflo(cu.x), u1 = bfhi(cu.x), u2 = bflo(cu.y), u3 = bfhi(cu.y);
        s[0] += u0; s[1] += u1; s[2] += u2; s[3] += u3;
        const int t = t0 + i; const float inv = 1.0f / (float)((t + 1) < W ? (t + 1) : W);
        u32x2 o; o.x = pk2(s[0] * inv - u0, s[1] * inv - u1); o.y = pk2(s[2] * inv - u2, s[3] * inv - u3);
        *(u32x2*)(dp + (size_t)i * PW) = o;
        const u32x2 od = raw[i]; s[0] -= bflo(od.x); s[1] -= bfhi(od.x); s[2] -= bflo(od.y); s[3] -= bfhi(od.y); }
}
__device__ __forceinline__ void phase_mixprep(const Params& p) {
    const int gt = blockIdx.x * NTHREADS + threadIdx.x, NGT = gridDim.x * NTHREADS;
    const bf16_t* Z = (const bf16_t*)(p.ws + WS_Z); bf16_t* Dp = (bf16_t*)(p.ws + WS_DP); bf16_t* XC = (bf16_t*)(p.ws + WS_XC);
    for (int it = gt; it < (MPROMPT / 16) * 256; it += NGT) {
        const int c4 = it & 255, run = it >> 8, ch0 = 4 * c4, g = ch0 >> 8, r0 = run * 16, t0 = r0 & (SEQ - 1);
        const bf16_t* zp = Z + (size_t)r0 * INW + ch0;
        switch (g) { case 0: pool_run<2>(zp, Dp + (size_t)r0 * PW + ch0, t0); break; case 1: pool_run<4>(zp, Dp + (size_t)r0 * PW + ch0, t0); break;
                     case 2: pool_run<8>(zp, Dp + (size_t)r0 * PW + ch0, t0); break; default: pool_run<16>(zp, Dp + (size_t)r0 * PW + ch0, t0); break; }
    }
    for (int it = gt; it < 1024 * 128; it += NGT) {
        const int row = MPROMPT + (it >> 7), ch0 = (it & 127) * 8, g = ch0 >> 8, w = 2 << g;
        const int b = (row - MPROMPT) >> 3, t = (row - MPROMPT) & 7;
        u32x4 zr[8]; f32x4 sa[15], sb[15];
#pragma unroll
        for (int j = 0; j < 8; ++j) { zr[j] = (u32x4){0u, 0u, 0u, 0u}; if (j <= t && j < w) zr[j] = *(const u32x4*)(Z + (size_t)(row - j) * INW + ch0); }
#pragma unroll
        for (int k = 0; k < 15; ++k) { const int j = t + 15 - k;
            sa[k] = (f32x4){0.f, 0.f, 0.f, 0.f}; sb[k] = sa[k];
            if (j < w) { const float* sp = p.in[I_SPOOL] + ((size_t)b * 15 + k) * PW + ch0; sa[k] = *(const f32x4*)sp; sb[k] = *(const f32x4*)(sp + 4); } }
        float s[8], u[8]; unpack8(zr[0], u);
#pragma unroll
        for (int e = 0; e < 8; ++e) s[e] = u[e];
#pragma unroll
        for (int j = 1; j < 8; ++j) { float x[8]; unpack8(zr[j], x);
#pragma unroll
            for (int e = 0; e < 8; ++e) s[e] += x[e]; }
#pragma unroll
        for (int k = 0; k < 15; ++k) { s[0] += sa[k].x; s[1] += sa[k].y; s[2] += sa[k].z; s[3] += sa[k].w; s[4] += sb[k].x; s[5] += sb[k].y; s[6] += sb[k].z; s[7] += sb[k].w; }
        const float inv = 1.0f / (float)w; float d[8];
#pragma unroll
        for (int e = 0; e < 8; ++e) d[e] = s[e] * inv - u[e];
        *(u32x4*)(Dp + (size_t)row * PW + ch0) = pack8(d);
    }
    for (int it = gt; it < (MPROMPT / 8) * 256; it += NGT) {
        const int c8 = it & 255, run = it >> 8, ch0 = 8 * c8, r0 = run * 8, t0 = r0 & (SEQ - 1);
        u32x4 raw[11];
#pragma unroll
        for (int i = 0; i < 11; ++i) { const int tt = t0 - 3 + i; raw[i] = (u32x4){0u, 0u, 0u, 0u}; if (tt >= 0) raw[i] = __builtin_nontemporal_load((const u32x4*)(Z + (size_t)(r0 - 3 + i) * INW + PW + ch0)); }
        float wk[4][8], bb[8];
#pragma unroll
        for (int k = 0; k < 4; ++k) ld8f(p.in[I_WLCONV] + (size_t)k * LW + ch0, wk[k]);
        ld8f(p.in[I_BLCONV] + ch0, bb);
        float x0[8], x1[8], x2[8], x3[8];
        unpack8(raw[0], x0); unpack8(raw[1], x1); unpack8(raw[2], x2);
#pragma unroll
        for (int i = 0; i < 8; ++i) { unpack8(raw[3 + i], x3); float o[8];
#pragma unroll
            for (int e = 0; e < 8; ++e) { o[e] = bb[e] + x0[e] * wk[0][e] + x1[e] * wk[1][e] + x2[e] * wk[2][e] + x3[e] * wk[3][e]; x0[e] = x1[e]; x1[e] = x2[e]; x2[e] = x3[e]; }
            *(u32x4*)(XC + (size_t)(r0 + i) * LW + ch0) = pack8(o); }
    }
    for (int it = gt; it < 1024 * 256; it += NGT) {
        const int row = MPROMPT + (it >> 8), ch0 = (it & 255) * 8;
        float acc[8]; ld8f(p.in[I_BLCONV] + ch0, acc);
        const int t = (row - MPROMPT) & 7, b = (row - MPROMPT) >> 3;
#pragma unroll
        for (int k = 0; k < 4; ++k) { const int tt = t - 3 + k; float x[8];
            if (tt >= 0) unpack8(*(const u32x4*)(Z + (size_t)(row - 3 + k) * INW + PW + ch0), x);
            else ld8f(p.in[I_SLCONV] + ((size_t)b * 3 + (3 + tt)) * LW + ch0, x);
            float wv[8]; ld8f(p.in[I_WLCONV] + (size_t)k * LW + ch0, wv);
#pragma unroll
            for (int e = 0; e < 8; ++e) acc[e] += x[e] * wv[e]; }
        *(u32x4*)(XC + (size_t)row * LW + ch0) = pack8(acc);
    }
    float* out = p.out;
    for (int i = gt; i < 4 * 15 * PW / 8; i += NGT) { const int ch = (i & 127) * 8, q = i >> 7, b = q / 15, r = q % 15;
        float x[8]; unpack8(*(const u32x4*)(Z + (size_t)(b * SEQ + SEQ - 15 + r) * INW + ch), x);
        float* o = out + O_POOLP + (size_t)q * PW + ch; __builtin_nontemporal_store((f32x4){x[0], x[1], x[2], x[3]}, (f32x4*)o); __builtin_nontemporal_store((f32x4){x[4], x[5], x[6], x[7]}, (f32x4*)(o + 4)); }
    for (int i = gt; i < 128 * 15 * PW / 8; i += NGT) { const int ch = (i & 127) * 8, q = i >> 7, b = q / 15, r = q % 15;
        float x[8];
        if (r < 7) ld8f(p.in[I_SPOOL] + ((size_t)b * 15 + 8 + r) * PW + ch, x); else unpack8(*(const u32x4*)(Z + (size_t)(MPROMPT + b * 8 + r - 7) * INW + ch), x);
        float* o = out + O_POOLS + (size_t)q * PW + ch; __builtin_nontemporal_store((f32x4){x[0], x[1], x[2], x[3]}, (f32x4*)o); __builtin_nontemporal_store((f32x4){x[4], x[5], x[6], x[7]}, (f32x4*)(o + 4)); }
    for (int i = gt; i < 4 * 3 * LW / 8; i += NGT) { const int ch = (i & 255) * 8, q = i >> 8, b = q / 3, r = q % 3;
        float x[8]; unpack8(*(const u32x4*)(Z + (size_t)(b * SEQ + SEQ - 3 + r) * INW + PW + ch), x);
        float* o = out + O_LCONVP + (size_t)q * LW + ch; __builtin_nontemporal_store((f32x4){x[0], x[1], x[2], x[3]}, (f32x4*)o); __builtin_nontemporal_store((f32x4){x[4], x[5], x[6], x[7]}, (f32x4*)(o + 4)); }
    for (int i = gt; i < 128 * 3 * LW / 8; i += NGT) { const int ch = (i & 255) * 8, q = i >> 8, b = q / 3, r = q % 3;
        float x[8]; unpack8(*(const u32x4*)(Z + (size_t)(MPROMPT + b * 8 + 5 + r) * INW + PW + ch), x);
        float* o = out + O_LCONVS + (size_t)q * LW + ch; __builtin_nontemporal_store((f32x4){x[0], x[1], x[2], x[3]}, (f32x4*)o); __builtin_nontemporal_store((f32x4){x[4], x[5], x[6], x[7]}, (f32x4*)(o + 4)); }
}

__device__ __forceinline__ void phase_scan(const Params& p, LAS unsigned char* lds) {
    const int tid = threadIdx.x;
    const unsigned* LU = (const unsigned*)(p.ws + WS_LA); bf16_t* YL = (bf16_t*)(p.ws + WS_YL);
    LAS float* sA = (LAS float*)lds; LAS float* sH = sA + 512;
    for (int item = blockIdx.x; item < 256; item += gridDim.x) {
        const int b = item >> 6, c32 = tid & 31, ch = (item & 63) * 32 + c32, chunk = tid >> 5;
        const size_t base = (size_t)(b * SEQ + chunk * 128) * LW + ch;
        float h = 0.f, sla = 0.f;
#pragma unroll 8
        for (int s = 0; s < 128; ++s) { const unsigned lw = LU[base + (size_t)s * LW]; const float la = bflo(lw), u = bfhi(lw); h = __expf(la) * h + u; sla += la; }
        sA[chunk * 32 + c32] = __expf(sla); sH[chunk * 32 + c32] = h;
        __syncthreads();
        float hin = 0.f;
        for (int j = 0; j < chunk; ++j) hin = sA[j * 32 + c32] * hin + sH[j * 32 + c32];
        h = hin;
#pragma unroll 8
        for (int s = 0; s < 128; ++s) { const unsigned lw = __builtin_nontemporal_load(LU + base + (size_t)s * LW); const float la = bflo(lw), u = bfhi(lw); h = __expf(la) * h + u;
            YL[base + (size_t)s * LW] = (bf16_t)(pk2(h, h) & 0xffffu); }
        if (chunk == 15) p.out[O_LHP + b * LW + ch] = h;
        __syncthreads();
    }
    const int gt = blockIdx.x * NTHREADS + tid, NGT = gridDim.x * NTHREADS;
    for (int i = gt; i < 128 * LW; i += NGT) { const int b = i >> 11, ch = i & 2047;
        float h = p.in[I_SLH][i]; const size_t base = (size_t)(MPROMPT + b * 8) * LW + ch;
#pragma unroll
        for (int s = 0; s < 8; ++s) { const unsigned lw = LU[base + (size_t)s * LW]; const float la = bflo(lw), u = bfhi(lw); h = __expf(la) * h + u;
            YL[base + (size_t)s * LW] = (bf16_t)(pk2(h, h) & 0xffffu); }
        p.out[O_LHS + i] = h; }
}

__device__ __forceinline__ void load_mo_row(f32x4 (&v)[8], const bf16_t* Ob, const float* Os, int row, int lane) {
    if (row < MPROMPT) { const u32x2* mr = (const u32x2*)(Ob + (size_t)row * DM) + lane;
#pragma unroll
        for (int j = 0; j < 8; ++j) { const u32x2 w = __builtin_nontemporal_load(mr + 64 * j); v[j] = (f32x4){bflo(w.x), bfhi(w.x), bflo(w.y), bfhi(w.y)}; } }
    else { const f32x4* mr = (const f32x4*)(Os + (size_t)(row - MPROMPT) * DM) + lane;
#pragma unroll
        for (int j = 0; j < 8; ++j) v[j] = __builtin_nontemporal_load(mr + 64 * j);
#pragma unroll 1
        for (int k0 = 1; k0 < 8; k0 += 4) { f32x4 t[4][8];
#pragma unroll
            for (int q = 0; q < 4; ++q)
#pragma unroll
                for (int j = 0; j < 8; ++j) t[q][j] = (k0 + q < 8) ? mr[(size_t)(k0 + q) * (1024 * DM / 4) + 64 * j] : (f32x4){0.f, 0.f, 0.f, 0.f};
#pragma unroll
            for (int q = 0; q < 4; ++q)
#pragma unroll
                for (int j = 0; j < 8; ++j) v[j] += t[q][j]; } }
}
__device__ __forceinline__ void mid_row(const Params& p, const f32x4 (&x)[8], f32x4 (&v)[8], const f32x4 (&G1)[8], const f32x4 (&S2)[8], const f32x4 (&sh2)[8], int row, int lane) {
    bf16_t* H = (bf16_t*)(p.ws + WS_H2);
    float ss = 0.f;
#pragma unroll
    for (int j = 0; j < 8; ++j) ss += (v[j].x * v[j].x + v[j].y * v[j].y) + (v[j].z * v[j].z + v[j].w * v[j].w);
    const float rstd = 1.0f / sqrtf(wave_sum(ss) * (1.0f / DM) + EPS);
    float ss2 = 0.f;
#pragma unroll
    for (int j = 0; j < 8; ++j) { const int col = 4 * lane + 256 * j;
        v[j] = x[j] + G1[j] * (v[j] * rstd);
        __builtin_nontemporal_store(v[j], (f32x4*)(p.out + (size_t)row * DM + col));
        ss2 += (v[j].x * v[j].x + v[j].y * v[j].y) + (v[j].z * v[j].z + v[j].w * v[j].w); }
    const float rstd2 = 1.0f / sqrtf(wave_sum(ss2) * (1.0f / DM) + EPS);
#pragma unroll
    for (int j = 0; j < 8; ++j) { const int col = 4 * lane + 256 * j;
        const f32x4 h = v[j] * rstd2 * S2[j] + sh2[j];
        u32x2 w; w.x = pk2(h.x, h.y); w.y = pk2(h.z, h.w);
        *(u32x2*)(H + (size_t)row * DM + col) = w; }
}
__device__ __forceinline__ void phase_mid(const Params& p) {
    const int tid = threadIdx.x, lane = tid & 63, wave = tid >> 6;
    const int gw = blockIdx.x * NWAVES + wave, NGW = gridDim.x * NWAVES;
    const float* ada = (const float*)(p.ws + WS_ADA);
    const bf16_t* Ob = (const bf16_t*)(p.ws + WS_MO); const float* Os = (const float*)(p.ws + WS_MOS);
    {
        f32x4 x[8], xn[8]; u32x2 mb[8], mbn[8];
        if (gw < MPROMPT) { const f32x4* xr = (const f32x4*)(p.in[I_XP] + (size_t)gw * DM) + lane; const u32x2* mr = (const u32x2*)(Ob + (size_t)gw * DM) + lane;
#pragma unroll
            for (int j = 0; j < 8; ++j) { x[j] = __builtin_nontemporal_load(xr + 64 * j); mb[j] = __builtin_nontemporal_load(mr + 64 * j); } }
        for (int row = gw; row < MPROMPT; row += NGW) {
            const float* ar = ada + (size_t)(row >> 11) * NADA;
            f32x4 G1[8], S2[8], sh2[8];
#pragma unroll
            for (int j = 0; j < 8; ++j) { const int col = 4 * lane + 256 * j; G1[j] = *(const f32x4*)(ar + 2 * DM + col); }
            if (row + NGW < MPROMPT) { const f32x4* xr = (const f32x4*)(p.in[I_XP] + (size_t)(row + NGW) * DM) + lane; const u32x2* mr = (const u32x2*)(Ob + (size_t)(row + NGW) * DM) + lane;
#pragma unroll
                for (int j = 0; j < 8; ++j) { xn[j] = __builtin_nontemporal_load(xr + 64 * j); mbn[j] = __builtin_nontemporal_load(mr + 64 * j); } }
#pragma unroll
            for (int j = 0; j < 8; ++j) { const int col = 4 * lane + 256 * j; S2[j] = *(const f32x4*)(ar + 4 * DM + col); sh2[j] = *(const f32x4*)(ar + 3 * DM + col); }
            f32x4 v[8];
#pragma unroll
            for (int j = 0; j < 8; ++j) v[j] = (f32x4){bflo(mb[j].x), bfhi(mb[j].x), bflo(mb[j].y), bfhi(mb[j].y)};
            mid_row(p, x, v, G1, S2, sh2, row, lane);
#pragma unroll
            for (int j = 0; j < 8; ++j) { x[j] = xn[j]; mb[j] = mbn[j]; }
        }
    }
    for (int row = MPROMPT + (gw >> 1); (gw & 1) == 0 && row < MTOK; row += (NGW >> 1)) {
        const float* ar = ada + (size_t)seq_of_row(row) * NADA;
        f32x4 v[8]; load_mo_row(v, Ob, Os, row, lane);
        f32x4 x[8], G1[8], S2[8], sh2[8]; const f32x4* xr = (const f32x4*)xrow_ptr(p, row) + lane;
#pragma unroll
        for (int j = 0; j < 8; ++j) { const int col = 4 * lane + 256 * j; x[j] = __builtin_nontemporal_load(xr + 64 * j); G1[j] = *(const f32x4*)(ar + 2 * DM + col); S2[j] = *(const f32x4*)(ar + 4 * DM + col); sh2[j] = *(const f32x4*)(ar + 3 * DM + col); }
        mid_row(p, x, v, G1, S2, sh2, row, lane);
    }
}

__device__ __forceinline__ void phase_ffnconv(const Params& p) {
    const int gt = blockIdx.x * NTHREADS + threadIdx.x, NGT = gridDim.x * NTHREADS;
    const bf16_t* UP = (const bf16_t*)(p.ws + WS_UP); bf16_t* F = (bf16_t*)(p.ws + WS_F2);
    constexpr int NCH = DFF / 8;
    const bf16_t* UPB = (const bf16_t*)(p.ws + WS_UPB);
    for (int it = gt; it < 128 * 2 * NCH; it += NGT) {
        const int c = it % NCH, q = it / NCH, sl = q & 1, blk = q >> 1, j0 = 8 * c, colg = (j0 >> 7) * 256 + (j0 & 127);
        const int row = blk * 64 + sl; const bool first = (blk & 31) == 0;
        float wg[3][8], wv[3][8], ag[8], av[8];
#pragma unroll
        for (int k = 0; k < 3; ++k) { ld8f(p.in[I_WFCONV] + (size_t)k * 2 * DFF + j0, wg[k]); ld8f(p.in[I_WFCONV] + (size_t)k * 2 * DFF + DFF + j0, wv[k]); }
        ld8f(p.in[I_BFCONV] + j0, ag); ld8f(p.in[I_BFCONV] + DFF + j0, av);
#pragma unroll
        for (int k = 0; k < 3; ++k) { const int d = k - 2 + sl;
            if (d < 0 && first) continue;
            const size_t ub = d < 0 ? (size_t)((blk - 1) * 4 + 4 + d) : (size_t)(blk * 4 + d);
            float xg[8], xv[8]; unpack8(*(const u32x4*)(UPB + ub * (2 * DFF) + colg), xg); unpack8(*(const u32x4*)(UPB + ub * (2 * DFF) + colg + 128), xv);
#pragma unroll
            for (int e = 0; e < 8; ++e) { ag[e] += xg[e] * wg[k][e]; av[e] += xv[e] * wv[k][e]; } }
        float f[8];
#pragma unroll
        for (int e = 0; e < 8; ++e) f[e] = gelu_tanh(ag[e]) * av[e];
        *(u32x4*)(F + (size_t)row * DFF + j0) = pack8(f);
    }
    if (gt < 170 * NCH) {
        const int c = gt % NCH, slot = gt / NCH, j0 = 8 * c, colg = (j0 >> 7) * 256 + (j0 & 127);
        float wg[3][8], wv[3][8], bg[8], bv[8];
#pragma unroll
        for (int k = 0; k < 3; ++k) { ld8f(p.in[I_WFCONV] + (size_t)k * 2 * DFF + j0, wg[k]); ld8f(p.in[I_WFCONV] + (size_t)k * 2 * DFF + DFF + j0, wv[k]); }
        ld8f(p.in[I_BFCONV] + j0, bg); ld8f(p.in[I_BFCONV] + DFF + j0, bv);
        for (int rs = slot; rs < 1024; rs += 170) {
            const int row = MPROMPT + rs, t = rs & 7, b = rs >> 3;
            float xg[3][8], xv[3][8];
#pragma unroll
            for (int k = 0; k < 3; ++k) { const int tt = t - 2 + k;
                if (tt >= 0) { unpack8(*(const u32x4*)(UP + (size_t)(row - 2 + k) * 2 * DFF + colg), xg[k]); unpack8(*(const u32x4*)(UP + (size_t)(row - 2 + k) * 2 * DFF + colg + 128), xv[k]); }
                else { const float* sp = p.in[I_SFCONV] + ((size_t)b * 2 + (2 + tt)) * 2 * DFF; ld8f(sp + j0, xg[k]); ld8f(sp + DFF + j0, xv[k]); } }
            float f[8];
#pragma unroll
            for (int e = 0; e < 8; ++e) { const float cg_ = bg[e] + xg[0][e] * wg[0][e] + xg[1][e] * wg[1][e] + xg[2][e] * wg[2][e];
                const float cv_ = bv[e] + xv[0][e] * wv[0][e] + xv[1][e] * wv[1][e] + xv[2][e] * wv[2][e]; f[e] = gelu_tanh(cg_) * cv_; }
            *(u32x4*)(F + (size_t)row * DFF + j0) = pack8(f);
        }
    }
    for (int i = gt; i < NSEQ * 2 * (2 * DFF / 8); i += NGT) { const int c = i % 1536, q = i / 1536, r = q & 1, s = q >> 1, n0 = 8 * c;
        const int j0 = n0 < DFF ? n0 : n0 - DFF, col = (j0 >> 7) * 256 + (n0 < DFF ? 0 : 128) + (j0 & 127);
        const int row = s < 4 ? s * SEQ + SEQ - 2 + r : MPROMPT + (s - 4) * 8 + 6 + r;
        float x[8];
        if (s < 4) unpack8(*(const u32x4*)(UPB + ((size_t)(s * 32 + 31) * 4 + 2 + r) * (2 * DFF) + col), x); else unpack8(*(const u32x4*)(UP + (size_t)row * 2 * DFF + col), x);
        float* o = p.out + (s < 4 ? O_FCONVP + ((size_t)s * 2 + r) * 2 * DFF : O_FCONVS + ((size_t)(s - 4) * 2 + r) * 2 * DFF) + n0;
        __builtin_nontemporal_store((f32x4){x[0], x[1], x[2], x[3]}, (f32x4*)o); __builtin_nontemporal_store((f32x4){x[4], x[5], x[6], x[7]}, (f32x4*)(o + 4)); }
}

__device__ __forceinline__ void phase_final(const Params& p) {
    const int tid = threadIdx.x, lane = tid & 63, wave = tid >> 6;
    const int gw = blockIdx.x * NWAVES + wave, NGW = gridDim.x * NWAVES;
    const float* ada = (const float*)(p.ws + WS_ADA);
    const bf16_t* Ob = (const bf16_t*)(p.ws + WS_FO); const float* Os = (const float*)(p.ws + WS_FOS2);
    {
        f32x4 x[8], xn[8]; u32x2 mb[8], mbn[8];
        if (gw < MPROMPT) { const f32x4* xr = (const f32x4*)(p.out + (size_t)gw * DM) + lane; const u32x2* mr = (const u32x2*)(Ob + (size_t)gw * DM) + lane;
#pragma unroll
            for (int j = 0; j < 8; ++j) { x[j] = __builtin_nontemporal_load(xr + 64 * j); mb[j] = __builtin_nontemporal_load(mr + 64 * j); } }
        for (int row = gw; row < MPROMPT; row += NGW) {
            const float* ar = ada + (size_t)(row >> 11) * NADA;
            f32x4 gt2[8];
#pragma unroll
            for (int j = 0; j < 8; ++j) { const int col = 4 * lane + 256 * j; gt2[j] = *(const f32x4*)(ar + 5 * DM + col); }
            if (row + NGW < MPROMPT) { const f32x4* xr = (const f32x4*)(p.out + (size_t)(row + NGW) * DM) + lane; const u32x2* mr = (const u32x2*)(Ob + (size_t)(row + NGW) * DM) + lane;
#pragma unroll
                for (int j = 0; j < 8; ++j) { xn[j] = __builtin_nontemporal_load(xr + 64 * j); mbn[j] = __builtin_nontemporal_load(mr + 64 * j); } }
            f32x4 v[8]; float ss = 0.f;
#pragma unroll
            for (int j = 0; j < 8; ++j) { v[j] = (f32x4){bflo(mb[j].x), bfhi(mb[j].x), bflo(mb[j].y), bfhi(mb[j].y)}; ss += (v[j].x * v[j].x + v[j].y * v[j].y) + (v[j].z * v[j].z + v[j].w * v[j].w); }
            const float rstd = 1.0f / sqrtf(wave_sum(ss) * (1.0f / DM) + EPS);
#pragma unroll
            for (int j = 0; j < 8; ++j) { const int col = 4 * lane + 256 * j;
                __builtin_nontemporal_store(x[j] + gt2[j] * (v[j] * rstd), (f32x4*)(p.out + (size_t)row * DM + col)); }
#pragma unroll
            for (int j = 0; j < 8; ++j) { x[j] = xn[j]; mb[j] = mbn[j]; }
        }
    }
    for (int row = MPROMPT + (gw >> 1); (gw & 1) == 0 && row < MTOK; row += (NGW >> 1)) {
        f32x4 v[8]; float ss = 0.f;
        load_mo_row(v, Ob, Os, row, lane);
#pragma unroll
        for (int j = 0; j < 8; ++j) ss += (v[j].x * v[j].x + v[j].y * v[j].y) + (v[j].z * v[j].z + v[j].w * v[j].w);
        const float rstd = 1.0f / sqrtf(wave_sum(ss) * (1.0f / DM) + EPS);
        const float* ar = ada + (size_t)seq_of_row(row) * NADA;
#pragma unroll
        for (int j = 0; j < 8; ++j) { const int col = 4 * lane + 256 * j;
            const f32x4 gt2 = *(const f32x4*)(ar + 5 * DM + col);
            float* o = p.out + (size_t)row * DM + col; const f32x4 x1 = *(const f32x4*)o;
            *(f32x4*)o = x1 + gt2 * (v[j] * rstd); }
    }
}

__global__ void __launch_bounds__(NTHREADS, 2) fwd_megakernel(Params p) {
    extern __shared__ __attribute__((aligned(16))) unsigned char lds_raw[];
    LAS unsigned char* lds = (LAS unsigned char*)lds_raw;
    cg::grid_group grid = cg::this_grid();
    unsigned char* ws = p.ws;
    if (ws == nullptr) grid.sync();
    volatile LAS unsigned* xst = (volatile LAS unsigned*)(lds + LDS_MAIN);
    if (threadIdx.x < 4) xst[threadIdx.x] = 0u;
    __syncthreads();
    const XcdBarrier xbar = xcd_barrier_post((unsigned*)(ws + WS_BAR), xst);
    const int G = gridDim.x, c = blockIdx.x;
    using namespace pg8;
    const size_t TA = 256ull * 2;

    if (PHASE_MASK & 1u) phase0<0>(p, lds);
    xcd_barrier(xbar);
    if (c < 48) {
        Sched S{(const char*)(ws + WS_SADA), (const char*)(ws + WS_WADA), TA * DM, TA * DM, 1, NADA / 256, DM / 64, G, c, 0, 0};
        EpiAda E{(float*)(ws + WS_ADA), p.in[I_BADA], p.in[I_GPRE1], p.in[I_GPOST1], p.in[I_GPRE2], p.in[I_GPOST2]};
        gemm_phase(lds, DM, DM, S, E);
        if (threadIdx.x == 0) { __builtin_amdgcn_fence(__ATOMIC_RELEASE, "agent"); asm volatile("s_waitcnt vmcnt(0)" ::: "memory");
            __hip_atomic_fetch_add((unsigned*)(ws + WS_BAR) + ADA_FLAG, 1u, __ATOMIC_RELAXED, __HIP_MEMORY_SCOPE_AGENT); }
    } else phase0<1>(p, lds);
    if (threadIdx.x == 0) { unsigned* f = (unsigned*)(ws + WS_BAR) + ADA_FLAG; unsigned sp = 0;
        while (__hip_atomic_load(f, __ATOMIC_RELAXED, __HIP_MEMORY_SCOPE_AGENT) < 48u) { __builtin_amdgcn_s_sleep(2); if (++sp > (1u << 20)) break; }
        __builtin_amdgcn_fence(__ATOMIC_ACQUIRE, "agent"); asm volatile("s_waitcnt vmcnt(0)" ::: "memory"); }
    __syncthreads();
    if (PHASE_MASK & 4u) phase_norm1(p);
    xcd_barrier(xbar);
    if (PHASE_MASK & 8u) {
        Sched S{(const char*)(ws + WS_H), (const char*)(ws + WS_WIN), TA * DM, TA * DM, MTOK / 256, INW / 256, DM / 64, G, c, 0, 0};
        EpiBf16 E{(bf16_t*)(ws + WS_Z), INW, 12};
        gemm_phase(lds, DM, DM, S, E);
    }
    xcd_barrier(xbar);
    if (PHASE_MASK & 16u) phase_mixprep(p);
    xcd_barrier(xbar);
    if (PHASE_MASK & 32u) {
        { Sched S{(const char*)(ws + WS_DP), (const char*)(ws + WS_WGRP), TA * PW, TA * 256, MTOK / 256, 4, 4, G, c, 0, 512};
          EpiPool E{(bf16_t*)(ws + WS_YP), p.in[I_PSCALE]};
          gemm_phase(lds, PW, 256, S, E); }
        { Sched S{(const char*)(ws + WS_XC), (const char*)(ws + WS_WGATE), TA * LW, TA * 256, MTOK / 256, 16, 4, G, (c + 80) & 255, 1, 512};
          EpiGates E{(const bf16_t*)(ws + WS_XC), (unsigned*)(ws + WS_LA), p.in[I_BRG], p.in[I_BIG], (const float*)(ws + WS_CTL)};
          gemm_phase(lds, LW, 256, S, E); }
    }
    xcd_barrier(xbar);
    if (PHASE_MASK & 64u) phase_scan(p, lds);
    xcd_barrier(xbar);
    if (PHASE_MASK & 128u) {
        { SchedP7 S{Sched{(const char*)(ws + WS_YP), (const char*)(ws + WS_WPU), TA * PW, TA * PW, 32, DM / 256, PW / 64, G, c, 0, 0}, 0, 1000};
          EpiMerge<false> E{(bf16_t*)(ws + WS_MG), (const bf16_t*)(ws + WS_Z), PW + LW, (unsigned*)(ws + WS_BAR)};
          gemm_phase(lds, PW, PW, S, E); }
        { SchedP7 S{Sched{(const char*)(ws + WS_YL), (const char*)(ws + WS_WLU), TA * LW, TA * LW, 32, DM / 256, LW / 64, G, c, 0, 0}, 32, 2000};
          EpiMerge<true> E{(bf16_t*)(ws + WS_MG), (const bf16_t*)(ws + WS_Z), PW + LW + DM, (unsigned*)(ws + WS_BAR)};
          gemm_phase(lds, LW, LW, S, E); }
        phase0<2>(p, lds);
    }
    xcd_barrier(xbar);
    if (PHASE_MASK & 256u) {
        SchedSplit S{Sched{(const char*)(ws + WS_MG), (const char*)(ws + WS_WOUT), TA * DM, TA * DM, 32, DM / 256, DM / 64, G, c, 0, 0}, 4, 0, 8, 0};
        EpiOut E{(bf16_t*)(ws + WS_MO), (float*)(ws + WS_MOS)};
        gemm_phase(lds, DM, DM, S, E);
    }
    xcd_barrier(xbar);
    if (PHASE_MASK & 512u) phase_mid(p);
    xcd_barrier(xbar);
    if (PHASE_MASK & 1024u) {
        Sched S{(const char*)(ws + WS_H2), (const char*)(ws + WS_WUP), TA * DM, TA * DM, MTOK / 256, 2 * DFF / 256, DM / 64, G, c, 0, 0};
        EpiUpFused E{(bf16_t*)(ws + WS_UP), (bf16_t*)(ws + WS_F2), (bf16_t*)(ws + WS_UPB), p.in[I_WFCONV], p.in[I_BFCONV]};
        gemm_phase(lds, DM, DM, S, E);
        phase0<3>(p, lds);
    }
    xcd_barrier(xbar);
    if (PHASE_MASK & 2048u) phase_ffnconv(p);
    xcd_barrier(xbar);
    if (PHASE_MASK & 4096u) {
        SchedSplit S{Sched{(const char*)(ws + WS_F2), (const char*)(ws + WS_WDOWN), TA * DFF, TA * DFF, 32, DM / 256, DFF / 64, G, c, 0, 0}, 12, 0, 8, 0};
        EpiOut E{(bf16_t*)(ws + WS_FO), (float*)(ws + WS_FOS2)};
        gemm_phase(lds, DFF, DFF, S, E);
    }
    xcd_barrier(xbar);
    if (PHASE_MASK & 8192u) phase_final(p);
}

extern "C" void kernel_launch(void* const* d_in, const int* in_sizes, int n_in, void* d_out, int out_size, void* d_ws, size_t ws_size, hipStream_t stream) {
    constexpr size_t kDynLds = LDS_MAIN + 64;
    static int grid_blocks = 0;
    if (!grid_blocks) {
        int dev = 0, cus = 0, per_cu = 0;
        (void)hipGetDevice(&dev);
        (void)hipDeviceGetAttribute(&cus, hipDeviceAttributeMultiprocessorCount, dev);
        (void)hipFuncSetAttribute((const void*)fwd_megakernel, hipFuncAttributeMaxDynamicSharedMemorySize, (int)kDynLds);
        (void)hipOccupancyMaxActiveBlocksPerMultiprocessor(&per_cu, (const void*)fwd_megakernel, NTHREADS, kDynLds);
        if (per_cu < 1) per_cu = 1;
        grid_blocks = cus;
        if (n_in != N_IN) fprintf(stderr, "kernel_launch: expected %d inputs, got %d\n", (int)N_IN, n_in);
    }
    Params p{};
    for (int i = 0; i < N_IN; ++i) p.in[i] = (const float*)d_in[i];
    p.out = (float*)d_out; p.ws = (unsigned char*)d_ws;
    (void)hipMemsetAsync((unsigned char*)d_ws + WS_BAR, 0, BAR_ZERO_WORDS * 4, stream);
    void* args[] = {&p};
    hipError_t e = hipLaunchCooperativeKernel((const void*)fwd_megakernel, dim3(grid_blocks), dim3(NTHREADS), args, kDynLds, stream);
    if (e != hipSuccess) fprintf(stderr, "cooperative launch failed: %s (grid %d)\n", hipGetErrorString(e), grid_blocks);
}
```
